# Optimizing an MI355X kernel written in HIP

```python
import math
import jax
import jax.numpy as jnp
from jax import lax
import numpy as np

D_MODEL = 1024
BATCH = 4
SEQ = 8192
DEPTH = 1

N_META = 16
ATT_HEAD_DIM = 64
ATT_HEADS = D_MODEL // 128
ATT_WIDTH = ATT_HEADS * ATT_HEAD_DIM
Q_BLOCK = 128
SSM_WIDTH = D_MODEL // 2
SSM_GROUP_CH = 16
SSM_GROUPS = SSM_WIDTH // SSM_GROUP_CH
SSM_STATE = 64
DT_MIN = 0.001
DT_MAX = 0.1
IN_COLS = 3 * ATT_WIDTH + SSM_WIDTH + 2 * D_MODEL
MOE_GROUPS = 4
EXPERTS_PER_GROUP = 8
N_EXPERTS = MOE_GROUPS * EXPERTS_PER_GROUP
INNER_TOP_K = 2
EXPERT_FF = D_MODEL // 2
MOE_BLOCK = 128

RMS_EPS = 1e-6
NEG_BIG = -1e30

kernel_name = "hybrid_stickbreak_s5_hmoe_block"


def rms_norm(x, g):
    x32 = x.astype(jnp.float32)
    y = x32 * lax.rsqrt(jnp.mean(x32 * x32, axis=-1, keepdims=True) + RMS_EPS)
    return (y * g.astype(jnp.float32)).astype(x.dtype)


def stick_breaking_attention(q, k, v):
    b, l, _ = q.shape
    pad = (-N_META) % Q_BLOCK
    lp = l + pad

    def heads(t):
        t = jnp.pad(t, ((0, 0), (pad, 0), (0, 0)))
        return t.reshape(b, lp, ATT_HEADS, ATT_HEAD_DIM).transpose(0, 2, 1, 3)

    qh, kh, vh = heads(q), heads(k), heads(v)
    n_blocks = lp // Q_BLOCK
    key_pos = jnp.arange(lp)
    scale = ATT_HEAD_DIM ** -0.5

    def one_block(i):
        start = i * Q_BLOCK
        qb = lax.dynamic_slice_in_dim(qh, start, Q_BLOCK, axis=2)
        z = jnp.einsum('bhqd,bhkd->bhqk', qb, kh).astype(jnp.float32) * scale
        q_pos = start + jnp.arange(Q_BLOCK)
        valid = (key_pos[None, :] < q_pos[:, None]) & (key_pos[None, :] >= pad)
        log_beta = jnp.where(valid, jax.nn.log_sigmoid(z), NEG_BIG)
        log_keep = jnp.where(valid, jax.nn.log_sigmoid(-z), 0.0)
        tail = lax.cumsum(log_keep, axis=3, reverse=True)
        log_stick = jnp.concatenate([tail[..., 1:], jnp.zeros_like(tail[..., :1])], axis=-1)
        w = jnp.exp(log_beta + log_stick)
        return jnp.einsum('bhqk,bhkd->bhqd', w.astype(vh.dtype), vh)

    out = lax.map(one_block, jnp.arange(n_blocks))
    out = out.transpose(1, 0, 3, 2, 4).reshape(b, lp, ATT_WIDTH)
    return out[:, pad:]


def s5_ssm(u, lam_re, lam_im, log_dt, b_re, b_im, c_re, c_im, d_skip):
    b, l, _ = u.shape
    f32 = jnp.float32
    ug = u.astype(f32).reshape(b, l, SSM_GROUPS, SSM_GROUP_CH)
    lr, li = lam_re.astype(f32), lam_im.astype(f32)
    dt = jnp.exp(log_dt.astype(f32))[:, None]
    mag = jnp.exp(lr * dt)
    lb_re, lb_im = mag * jnp.cos(li * dt), mag * jnp.sin(li * dt)
    nr, ni = lb_re - 1.0, lb_im
    den = lr * lr + li * li
    f_re = (nr * lr + ni * li) / den
    f_im = (ni * lr - nr * li) / den
    br, bi = b_re.astype(f32), b_im.astype(f32)
    bb_re = f_re[:, :, None] * br - f_im[:, :, None] * bi
    bb_im = f_re[:, :, None] * bi + f_im[:, :, None] * br
    bu_re = jnp.einsum('blgc,gpc->lbgp', ug, bb_re)
    bu_im = jnp.einsum('blgc,gpc->lbgp', ug, bb_im)
    a_re = jnp.broadcast_to(lb_re, (l,) + lb_re.shape)
    a_im = jnp.broadcast_to(lb_im, (l,) + lb_im.shape)

    def combine(e1, e2):
        a1r, a1i, b1r, b1i = e1
        a2r, a2i, b2r, b2i = e2
        ar = a2r * a1r - a2i * a1i
        ai = a2r * a1i + a2i * a1r
        a2r_b, a2i_b = a2r[:, None], a2i[:, None]
        new_br = a2r_b * b1r - a2i_b * b1i + b2r
        new_bi = a2r_b * b1i + a2i_b * b1r + b2i
        return ar, ai, new_br, new_bi

    _, _, x_re, x_im = lax.associative_scan(combine, (a_re, a_im, bu_re, bu_im), axis=0)
    y = (jnp.einsum('lbgp,gcp->blgc', x_re, c_re.astype(f32))
         - jnp.einsum('lbgp,gcp->blgc', x_im, c_im.astype(f32))
         + d_skip.astype(f32).reshape(SSM_GROUPS, SSM_GROUP_CH) * ug)
    return y.reshape(b, l, SSM_WIDTH)


def hierarchical_moe(x, rg_w, rg_b, re_w, re_b, w1, w3, w2):
    b, l, d = x.shape
    t = b * l
    xt = x.reshape(t, d)
    group_probs = jax.nn.softmax((xt @ rg_w).astype(jnp.float32) + rg_b.astype(jnp.float32), axis=-1)
    p_top, g_top = lax.top_k(group_probs, 1)
    e_logits = ((xt @ re_w).astype(jnp.float32) + re_b.astype(jnp.float32)).reshape(t, MOE_GROUPS, EXPERTS_PER_GROUP)
    sel = jnp.take_along_axis(e_logits, g_top[:, :, None], axis=1)[:, 0]
    e_val, e_idx = lax.top_k(sel, INNER_TOP_K)
    gate = jax.nn.softmax(e_val, axis=-1) * p_top
    expert_id = g_top * EXPERTS_PER_GROUP + e_idx

    n = t * INNER_TOP_K
    n_blocks = (n + N_EXPERTS * (MOE_BLOCK - 1)) // MOE_BLOCK + 1
    cap = n_blocks * MOE_BLOCK
    e_flat = expert_id.reshape(n).astype(jnp.int32)
    tok_flat = jnp.repeat(jnp.arange(t, dtype=jnp.int32), INNER_TOP_K)
    w_flat = gate.reshape(n)
    order = jnp.argsort(e_flat)
    e_s, t_s, w_s = e_flat[order], tok_flat[order], w_flat[order]
    counts = jnp.bincount(e_flat, length=N_EXPERTS)
    padded = ((counts + MOE_BLOCK - 1) // MOE_BLOCK) * MOE_BLOCK
    start = jnp.cumsum(counts) - counts
    pend = jnp.cumsum(padded)
    pstart = pend - padded
    dest = pstart[e_s] + (jnp.arange(n, dtype=jnp.int32) - start[e_s])
    slot_tok = jnp.full((cap,), t, dtype=jnp.int32).at[dest].set(t_s)
    slot_w = jnp.zeros((cap,), jnp.float32).at[dest].set(w_s)
    block_e = jnp.minimum(jnp.searchsorted(pend, jnp.arange(n_blocks) * MOE_BLOCK, side='right'), N_EXPERTS - 1)
    x_pad = jnp.concatenate([xt, jnp.zeros((1, d), xt.dtype)], axis=0)
    xb = x_pad[slot_tok].reshape(n_blocks, MOE_BLOCK, d)

    def expert_block(args):
        xi, e = args
        hdn = jax.nn.silu(xi @ w1[e]) * (xi @ w3[e])
        return hdn @ w2[e]

    yb = lax.map(expert_block, (xb, block_e)).reshape(cap, d)
    y = jax.ops.segment_sum(yb * slot_w[:, None].astype(yb.dtype), slot_tok, num_segments=t + 1)[:t]
    return y.reshape(b, l, d)


def setup_inputs(seed: int = 0) -> dict:
    key = jax.random.key(seed)
    ks = jax.random.split(key, 32)
    nrm = jax.random.normal
    f32 = jnp.float32
    D, G, P, C, S = D_MODEL, SSM_GROUPS, SSM_STATE, SSM_GROUP_CH, SSM_WIDTH
    lam_im0 = math.pi * jnp.arange(P, dtype=f32)
    return {
        "x": nrm(ks[0], (BATCH, SEQ, D), f32),
        "meta_tokens": nrm(ks[1], (N_META, D), f32),
        "norm_mix_g": 1.0 + 0.01 * nrm(ks[2], (DEPTH, D), f32),
        "w_in": nrm(ks[3], (DEPTH, D, IN_COLS), f32) * D ** -0.5,
        "ssm_lambda_re": -0.5 + 0.01 * nrm(ks[4], (DEPTH, G, P), f32),
        "ssm_lambda_im": lam_im0 + 0.01 * nrm(ks[5], (DEPTH, G, P), f32),
        "ssm_log_dt": jax.random.uniform(ks[6], (DEPTH, G), f32, math.log(DT_MIN), math.log(DT_MAX)),
        "ssm_b_re": nrm(ks[7], (DEPTH, G, P, C), f32) * (2 * C) ** -0.5,
        "ssm_b_im": nrm(ks[8], (DEPTH, G, P, C), f32) * (2 * C) ** -0.5,
        "ssm_c_re": nrm(ks[9], (DEPTH, G, C, P), f32) * P ** -0.5,
        "ssm_c_im": nrm(ks[10], (DEPTH, G, C, P), f32) * P ** -0.5,
        "ssm_d": nrm(ks[11], (DEPTH, S), f32),
        "ssm_glu_w": nrm(ks[12], (DEPTH, S, S), f32) * S ** -0.5,
        "ssm_glu_b": 0.01 * nrm(ks[13], (DEPTH, S), f32),
        "w_branch_attn": nrm(ks[14], (DEPTH, ATT_WIDTH, D), f32) * ATT_WIDTH ** -0.5,
        "w_branch_ssm": nrm(ks[15], (DEPTH, S, D), f32) * S ** -0.5,
        "w_out": nrm(ks[16], (DEPTH, D, D), f32) * D ** -0.5,
        "norm_ffn_g": 1.0 + 0.01 * nrm(ks[17], (DEPTH, D), f32),
        "router_group_w": nrm(ks[18], (DEPTH, D, MOE_GROUPS), f32) * D ** -0.5,
        "router_group_b": 0.01 * nrm(ks[19], (DEPTH, MOE_GROUPS), f32),
        "router_expert_w": nrm(ks[20], (DEPTH, D, N_EXPERTS), f32) * D ** -0.5,
        "router_expert_b": 0.01 * nrm(ks[21], (DEPTH, N_EXPERTS), f32),
        "expert_w1": nrm(ks[22], (DEPTH, N_EXPERTS, D, EXPERT_FF), f32) * D ** -0.5,
        "expert_w3": nrm(ks[23], (DEPTH, N_EXPERTS, D, EXPERT_FF), f32) * D ** -0.5,
        "expert_w2": nrm(ks[24], (DEPTH, N_EXPERTS, EXPERT_FF, D), f32) * EXPERT_FF ** -0.5,
        "norm_final_g": 1.0 + 0.01 * nrm(ks[25], (D,), f32),
    }


def reference(x, meta_tokens, norm_mix_g, w_in, ssm_lambda_re, ssm_lambda_im, ssm_log_dt,
              ssm_b_re, ssm_b_im, ssm_c_re, ssm_c_im, ssm_d, ssm_glu_w, ssm_glu_b,
              w_branch_attn, w_branch_ssm, w_out, norm_ffn_g, router_group_w, router_group_b,
              router_expert_w, router_expert_b, expert_w1, expert_w3, expert_w2, norm_final_g):
    b = x.shape[0]
    meta = jnp.broadcast_to(meta_tokens.astype(x.dtype)[None], (b, N_META, D_MODEL))
    h = jnp.concatenate([meta, x], axis=1)
    splits = np.cumsum([ATT_WIDTH, ATT_WIDTH, ATT_WIDTH, SSM_WIDTH, D_MODEL]).tolist()
    for layer in range(DEPTH):
        xn = rms_norm(h, norm_mix_g[layer])
        proj = xn @ w_in[layer]
        q, k, v, u, ga, gb = jnp.split(proj, splits, axis=-1)
        attn = stick_breaking_attention(q, k, v)
        y = jax.nn.gelu(s5_ssm(u, ssm_lambda_re[layer], ssm_lambda_im[layer], ssm_log_dt[layer],
                               ssm_b_re[layer], ssm_b_im[layer], ssm_c_re[layer], ssm_c_im[layer],
                               ssm_d[layer]))
        ssm = (y * jax.nn.sigmoid(y @ ssm_glu_w[layer].astype(jnp.float32)
                                  + ssm_glu_b[layer].astype(jnp.float32))).astype(x.dtype)
        merged = (jax.nn.sigmoid(ga) * (attn @ w_branch_attn[layer])
                  + jax.nn.sigmoid(gb) * (ssm @ w_branch_ssm[layer]))
        h = h + merged @ w_out[layer]
        hn = rms_norm(h, norm_ffn_g[layer])
        h = h + hierarchical_moe(hn, router_group_w[layer], router_group_b[layer],
                                 router_expert_w[layer], router_expert_b[layer],
                                 expert_w1[layer], expert_w3[layer], expert_w2[layer])
    return rms_norm(h, norm_final_g)[:, N_META:]
```

```cpp
#include <hip/hip_runtime.h>
#include <cstdio>
#include <cstdint>

#ifndef REP_P0
#define REP_P0 1
#endif
#ifndef WGM_P1
#define WGM_P1 4
#endif
#ifndef WGM_GLU
#define WGM_GLU 4
#endif
#ifndef WGM_MRG
#define WGM_MRG 4
#endif
#ifndef WGM_WO
#define WGM_WO 4
#endif
#ifndef REP_P0S
#define REP_P0S 1
#endif
#ifndef REP_P1
#define REP_P1 1
#endif
#ifndef REP_SSM
#define REP_SSM 1
#endif
#ifndef REP_ATT
#define REP_ATT 1
#endif
#ifndef REP_MIX
#define REP_MIX 1
#endif
#ifndef REP_RT
#define REP_RT 1
#endif
#ifndef REP_MOE
#define REP_MOE 1
#endif
#ifndef REP_FIN
#define REP_FIN 1
#endif
#ifndef PH_MAX
#define PH_MAX 3
#endif

#define GAS __attribute__((address_space(1)))
#define LAS __attribute__((address_space(3)))
typedef unsigned short bf16;
typedef unsigned v4u __attribute__((ext_vector_type(4)));
typedef unsigned v2u __attribute__((ext_vector_type(2)));
typedef float f32x2 __attribute__((ext_vector_type(2)));
typedef float f32x4 __attribute__((ext_vector_type(4)));
typedef float f32x16 __attribute__((ext_vector_type(16)));
typedef short bf16x8 __attribute__((ext_vector_type(8)));
typedef GAS unsigned gu32;

constexpr int D = 1024, NB = 4, SEQ = 8192, M = NB * SEQ, NMETA = 16;
constexpr int ATW = 512, NH = 8, HD = 64, SW = 512, NG = 32, GC = 16, NP = 64, INC = 4096;
constexpr int NE = 32, FF = 512;
constexpr int LPB = 8224;
constexpr int KT_ROWS = 66;
constexpr int MAXRB = 288;
constexpr float RMS_EPS = 1e-6f;
constexpr float QSCALE = 0.125f * 1.4426950408889634f;

constexpr size_t MiB = 1u << 20;
constexpr size_t WS_CTL = 0, CTL_ZERO_BYTES = 64 * 1024;
constexpr size_t WS_SMALL = 1 * MiB;
constexpr size_t SM_RSTD1 = WS_SMALL;
constexpr size_t SM_RSTD2 = SM_RSTD1 + 128 * 1024;
constexpr size_t SM_EID = SM_RSTD2 + 128 * 1024;
constexpr size_t SM_GATE = SM_EID + 256 * 1024;
constexpr size_t SM_CNT = SM_GATE + 256 * 1024;
constexpr size_t SM_UMETA = SM_CNT + 32 * 1024;
constexpr size_t SM_BBAR = SM_UMETA + 32 * 1024;
constexpr size_t SM_LBAR = SM_BBAR + 256 * 1024;
constexpr size_t SM_L64 = SM_LBAR + 16 * 1024;
constexpr size_t SM_SDST = SM_L64 + 16 * 1024;
constexpr size_t SM_SGATE = SM_SDST + 288 * 1024;
constexpr size_t SM_SRS = SM_SGATE + 288 * 1024;
constexpr size_t SM_WR = SM_SRS + 288 * 1024;
constexpr size_t SM_RB = SM_WR + 256 * 1024;
constexpr size_t SM_MOEMETA = SM_RB + 1024;
constexpr size_t SM_METAP = SM_MOEMETA + 4096;
constexpr size_t SM_SSQP = 4 * MiB;
static_assert(SM_METAP + 8 * 16 * 1536 * 4 <= SM_SSQP, "small map");
constexpr size_t WS_WIN = 6 * MiB;
constexpr size_t WS_WPAB = 14 * MiB;
constexpr size_t WS_WO = 16 * MiB;
constexpr size_t WS_GLU = 18 * MiB;
constexpr size_t WS_KT = 19 * MiB;
constexpr size_t WS_T2 = 21 * MiB;
constexpr size_t WS_T3 = 29 * MiB;
constexpr size_t WS_WUP = 37 * MiB;
constexpr size_t WS_W2 = 101 * MiB;
constexpr size_t WS_XB = 133 * MiB;
constexpr size_t WS_Y = 133 * MiB;
constexpr size_t WS_S = 165 * MiB;
constexpr size_t WS_XS = 173 * MiB;
constexpr size_t WS_Q = 197 * MiB;
constexpr size_t WS_SSM = 229 * MiB;
constexpr size_t WS_K = 261 * MiB;
constexpr size_t WS_VT = 295 * MiB;
constexpr size_t WS_UG = 329 * MiB;
constexpr size_t WS_SG = 361 * MiB;
constexpr size_t WS_H1B = 361 * MiB;
constexpr size_t WS_H1B8 = 425 * MiB;
constexpr size_t WS_HID = 277 * MiB;
constexpr size_t WS_YB = 133 * MiB;
constexpr size_t WS_INV = 489 * MiB;
constexpr size_t WS_MWG = 502 * MiB;
constexpr size_t WS_END = 503 * MiB;
constexpr int CAPE = 32768;
constexpr int CW_TOT = 8192;

constexpr int CW_BAR = 4096;

constexpr int RING_OFF = 0, RING_BYTES = 131072;
constexpr int P0_SCR = 16896;
constexpr int LDSCTL_OFF = 8 * P0_SCR, MISC_OFF = LDSCTL_OFF + 320;
static_assert(LDSCTL_OFF >= RING_BYTES, "lds map");
constexpr int LDS_BYTES = 147456;
constexpr int ROWTOK_OFF = 8 * 16896 + 512;
static_assert(ROWTOK_OFF + 5 * 256 * 4 <= LDS_BYTES, "lds map");
constexpr int NWAVES = 8;

#define LDS_WAIT() asm volatile("s_waitcnt lgkmcnt(0)" ::: "memory")
#define VM_WAIT() asm volatile("s_waitcnt vmcnt(0)" ::: "memory")

typedef __bf16 bf16x2_t __attribute__((ext_vector_type(2)));
__device__ __forceinline__ unsigned cvt_pk_bf16(float lo, float hi) { bf16x2_t v; v[0] = (__bf16)lo; v[1] = (__bf16)hi; return __builtin_bit_cast(unsigned, v); }
__device__ __forceinline__ float bf2f(unsigned short b) { return __builtin_bit_cast(float, (unsigned)b << 16); }
__device__ __forceinline__ float bflo(unsigned w) { return __builtin_bit_cast(float, w << 16); }
__device__ __forceinline__ float bfhi(unsigned w) { return __builtin_bit_cast(float, w & 0xffff0000u); }
__device__ __forceinline__ float fast_sigmoid(float x) { return __builtin_amdgcn_rcpf(1.0f + __expf(-x)); }
__device__ __forceinline__ float shx(float v, int k, int lane) { return __builtin_bit_cast(float, __builtin_amdgcn_ds_bpermute((lane ^ k) << 2, __builtin_bit_cast(int, v))); }
__device__ __forceinline__ float wave_sum(float v, int lane) {
#pragma unroll
    for (int o = 1; o < 64; o <<= 1) v += shx(v, o, lane);
    return v;
}

#define XB_TMO      128
#define XB_XCNT(j)  (256  + 64 * (j))
#define XB_XSUB(j)  (1280 + 64 * (j))
#define XB_XGEN(j)  (2304 + 64 * (j))
#define XB_TOP      3328
#define XB_TOPGEN   3392
#define XCD_BAR_WORDS 3456
static_assert((size_t)(CW_BAR + XCD_BAR_WORDS) * 4 <= CTL_ZERO_BYTES && (size_t)(CW_TOT + 32) * 4 <= CTL_ZERO_BYTES, "zeroed control region");
#define XB_SPIN_CAP (1u << 18)
__device__ __forceinline__ unsigned xb_ld(unsigned* p)              { return __hip_atomic_load(p, __ATOMIC_RELAXED, __HIP_MEMORY_SCOPE_AGENT); }
__device__ __forceinline__ unsigned xb_add(unsigned* p, unsigned v) { return __hip_atomic_fetch_add(p, v, __ATOMIC_RELAXED, __HIP_MEMORY_SCOPE_AGENT); }
__device__ __forceinline__ unsigned xb_xcc_id() { return (unsigned)__builtin_amdgcn_s_getreg((3 << 11) | 20) & 0xFu; }
#define XB_SPIN(cond, bar) do { unsigned _sp = 0; while (cond) { __builtin_amdgcn_s_sleep(1); \
    if ((++_sp & 255u) == 0u) { if (xb_ld(&(bar)[XB_TMO])) break; if (_sp > XB_SPIN_CAP) { atomicAdd(&(bar)[XB_TMO], 1u); break; } } } } while (0)
struct XcdBarrier { unsigned* bar; unsigned x; volatile LAS unsigned* st; };
__device__ __forceinline__ XcdBarrier xcd_barrier_post(unsigned* bar, volatile LAS unsigned* st) {
    XcdBarrier b; b.bar = bar; b.x = (unsigned)__builtin_amdgcn_readfirstlane((int)xb_xcc_id()); b.st = st;
    if (threadIdx.x == 0) (void)xb_add(&bar[XB_XCNT(b.x)], 1u);
    return b;
}
__device__ __forceinline__ void xcd_barrier_complete(unsigned* bar, unsigned x, unsigned& nloc, unsigned& nx) {
    const unsigned G = gridDim.x * gridDim.y * gridDim.z;
    unsigned sum, cnt, mine, sp = 0u;
    for (;;) {
        sum = 0u; cnt = 0u; mine = 0u;
#pragma unroll
        for (unsigned j = 0; j < 16; ++j) { const unsigned c = xb_ld(&bar[XB_XCNT(j)]); sum += c; cnt += (c > 0u) ? 1u : 0u; mine = (j == x) ? c : mine; }
        if (sum == G) break;
        __builtin_amdgcn_s_sleep(1);
        if ((++sp & 255u) == 0u) { if (xb_ld(&bar[XB_TMO])) break; if (sp > XB_SPIN_CAP) { atomicAdd(&bar[XB_TMO], 1u); break; } }
    }
    nloc = mine > 0u ? mine : 1u; nx = cnt > 0u ? cnt : 1u;
}
__device__ __forceinline__ void xcd_barrier(const XcdBarrier& b) {
    asm volatile("s_waitcnt vmcnt(0)" ::: "memory");
    __syncthreads();
    if (threadIdx.x == 0) {
        unsigned* bar = b.bar; asm volatile("" : "+s"(bar));
        __builtin_amdgcn_s_waitcnt(0);
        unsigned bx = b.x; asm volatile("" : "+s"(bx));
        const unsigned osub = (unsigned)__builtin_amdgcn_readfirstlane((int)XB_XSUB(bx)), ogen = (unsigned)__builtin_amdgcn_readfirstlane((int)XB_XGEN(bx));
        unsigned nloc = b.st[0], nx = b.st[1];
        if (nloc == 0u) { xcd_barrier_complete(bar, bx, nloc, nx); b.st[0] = nloc; b.st[1] = nx; }
        const unsigned old = xb_add(&bar[osub], 1u);
        const unsigned gen = old / nloc;
        if (old + 1u == (gen + 1u) * nloc) {
            __builtin_amdgcn_fence(__ATOMIC_RELEASE, "agent");
            asm volatile("s_waitcnt vmcnt(0)" ::: "memory");
            const unsigned og = xb_add(&bar[XB_TOP], 1u);
            const unsigned tg = og / nx;
            if (og + 1u == (tg + 1u) * nx) xb_add(&bar[XB_TOPGEN], 1u);
            else XB_SPIN(xb_ld(&bar[XB_TOPGEN]) == tg, bar);
            __builtin_amdgcn_fence(__ATOMIC_ACQUIRE, "agent");
            xb_add(&bar[ogen], 1u);
            asm volatile("s_waitcnt vmcnt(0)" ::: "memory");
        } else {
            XB_SPIN(xb_ld(&bar[ogen]) == gen, bar);
            __builtin_amdgcn_fence(__ATOMIC_ACQUIRE, "agent");
            asm volatile("s_waitcnt vmcnt(0)" ::: "memory");
        }
    }
    __syncthreads();
}

namespace pg8 {
typedef int pg8_v4i __attribute__((ext_vector_type(4)));
typedef int pg8_v8i __attribute__((ext_vector_type(8)));
constexpr int BM = 256, BK = 64, HALF = 128, HTB = HALF * BK * 2, STAGE_BYTES = 8 * HTB, NXCD = 8, WGM = 4;
__host__ __device__ __forceinline__ int lds_byte(int r, int c) { const int st = (r >> 4) * 2 + (c >> 5), rr = r & 15, cc = c & 31, ob = rr * 64 + cc * 2; return st * 1024 + (ob ^ (((ob >> 9) & 1) << 5)); }
__host__ __device__ __forceinline__ void stage_rc(int b, int& R, int& C) { const int st = b / 1024, sb = b % 1024, swz = sb ^ (((sb >> 9) & 1) << 5); R = (st >> 1) * 16 + swz / 64; C = (st & 1) * 32 + (swz % 64) / 2; }
__host__ __device__ __forceinline__ int perm32(int rho) { const int n = rho >> 4, i = rho & 15; return 8 * (i >> 2) + 4 * n + (i & 3); }
struct Unit { int pm, pn; };
struct StaticOrder {
    int nM, nN, nwg, G, c, wgm;
    __host__ __device__ void init(int nM_, int nN_, int G_, int c_, int wgm_ = WGM) { nM = nM_; nN = nN_; nwg = nM * nN; G = G_; c = c_; wgm = wgm_; }
    __host__ __device__ bool next(int i, Unit& u) const {
        const long L = (long)i * G + c; if (L >= nwg) return false;
        int wgid = (int)L; { const int q = nwg / NXCD, r = nwg % NXCD, xcd = wgid % NXCD, off = wgid / NXCD; wgid = (xcd < r ? xcd * (q + 1) : r * (q + 1) + (xcd - r) * q) + off; }
        const int nig = wgm * nN, gid = wgid / nig, fm = gid * wgm, gsz = (nM - fm) < wgm ? (nM - fm) : wgm;
        u.pm = fm + ((wgid % nig) % gsz); u.pn = (wgid % nig) / gsz; return true;
    }
};
template <class Epi, class Sched, bool ALIGN_EPI, bool GATHER = false, bool KS = false, bool F8 = false>
__device__ __forceinline__ void gemm_phase(LAS unsigned char* lds, const int K, const Sched& S, const Epi& E, const int sc_wa = 0x7f7f) {
    int tid = threadIdx.x; asm volatile("" : "+v"(tid));
    const int wid = __builtin_amdgcn_readfirstlane(tid >> 6), lane = tid & 63, wr = wid >> 2, wc = wid & 3, fr = lane & 15, fq = lane >> 4;
    const int nt = KS ? 16 : K / BK;
    unsigned voffA[2], voffB[2]; int Rr[2], Cc[2];
#pragma unroll
    for (int i = 0; i < 2; ++i) { int R, C; stage_rc(tid * 16 + i * 8192, R, C); const int Rb = Epi::PERM ? ((R & ~31) + perm32(R & 31)) : R; Rr[i] = R; Cc[i] = C;
        voffA[i] = (unsigned)(R * K + C) * 2u; voffB[i] = (unsigned)(Rb * K + C) * 2u; }
    unsigned gA[2][2], gAn[2][2];
#pragma unroll
    for (int h2 = 0; h2 < 2; ++h2) { gA[h2][0] = gA[h2][1] = gAn[h2][0] = gAn[h2][1] = 0u; }
    const size_t kstep = (size_t)(BK * 2);
    const size_t hstep = (size_t)HALF * K * 2;
    const unsigned ldsw = (unsigned)wid * 1024u;
    const int aoff = lds_byte(wr * 64 + fr, fq * 8), boff = lds_byte(wc * 32 + fr, fq * 8);
#define PG8_SA(b, h) (((b) * 2 + (h)) * HTB)
#define PG8_SB(b, h) ((4 + (b) * 2 + (h)) * HTB)
#define PG8_STAGE(bufoff, gbase, voff) do { _Pragma("unroll") for (int _i = 0; _i < 2; ++_i) \
        __builtin_amdgcn_global_load_lds((const unsigned*)((const char*)(gbase) + (voff)[_i]), (LAS unsigned*)(lds + (bufoff) + ldsw + _i * 8192), 16, 0, 0); } while (0)
#define PG8_LD8(dst8, addr) do { const pg8_v4i lo_ = *(const LAS pg8_v4i*)(addr), hi_ = *(const LAS pg8_v4i*)((addr) + 1024); dst8 = __builtin_shufflevector(lo_, hi_, 0, 1, 2, 3, 4, 5, 6, 7); } while (0)
#define PG8_LDA(dst, b, h) do { if constexpr (F8) { _Pragma("unroll") for (int m = 0; m < 4; ++m) PG8_LD8(dst##8[m], lds + PG8_SA(b, h) + aoff + m * 2048); } \
        else { _Pragma("unroll") for (int m = 0; m < 4; ++m) _Pragma("unroll") for (int k = 0; k < 2; ++k) dst[m][k] = *(const LAS bf16x8*)(lds + PG8_SA(b, h) + aoff + m * 2048 + k * 1024); } } while (0)
#define PG8_LDB(dst, b, h) do { if constexpr (F8) { _Pragma("unroll") for (int n = 0; n < 2; ++n) PG8_LD8(dst##8[n], lds + PG8_SB(b, h) + boff + n * 2048); } \
        else { _Pragma("unroll") for (int n = 0; n < 2; ++n) _Pragma("unroll") for (int k = 0; k < 2; ++k) dst[n][k] = *(const LAS bf16x8*)(lds + PG8_SB(b, h) + boff + n * 2048 + k * 1024); } } while (0)
#define PG8_MMA(ai, bj, At, Bt) do { __builtin_amdgcn_s_setprio(1); _Pragma("unroll") for (int m = 0; m < 4; ++m) _Pragma("unroll") for (int n = 0; n < 2; ++n) { \
        if constexpr (F8) { acc[ai][bj][m][n] = __builtin_amdgcn_mfma_scale_f32_16x16x128_f8f6f4(Bt##8[n], At##8[m], acc[ai][bj][m][n], 0, 0, 0, sc_wa, 1, sc_wa); } \
        else { _Pragma("unroll") for (int k = 0; k < 2; ++k) acc[ai][bj][m][n] = __builtin_amdgcn_mfma_f32_16x16x32_bf16(Bt[n][k], At[m][k], acc[ai][bj][m][n], 0, 0, 0); } } \
        if constexpr (F8) asm volatile("" : "+v"(acc[ai][bj][0][0]), "+v"(acc[ai][bj][0][1]), "+v"(acc[ai][bj][1][0]), "+v"(acc[ai][bj][1][1]), "+v"(acc[ai][bj][2][0]), "+v"(acc[ai][bj][2][1]), "+v"(acc[ai][bj][3][0]), "+v"(acc[ai][bj][3][1]));   \
        __builtin_amdgcn_s_setprio(0); } while (0)
#define PG8_WAIT_V(n) asm volatile("s_waitcnt vmcnt(" #n ")" ::: "memory")
#define PG8_WAIT_L(n) asm volatile("s_waitcnt lgkmcnt(" #n ")" ::: "memory")
#define PG8_BAR __builtin_amdgcn_s_barrier()
#define PG8_SCHED __builtin_amdgcn_sched_barrier(0)
    Unit cur, nxt; int ui = 0;
    if (!S.next(0, cur)) return;
    f32x4 acc[2][2][4][2];
#pragma unroll
    for (int a = 0; a < 2; ++a)
#pragma unroll
        for (int b = 0; b < 2; ++b)
#pragma unroll
            for (int m = 0; m < 4; ++m)
#pragma unroll
                for (int n = 0; n < 2; ++n) acc[a][b][m][n] = (f32x4){0.f, 0.f, 0.f, 0.f};
    if constexpr (F8) {
#pragma unroll
        for (int a = 0; a < 2; ++a)
#pragma unroll
            for (int b = 0; b < 2; ++b)
#pragma unroll
                for (int m = 0; m < 4; ++m)
#pragma unroll
                    for (int n = 0; n < 2; ++n) asm volatile("" : "+v"(acc[a][b][m][n]));
    }
    bf16x8 At[4][2], B0[2][2], B1[2][2];
    pg8_v8i At8[4], B08[2], B18[2];
    const char* cA = S.aptr(cur); const char* cB = S.bptr(cur);
    if constexpr (GATHER) { S.gather(cur, Rr, Cc, K, gA); }
#define PG8_STAGE_A(bufoff, h, ko, usenext) PG8_STAGE_A2(bufoff, h, cA, ko, usenext)
#define PG8_STAGE_A2(bufoff, h, cur_base, ko, usenext) do { if constexpr (GATHER) { unsigned _v[2] = { (usenext) ? gAn[h][0] : gA[h][0], (usenext) ? gAn[h][1] : gA[h][1] }; PG8_STAGE(bufoff, cA + (ko), _v); } \
        else { PG8_STAGE(bufoff, ((usenext) ? nA : (cur_base)) + (size_t)(h) * hstep + (ko), voffA); } } while (0)
    { const char* nA = cA; (void)nA;
    PG8_STAGE(PG8_SB(0, 0), cB, voffB); PG8_STAGE(PG8_SB(0, 1), cB + hstep, voffB); PG8_STAGE_A(PG8_SA(0, 0), 0, 0, false); PG8_STAGE_A(PG8_SA(0, 1), 1, 0, false);
    if (wr == 1) PG8_BAR;
    PG8_WAIT_V(2); PG8_BAR;
    PG8_STAGE(PG8_SB(1, 0), cB + kstep, voffB); PG8_STAGE_A(PG8_SA(1, 0), 0, kstep, false); PG8_STAGE(PG8_SB(1, 1), cB + hstep + kstep, voffB);
    PG8_WAIT_V(6); PG8_BAR; }
    for (;;) {
        { int tid2 = threadIdx.x; asm volatile("" : "+v"(tid2));
#pragma unroll
          for (int i = 0; i < 2; ++i) { int R, C; stage_rc(tid2 * 16 + i * 8192, R, C); const int Rb = Epi::PERM ? ((R & ~31) + perm32(R & 31)) : R;
              voffA[i] = (unsigned)(R * K + C) * 2u; voffB[i] = (unsigned)(Rb * K + C) * 2u; } }
        const bool has_next = S.next(ui + 1, nxt);
        const char* nA = has_next ? S.aptr(nxt) : cA; const char* nB = has_next ? S.bptr(nxt) : cB;
        const char* dA = cA; const char* dB = cB; if constexpr (KS) { dA = S.aptr2(cur); dB = S.bptr2(cur); }
        if constexpr (GATHER) { if (has_next) S.gather(nxt, Rr, Cc, K, gAn); else {
#pragma unroll
            for (int h2 = 0; h2 < 2; ++h2) { gAn[h2][0] = gA[h2][0]; gAn[h2][1] = gA[h2][1]; } } }
#pragma unroll 1
        for (int t = 0; t < nt; t += 2) {
            const bool last = (t == nt - 2);
            const char* pa1 = (KS && t >= 8) ? dA : cA; const char* pa2 = (KS && t >= 6) ? dA : cA; const char* pb2 = (KS && t >= 6) ? dB : cB;
            const size_t ko1 = KS ? (size_t)((t + 1) & 7) * kstep : (size_t)(t + 1) * kstep;
            const size_t ko2 = last ? (size_t)0 : (KS ? (size_t)((t + 2) & 7) * kstep : (size_t)(t + 2) * kstep), ko3 = ko2 + kstep;
            const char* b2 = last ? nB : pb2 + ko2; const char* b3 = b2 + kstep;
            PG8_LDB(B0, 0, 0); PG8_LDB(B1, 0, 1); PG8_SCHED; PG8_LDA(At, 0, 0); PG8_STAGE_A2(PG8_SA(1, 1), 1, pa1, ko1, false);
            PG8_WAIT_V(8); PG8_WAIT_L(0); PG8_BAR; PG8_MMA(0, 0, At, B0); PG8_MMA(0, 1, At, B1); PG8_BAR; PG8_SCHED;
            PG8_LDA(At, 0, 1); PG8_STAGE(PG8_SB(0, 0), b2, voffB); PG8_STAGE(PG8_SB(0, 1), b2 + hstep, voffB); PG8_STAGE_A2(PG8_SA(0, 0), 0, pa2, ko2, last);
            PG8_WAIT_V(8); PG8_WAIT_L(0); PG8_BAR; PG8_MMA(1, 0, At, B0); PG8_MMA(1, 1, At, B1); PG8_BAR; PG8_SCHED;
            PG8_LDB(B0, 1, 0); PG8_LDB(B1, 1, 1); PG8_SCHED; PG8_LDA(At, 1, 0); PG8_STAGE_A2(PG8_SA(0, 1), 1, pa2, ko2, last);
            PG8_WAIT_V(8); PG8_WAIT_L(0); PG8_BAR; PG8_MMA(0, 0, At, B0); PG8_MMA(0, 1, At, B1); PG8_BAR; PG8_SCHED;
            PG8_LDA(At, 1, 1); PG8_STAGE(PG8_SB(1, 0), b3, voffB); PG8_STAGE(PG8_SB(1, 1), b3 + hstep, voffB); PG8_STAGE_A2(PG8_SA(1, 0), 0, pa2, ko3, last);
            PG8_WAIT_V(8); PG8_WAIT_L(0); PG8_BAR; PG8_MMA(1, 0, At, B0); PG8_MMA(1, 1, At, B1); PG8_BAR; PG8_SCHED;
            if constexpr (KS) { if (t == 6) { int efr = fr, efq = fq; asm volatile("" : "+v"(efr), "+v"(efq)); E.mid(acc, cur, wr, wc, efr, efq); } }
        }
        if constexpr (ALIGN_EPI) { if (wr == 0) PG8_BAR; }
        { int efr = fr, efq = fq; asm volatile("" : "+v"(efr), "+v"(efq));
          E(acc, cur, wr, wc, efr, efq); }
        if (!has_next) break;
#pragma unroll
        for (int a = 0; a < 2; ++a)
#pragma unroll
            for (int b = 0; b < 2; ++b)
#pragma unroll
                for (int m = 0; m < 4; ++m)
#pragma unroll
                    for (int n = 0; n < 2; ++n) { acc[a][b][m][n] = (f32x4){0.f, 0.f, 0.f, 0.f}; if constexpr (F8) asm volatile("" : "+v"(acc[a][b][m][n])); }
        cur = nxt; cA = nA; cB = nB; ++ui;
        if constexpr (GATHER) {
#pragma unroll
            for (int h2 = 0; h2 < 2; ++h2) { gA[h2][0] = gAn[h2][0]; gA[h2][1] = gAn[h2][1]; } }
        if constexpr (ALIGN_EPI) { if (wr == 1) PG8_BAR; }
    }
    PG8_WAIT_V(0);
    if constexpr (!ALIGN_EPI) { if (wr == 0) PG8_BAR; }
    PG8_BAR;
#undef PG8_SA
#undef PG8_SB
#undef PG8_STAGE
#undef PG8_STAGE_A
#undef PG8_STAGE_A2
#undef PG8_LDA
#undef PG8_LD8
#undef PG8_LDB
#undef PG8_MMA
#undef PG8_WAIT_V
#undef PG8_WAIT_L
#undef PG8_BAR
#undef PG8_SCHED
}
}
using pg8::Unit;

struct Args { const float* in[26]; float* out; unsigned char* ws; };
struct Frame {
    LAS unsigned char* lds;
    volatile LAS unsigned* MISC;
    int tid, lane, wave, vcu, G;
};

struct GOrder {
    pg8::StaticOrder so; const char* A; const char* B; size_t ta, tb;
    __device__ __forceinline__ bool next(int i, Unit& u) const { return so.next(i, u); }
    __device__ __forceinline__ const char* aptr(const Unit& u) const { return A + (size_t)u.pm * ta; }
    __device__ __forceinline__ const char* bptr(const Unit& u) const { return B + (size_t)u.pn * tb; }
};
struct P1Order {
    pg8::StaticOrder so; const char* X; const char* W; size_t t;
    __device__ __forceinline__ bool next(int i, Unit& u) const { return so.next(i, u); }
    __device__ __forceinline__ const char* aptr(const Unit& u) const { return (u.pn == 4 || u.pn == 5) ? W + (size_t)u.pn * t : X + (size_t)u.pm * t; }
    __device__ __forceinline__ const char* bptr(const Unit& u) const { return (u.pn == 4 || u.pn == 5) ? X + (size_t)u.pm * t : W + (size_t)u.pn * t; }
};
struct MergeOrder {
    pg8::StaticOrder so; const char* A; const char* B; size_t ta, tb;
    __device__ __forceinline__ bool next(int i, Unit& u) const { return so.next(i, u); }
    __device__ __forceinline__ const char* aptr(const Unit& u) const { return A + (size_t)u.pm * ta; }
    __device__ __forceinline__ const char* aptr2(const Unit& u) const { return A + (size_t)(u.pm + 128) * ta; }
    __device__ __forceinline__ const char* bptr(const Unit& u) const { return B + (size_t)u.pn * tb; }
    __device__ __forceinline__ const char* bptr2(const Unit& u) const { return B + (size_t)(u.pn + 4) * tb; }
};
struct MoeOrder {
    const int* meta; int G, c; const char* A; const char* B; size_t ta, tb;
    __device__ __forceinline__ bool next(int i, Unit& u) const {
        const int nrb = __builtin_amdgcn_readfirstlane(meta[0]);
        const int rb = i * 64 + (c & 7) * 8 + (c >> 5);
        if (rb >= nrb) return false;
        const int e = __builtin_amdgcn_readfirstlane(meta[16 + rb]);
        u.pm = rb; u.pn = e * 4 + ((c >> 3) & 3); return true;
    }
    __device__ __forceinline__ const char* aptr(const Unit& u) const { return A + (size_t)u.pm * ta; }
    __device__ __forceinline__ const char* bptr(const Unit& u) const { return B + (size_t)u.pn * tb; }
};

struct MoeOrderG {
    const int* meta; const LAS int* rowtok; int G, c; const char* A; const char* B; size_t tb;
    __device__ __forceinline__ bool next(int i, Unit& u) const {
        const int nrb = __builtin_amdgcn_readfirstlane(meta[0]);
        const int rb = i * 64 + (c & 7) * 8 + (c >> 5);
        if (rb >= nrb) return false;
        const int e = __builtin_amdgcn_readfirstlane(meta[16 + rb]);
        u.pm = rb; u.pn = e * 4 + ((c >> 3) & 3); return true;
    }
    __device__ __forceinline__ const char* aptr(const Unit&) const { return A; }
    __device__ __forceinline__ const char* bptr(const Unit& u) const { return B + (size_t)u.pn * tb; }
    __device__ __forceinline__ void gather(const Unit& u, const int (&Rr)[2], const int (&Cc)[2], int K, unsigned (&v)[2][2]) const {
        const LAS int* t = rowtok + (u.pm >> 6) * 256;
#pragma unroll
        for (int h = 0; h < 2; ++h)
#pragma unroll
            for (int i = 0; i < 2; ++i) v[h][i] = ((unsigned)t[h * 128 + Rr[i]] * (unsigned)K + (unsigned)Cc[i]) * 2u;
    }
};

#define EPI_ARGS const f32x4 (&acc)[2][2][4][2], const Unit& u, int wr, int wc, int fr, int fq
__device__ __forceinline__ v4u pack8(f32x4 a, f32x4 b) { v4u w; w.x = cvt_pk_bf16(a[0], a[1]); w.y = cvt_pk_bf16(a[2], a[3]); w.z = cvt_pk_bf16(b[0], b[1]); w.w = cvt_pk_bf16(b[2], b[3]); return w; }

struct EpiIn {
    static constexpr bool PERM = true;
    bf16 *Q, *Kb, *VT, *UG; unsigned char* SG; const float* rstd;
    __device__ __forceinline__ void operator()(EPI_ARGS) const {
        const int pn = u.pn;
        if (pn == 4 || pn == 5) {
#pragma unroll
            for (int bj = 0; bj < 2; ++bj) {
                const int t0 = u.pm * 256 + bj * 128 + wc * 32 + 8 * fq; const int b = t0 >> 13, i0 = t0 & 8191;
                const f32x4 rs0 = *(const f32x4*)(rstd + t0), rs1 = *(const f32x4*)(rstd + t0 + 4);
#pragma unroll
                for (int ai = 0; ai < 2; ++ai)
#pragma unroll
                    for (int m = 0; m < 4; ++m) {
                        const int vr = (pn - 4) * 256 + ai * 128 + wr * 64 + m * 16 + fr;
                        bf16* dst = VT + ((size_t)(b * 512 + vr)) * LPB + 32 + i0;
                        *(v4u*)dst = pack8(acc[ai][bj][m][0] * rs0, acc[ai][bj][m][1] * rs1);
                    }
            }
        } else {
#pragma unroll
            for (int ai = 0; ai < 2; ++ai)
#pragma unroll
                for (int m = 0; m < 4; ++m) {
                    const int row = u.pm * 256 + ai * 128 + wr * 64 + m * 16 + fr; const float rs = rstd[row];
#pragma unroll
                    for (int bj = 0; bj < 2; ++bj) {
                        const int col0 = pn * 256 + bj * 128 + wc * 32 + 8 * fq;
                        f32x4 v0 = acc[ai][bj][m][0] * rs, v1 = acc[ai][bj][m][1] * rs;
                        if (pn < 2) { *(v4u*)(Q + (size_t)row * 512 + col0) = pack8(v0 * QSCALE, v1 * QSCALE); }
                        else if (pn < 4) { const int b = row >> 13, i = row & 8191; *(v4u*)(Kb + ((size_t)(b * LPB + 32 + i)) * 512 + (col0 - 512)) = pack8(v0, v1); }
                        else if (pn < 8) { const int c = col0 - 1536; const int mrow = row >> 6;
                            *(v4u*)(UG + ((((size_t)((c >> 4) * 16 + (mrow >> 5)) * 64 + (row & 63)) * 2 + ((c & 15) >> 3)) * 32 + (mrow & 31)) * 8) = pack8(v0, v1); }
                        else {
                            unsigned g0 = 0u, g1 = 0u;
#pragma unroll
                            for (int e = 0; e < 4; ++e) { g0 = __builtin_amdgcn_cvt_pk_u8_f32(floorf(fast_sigmoid(v0[e]) * 256.0f), e, g0); g1 = __builtin_amdgcn_cvt_pk_u8_f32(floorf(fast_sigmoid(v1[e]) * 256.0f), e, g1); }
                            *(v2u*)(SG + (size_t)row * 2048 + (col0 - 2048)) = (v2u){g0, g1};
                        }
                    }
                }
        }
    }
};

struct EpiGlu {
    static constexpr bool PERM = true;
    const bf16* Y; bf16* O; const float* bias;
    __device__ __forceinline__ void operator()(EPI_ARGS) const {
#pragma unroll
        for (int bj = 0; bj < 2; ++bj) {
            const int col0 = u.pn * 256 + bj * 128 + wc * 32 + 8 * fq;
            const f32x4 b0 = *(const f32x4*)(bias + col0), b1 = *(const f32x4*)(bias + col0 + 4);
#pragma unroll
            for (int ai = 0; ai < 2; ++ai)
#pragma unroll
                for (int m = 0; m < 4; ++m) {
                    const int row = u.pm * 256 + ai * 128 + wr * 64 + m * 16 + fr;
                    const v4u yv = *(const v4u*)(Y + (size_t)row * 512 + col0);
                    f32x4 v0 = acc[ai][bj][m][0] + b0, v1 = acc[ai][bj][m][1] + b1;
                    v0[0] = bflo(yv.x) * fast_sigmoid(v0[0]); v0[1] = bfhi(yv.x) * fast_sigmoid(v0[1]); v0[2] = bflo(yv.y) * fast_sigmoid(v0[2]); v0[3] = bfhi(yv.y) * fast_sigmoid(v0[3]);
                    v1[0] = bflo(yv.z) * fast_sigmoid(v1[0]); v1[1] = bfhi(yv.z) * fast_sigmoid(v1[1]); v1[2] = bflo(yv.w) * fast_sigmoid(v1[2]); v1[3] = bfhi(yv.w) * fast_sigmoid(v1[3]);
                    *(v4u*)(O + (size_t)row * 512 + col0) = pack8(v0, v1);
                }
        }
    }
};

struct EpiMerge {
    static constexpr bool PERM = true;
    const unsigned char* SG; bf16* O;
    static __device__ __forceinline__ float gq(unsigned w, int i) { return (float)((w >> (8 * i)) & 0xffu) + 0.5f; }
    __device__ __forceinline__ void mid(f32x4 (&acc)[2][2][4][2], const Unit& u, int wr, int wc, int fr, int fq) const {
#pragma unroll
        for (int ai = 0; ai < 2; ++ai)
#pragma unroll
            for (int m = 0; m < 4; ++m) {
                const int row = u.pm * 256 + ai * 128 + wr * 64 + m * 16 + fr;
#pragma unroll
                for (int bj = 0; bj < 2; ++bj) {
                    const int col0 = u.pn * 256 + bj * 128 + wc * 32 + 8 * fq;
                    const v2u ga = *(const v2u*)(SG + (size_t)row * 2048 + col0), gb = *(const v2u*)(SG + (size_t)row * 2048 + 1024 + col0);
                    f32x4& v0 = acc[ai][bj][m][0]; f32x4& v1 = acc[ai][bj][m][1];
#pragma unroll
                    for (int e = 0; e < 4; ++e) { v0[e] *= gq(ga.x, e) * __builtin_amdgcn_rcpf(gq(gb.x, e)); v1[e] *= gq(ga.y, e) * __builtin_amdgcn_rcpf(gq(gb.y, e)); }
                }
            }
    }
    __device__ __forceinline__ void operator()(EPI_ARGS) const {
#pragma unroll
        for (int ai = 0; ai < 2; ++ai)
#pragma unroll
            for (int m = 0; m < 4; ++m) {
                const int row = u.pm * 256 + ai * 128 + wr * 64 + m * 16 + fr;
#pragma unroll
                for (int bj = 0; bj < 2; ++bj) {
                    const int col0 = u.pn * 256 + bj * 128 + wc * 32 + 8 * fq;
                    const v2u g = *(const v2u*)(SG + (size_t)row * 2048 + 1024 + col0);
                    f32x4 v0 = acc[ai][bj][m][0], v1 = acc[ai][bj][m][1];
#pragma unroll
                    for (int e = 0; e < 4; ++e) { v0[e] *= gq(g.x, e) * 0.00390625f; v1[e] *= gq(g.y, e) * 0.00390625f; }
                    *(v4u*)(O + (size_t)row * 1024 + col0) = pack8(v0, v1);
                }
            }
    }
};

struct EpiOut {
    static constexpr bool PERM = true;
    const float* X; bf16* HB; unsigned char* HB8; float* ssqp;
    __device__ __forceinline__ void operator()(EPI_ARGS) const {
#pragma unroll
        for (int ai = 0; ai < 2; ++ai)
#pragma unroll
            for (int m = 0; m < 4; ++m) {
                const int row = u.pm * 256 + ai * 128 + wr * 64 + m * 16 + fr; float ss = 0.f;
#pragma unroll
                for (int bj = 0; bj < 2; ++bj) {
                    const int col0 = u.pn * 256 + bj * 128 + wc * 32 + 8 * fq;
                    const f32x4 x0 = *(const f32x4*)(X + (size_t)row * D + col0), x1 = *(const f32x4*)(X + (size_t)row * D + col0 + 4);
                    const f32x4 v0 = acc[ai][bj][m][0] + x0, v1 = acc[ai][bj][m][1] + x1;
                    *(v4u*)(HB + (size_t)row * D + col0) = pack8(v0, v1);
                    { int p0 = 0, p1 = 0;
                      p0 = __builtin_amdgcn_cvt_pk_fp8_f32(v0[0], v0[1], p0, false); p0 = __builtin_amdgcn_cvt_pk_fp8_f32(v0[2], v0[3], p0, true);
                      p1 = __builtin_amdgcn_cvt_pk_fp8_f32(v1[0], v1[1], p1, false); p1 = __builtin_amdgcn_cvt_pk_fp8_f32(v1[2], v1[3], p1, true);
                      *(v2u*)(HB8 + (size_t)row * D + col0) = (v2u){(unsigned)p0, (unsigned)p1}; }
                    ss += (v0[0] * v0[0] + v0[1] * v0[1]) + (v0[2] * v0[2] + v0[3] * v0[3]) + (v1[0] * v1[0] + v1[1] * v1[1]) + (v1[2] * v1[2] + v1[3] * v1[3]);
                }
                { const int ln = fq * 16 + fr; ss += shx(ss, 16, ln); ss += shx(ss, 32, ln); }
                if (fq == 0) ssqp[(size_t)row * 16 + u.pn * 4 + wc] = ss;
            }
    }
};

struct EpiUp {
    static constexpr bool PERM = true;
    const float* srs; unsigned char* HID;
    __device__ __forceinline__ void operator()(EPI_ARGS) const {
        const int pnl = u.pn & 3;
#pragma unroll
        for (int ai = 0; ai < 2; ++ai)
#pragma unroll
            for (int m = 0; m < 4; ++m) {
                const int slot = u.pm * 256 + ai * 128 + wr * 64 + m * 16 + fr; const float rs = srs[slot];
                f32x4 h0, h1;
#pragma unroll
                for (int e = 0; e < 4; ++e) {
                    const float a0 = acc[ai][0][m][0][e] * rs, c0 = acc[ai][1][m][0][e] * rs; h0[e] = a0 * fast_sigmoid(a0) * c0 * 4.0f;
                    const float a1 = acc[ai][0][m][1][e] * rs, c1 = acc[ai][1][m][1][e] * rs; h1[e] = a1 * fast_sigmoid(a1) * c1 * 4.0f;
                }
                int p0 = 0, p1 = 0;
                p0 = __builtin_amdgcn_cvt_pk_fp8_f32(h0[0], h0[1], p0, false); p0 = __builtin_amdgcn_cvt_pk_fp8_f32(h0[2], h0[3], p0, true);
                p1 = __builtin_amdgcn_cvt_pk_fp8_f32(h1[0], h1[1], p1, false); p1 = __builtin_amdgcn_cvt_pk_fp8_f32(h1[2], h1[3], p1, true);
                *(v2u*)(HID + (size_t)slot * FF + pnl * 128 + wc * 32 + 8 * fq) = (v2u){(unsigned)p0, (unsigned)p1};
            }
    }
};

struct EpiDown {
    static constexpr bool PERM = true;
    const int* sdst; const float* sgate; unsigned char* YB;
    __device__ __forceinline__ void operator()(EPI_ARGS) const {
        const int pnl = u.pn & 3;
#pragma unroll
        for (int ai = 0; ai < 2; ++ai)
#pragma unroll
            for (int m = 0; m < 4; ++m) {
                const int slot = u.pm * 256 + ai * 128 + wr * 64 + m * 16 + fr; const int dst = sdst[slot]; const float gt = sgate[slot] * 16.0f;
                if (dst >= 0) {
#pragma unroll
                    for (int bj = 0; bj < 2; ++bj) {
                        const f32x4 a = acc[ai][bj][m][0] * gt, c2 = acc[ai][bj][m][1] * gt; int p0 = 0, p1 = 0;
                        p0 = __builtin_amdgcn_cvt_pk_fp8_f32(a[0], a[1], p0, false); p0 = __builtin_amdgcn_cvt_pk_fp8_f32(a[2], a[3], p0, true);
                        p1 = __builtin_amdgcn_cvt_pk_fp8_f32(c2[0], c2[1], p1, false); p1 = __builtin_amdgcn_cvt_pk_fp8_f32(c2[2], c2[3], p1, true);
                        *(v2u*)(YB + ((unsigned)dst * (unsigned)D + (unsigned)(pnl * 256 + bj * 128 + wc * 32 + 8 * fq))) = (v2u){(unsigned)p0, (unsigned)p1};
                    }
                }
            }
    }
};

__device__ __forceinline__ void p0_transpose_block(const float* W, int N, int k0, int n0, bf16* dst, int ldk, const float* ksc, LAS float* scr, int lane) {
#pragma unroll 8
    for (int i = 0; i < 32; ++i) { const int kk = 2 * i + (lane >> 5); float v = W[(size_t)(k0 + kk) * N + n0 + (lane & 31)]; if (ksc) v *= ksc[k0 + kk]; scr[kk * 33 + (lane & 31)] = v; }
    LDS_WAIT(); asm volatile("" ::: "memory");
    const int c = lane & 7;
#pragma unroll
    for (int j = 0; j < 4; ++j) { const int n = (lane >> 3) + 8 * j; const LAS float* s = scr + (8 * c) * 33 + n;
        v4u o; o.x = cvt_pk_bf16(s[0 * 33], s[1 * 33]); o.y = cvt_pk_bf16(s[2 * 33], s[3 * 33]); o.z = cvt_pk_bf16(s[4 * 33], s[5 * 33]); o.w = cvt_pk_bf16(s[6 * 33], s[7 * 33]);
        *(v4u*)(dst + (size_t)n * ldk + k0 + 8 * c) = o; }
    LDS_WAIT(); asm volatile("" ::: "memory");
}


__device__ __forceinline__ float gelu_tanh(float x) { const float u = 0.7978845608028654f * (x + 0.044715f * x * x * x); return x * fast_sigmoid(2.0f * u); }
typedef unsigned short us4 __attribute__((ext_vector_type(4)));

__device__ __forceinline__ void attn_unit(const bf16* Qb, const bf16* Kb, const bf16* VT, bf16* Ob, int b, int head, int qb, int lane, LAS unsigned char* wl) {
    const int l31 = lane & 31, h = lane >> 5;
    const int row = b * SEQ + qb * 32 + l31;
    bf16x8 qf[4];
#pragma unroll
    for (int st = 0; st < 4; ++st) qf[st] = *(const bf16x8*)(Qb + (size_t)row * 512 + head * 64 + 16 * st + 8 * h);
    const int Pq0 = 16 + qb * 32, qpos = Pq0 + l31;
    f32x16 o0, o1;
#pragma unroll
    for (int r = 0; r < 16; ++r) { o0[r] = 0.f; o1[r] = 0.f; }
    float carry = 1.f;
    LAS unsigned char* kl = wl; LAS unsigned char* vl = wl + 32 * 144;
    const bf16* kg = Kb + ((size_t)b * LPB + 16 + (lane >> 3)) * 512 + head * 64 + (lane & 7) * 8;
    const bf16* vg = VT + ((size_t)(b * 512 + head * 64 + (lane >> 2))) * LPB + 16 + (lane & 3) * 8;
    const int kwo = (lane >> 3) * 144 + (lane & 7) * 16, vwo = (lane >> 2) * 72 + (lane & 3) * 16;
    v4u krx[4], vrx[4], kry[4], vry[4];
#define ATT_GLOAD(kr, vr, kbx) do { _Pragma("unroll") for (int i = 0; i < 4; ++i) { kr[i] = *(const v4u*)(kg + (long)((kbx) + 8 * i) * 512); vr[i] = *(const v4u*)(vg + (size_t)(16 * i) * LPB + (long)(kbx)); } } while (0)
#define ATT_STAGE(kr, vr) do { _Pragma("unroll") for (int i = 0; i < 4; ++i) { *(LAS v4u*)(kl + kwo + i * 8 * 144) = kr[i]; \
        *(LAS v2u*)(vl + vwo + i * 16 * 72) = (v2u){vr[i].x, vr[i].y}; *(LAS v2u*)(vl + vwo + i * 16 * 72 + 8) = (v2u){vr[i].z, vr[i].w}; } } while (0)
#define ATT_FRAGS(Sx, vax, vbx) do { bf16x8 kf_[4]; _Pragma("unroll") for (int st = 0; st < 4; ++st) kf_[st] = *(const LAS bf16x8*)(kl + l31 * 144 + st * 32 + 16 * h); \
        _Pragma("unroll") for (int db = 0; db < 2; ++db) _Pragma("unroll") for (int s2 = 0; s2 < 2; ++s2) { const LAS unsigned char* vp = vl + (db * 32 + l31) * 72 + (16 * s2 + 4 * h) * 2; vax[db][s2] = *(const LAS v2u*)vp; vbx[db][s2] = *(const LAS v2u*)(vp + 16); } \
        _Pragma("unroll") for (int r = 0; r < 16; ++r) Sx[r] = 0.f; \
        _Pragma("unroll") for (int st = 0; st < 4; ++st) Sx = __builtin_amdgcn_mfma_f32_32x32x16_bf16(kf_[st], qf[st], Sx, 0, 0, 0); } while (0)
#define ATT_TILE(Sx, vax, vbx, kbx) do { \
        float be[16], kp[16]; \
        const bool boundary = ((kbx) + 31 >= Pq0) || ((kbx) < 0);        \
        _Pragma("unroll") for (int r = 0; r < 16; ++r) { const float e = __builtin_amdgcn_exp2f(-Sx[r]); be[r] = __builtin_amdgcn_rcpf(1.0f + e); kp[r] = 1.0f - be[r]; } \
        if (boundary) { _Pragma("unroll") for (int r = 0; r < 16; ++r) { const int key = (kbx) + (r & 3) + 8 * (r >> 2) + 4 * h; const bool valid = (key < qpos) && (key >= 0); \
                be[r] = valid ? be[r] : 0.f; kp[r] = valid ? kp[r] : 1.f; } } \
        float gs[4], pg[4]; \
        _Pragma("unroll") for (int g = 0; g < 4; ++g) { gs[g] = (kp[4 * g] * kp[4 * g + 1]) * (kp[4 * g + 2] * kp[4 * g + 3]); pg[g] = shx(gs[g], 32, lane); } \
        float w[16]; float later = carry; \
        _Pragma("unroll") for (int g = 3; g >= 0; --g) { \
            const float p3 = later * (h == 0 ? pg[g] : 1.f); \
            const float p2 = p3 * kp[4 * g + 3], p1 = p2 * kp[4 * g + 2], p0 = p1 * kp[4 * g + 1]; \
            w[4 * g + 3] = be[4 * g + 3] * p3; w[4 * g + 2] = be[4 * g + 2] * p2; w[4 * g + 1] = be[4 * g + 1] * p1; w[4 * g] = be[4 * g] * p0; \
            later *= gs[g] * pg[g]; } \
        carry = later; \
        _Pragma("unroll") for (int s2 = 0; s2 < 2; ++s2) { \
            v4u wp; wp.x = cvt_pk_bf16(w[8 * s2], w[8 * s2 + 1]); wp.y = cvt_pk_bf16(w[8 * s2 + 2], w[8 * s2 + 3]); wp.z = cvt_pk_bf16(w[8 * s2 + 4], w[8 * s2 + 5]); wp.w = cvt_pk_bf16(w[8 * s2 + 6], w[8 * s2 + 7]); \
            const bf16x8 wf = __builtin_bit_cast(bf16x8, wp); \
            v4u v0; v0.x = vax[0][s2].x; v0.y = vax[0][s2].y; v0.z = vbx[0][s2].x; v0.w = vbx[0][s2].y; \
            v4u v1; v1.x = vax[1][s2].x; v1.y = vax[1][s2].y; v1.z = vbx[1][s2].x; v1.w = vbx[1][s2].y; \
            o0 = __builtin_amdgcn_mfma_f32_32x32x16_bf16(__builtin_bit_cast(bf16x8, v0), wf, o0, 0, 0, 0); \
            o1 = __builtin_amdgcn_mfma_f32_32x32x16_bf16(__builtin_bit_cast(bf16x8, v1), wf, o1, 0, 0, 0); } } while (0)
#define ATT_STEP(kr, vr, kbx) do { ATT_STAGE(kr, vr); const int kb2_ = ((kbx) - 64 > -32) ? (kbx) - 64 : (kbx); ATT_GLOAD(kr, vr, kb2_); \
        f32x16 S_; v2u va_[2][2], vb_[2][2]; ATT_FRAGS(S_, va_, vb_); ATT_TILE(S_, va_, vb_, kbx); } while (0)
    ATT_GLOAD(krx, vrx, Pq0);
    { const int kb1 = (Pq0 - 32 > -32) ? Pq0 - 32 : Pq0; ATT_GLOAD(kry, vry, kb1); }
    for (int kb = Pq0; ; kb -= 64) {
        ATT_STEP(krx, vrx, kb);
        if (__all(carry < 5.9604645e-8f)) break;
        if (!((kb - 32) > -32)) break;
        ATT_STEP(kry, vry, kb - 32);
        if (__all(carry < 5.9604645e-8f)) break;
        if (!((kb - 64) > -32)) break;
    }
#undef ATT_STEP
#undef ATT_TILE
#undef ATT_GLOAD
#undef ATT_STAGE
#undef ATT_FRAGS
    bf16* op = Ob + (size_t)row * 512 + head * 64 + 4 * h;
#pragma unroll
    for (int g = 0; g < 4; ++g) {
        v2u a; a.x = cvt_pk_bf16(o0[4 * g], o0[4 * g + 1]); a.y = cvt_pk_bf16(o0[4 * g + 2], o0[4 * g + 3]); *(v2u*)(op + 8 * g) = a;
        v2u d; d.x = cvt_pk_bf16(o1[4 * g], o1[4 * g + 1]); d.y = cvt_pk_bf16(o1[4 * g + 2], o1[4 * g + 3]); *(v2u*)(op + 32 + 8 * g) = d;
    }
}


struct Tr64 { const float* W; int N, k0, n0, ldk; bf16* dst; const float* ksc; int f8; float osc; };
__device__ __forceinline__ void tr64_load(const Tr64& t, f32x4 (&v)[16], int lane) {
    const float* p = t.W + (size_t)(t.k0 + (lane >> 4)) * t.N + t.n0 + 4 * (lane & 15);
#pragma unroll
    for (int i = 0; i < 16; ++i) v[i] = __builtin_nontemporal_load((const f32x4*)(p + (size_t)(4 * i) * t.N));
}
__device__ __forceinline__ void tr64_store(const Tr64& t, const f32x4 (&v)[16], LAS float* scr, int lane) {
    const int cch = lane & 7;
    f32x4 g0 = (f32x4){1.f, 1.f, 1.f, 1.f}, g1 = g0;
    if (t.ksc) { g0 = *(const f32x4*)(t.ksc + t.k0 + 8 * cch); g1 = *(const f32x4*)(t.ksc + t.k0 + 8 * cch + 4); }
    { LAS float* w = scr + (lane >> 4) * 65 + 4 * (lane & 15);
#pragma unroll
        for (int i = 0; i < 16; ++i) { w[(4 * i) * 65 + 0] = v[i][0]; w[(4 * i) * 65 + 1] = v[i][1]; w[(4 * i) * 65 + 2] = v[i][2]; w[(4 * i) * 65 + 3] = v[i][3]; } }
    LDS_WAIT(); asm volatile("" ::: "memory");
    if (t.f8) { g0 = g0 * t.osc; g1 = g1 * t.osc;
#pragma unroll
        for (int jj = 0; jj < 8; ++jj) { const int n = (lane >> 3) + 8 * jj; const LAS float* sp = scr + (8 * cch) * 65 + n; int p0 = 0, p1 = 0;
            p0 = __builtin_amdgcn_cvt_pk_fp8_f32(sp[0 * 65] * g0[0], sp[1 * 65] * g0[1], p0, false); p0 = __builtin_amdgcn_cvt_pk_fp8_f32(sp[2 * 65] * g0[2], sp[3 * 65] * g0[3], p0, true);
            p1 = __builtin_amdgcn_cvt_pk_fp8_f32(sp[4 * 65] * g1[0], sp[5 * 65] * g1[1], p1, false); p1 = __builtin_amdgcn_cvt_pk_fp8_f32(sp[6 * 65] * g1[2], sp[7 * 65] * g1[3], p1, true);
            *(v2u*)((unsigned char*)t.dst + (size_t)n * t.ldk + t.k0 + 8 * cch) = (v2u){(unsigned)p0, (unsigned)p1}; }
    } else {
#pragma unroll
    for (int jj = 0; jj < 8; ++jj) { const int n = (lane >> 3) + 8 * jj; const LAS float* sp = scr + (8 * cch) * 65 + n;
        v4u o; o.x = cvt_pk_bf16(sp[0 * 65] * g0[0], sp[1 * 65] * g0[1]); o.y = cvt_pk_bf16(sp[2 * 65] * g0[2], sp[3 * 65] * g0[3]);
        o.z = cvt_pk_bf16(sp[4 * 65] * g1[0], sp[5 * 65] * g1[1]); o.w = cvt_pk_bf16(sp[6 * 65] * g1[2], sp[7 * 65] * g1[3]);
        *(v4u*)(t.dst + (size_t)n * t.ldk + t.k0 + 8 * cch) = o; }
    }
    LDS_WAIT(); asm volatile("" ::: "memory");
}
constexpr int I_E1 = 32 * 16 * 8, I_E3 = I_E1, I_E2 = 32 * 8 * 16, NEX = I_E1 + I_E3 + I_E2;
__device__ __forceinline__ Tr64 expert_item(int r, const float* ew1, const float* ew3, const float* ew2, const float* g_ffn, bf16* WupT, bf16* W2T) {
    Tr64 t; t.f8 = 1;
    if (r < I_E1 + I_E3) { const int w3 = r >= I_E1; if (w3) r -= I_E1; const int e = r >> 7; t.k0 = 64 * ((r >> 3) & 15); t.n0 = 64 * (r & 7);
        const int drow = (t.n0 >> 7) * 256 + (t.n0 & 127) + (w3 ? 128 : 0);
        t.W = (w3 ? ew3 : ew1) + (size_t)e * D * FF; t.N = FF; t.dst = (bf16*)((unsigned char*)WupT + ((size_t)e * 1024 + drow) * 1024); t.ldk = 1024; t.ksc = g_ffn; t.osc = 32.0f; }
    else { r -= I_E1 + I_E3; const int e = r >> 7; t.k0 = 64 * ((r >> 4) & 7); t.n0 = 64 * (r & 15);
        t.W = ew2 + (size_t)e * FF * D; t.N = D; t.dst = (bf16*)((unsigned char*)W2T + ((size_t)e * 1024 + t.n0) * 512); t.ldk = 512; t.ksc = nullptr; t.osc = 16.0f; }
    return t;
}

__global__ void __launch_bounds__(NWAVES * 64, 2) fwd_kernel(Args args) {
    extern __shared__ __attribute__((aligned(16))) unsigned char lds_raw[];
    Frame F;
    F.lds = (LAS unsigned char*)lds_raw;
    F.MISC = (volatile LAS unsigned*)(F.lds + MISC_OFF);
    F.tid = threadIdx.x; F.lane = F.tid & 63; F.wave = __builtin_amdgcn_readfirstlane(F.tid >> 6);
    F.G = gridDim.x; { const int bx = blockIdx.x; F.vcu = (F.G % 8 == 0) ? (bx % 8) * (F.G / 8) + bx / 8 : bx; }
    unsigned char* ws = args.ws;
    gu32* ctl = (gu32*)(ws + WS_CTL);
    for (int u = F.tid; u < (LDS_BYTES - LDSCTL_OFF) / 4; u += NWAVES * 64) ((LAS unsigned*)(F.lds + LDSCTL_OFF))[u] = 0u;
    __syncthreads();
    XcdBarrier bar = xcd_barrier_post((unsigned*)(ctl + CW_BAR), F.MISC + 8);
    const int wave = F.wave, c = F.vcu;
    const int gw = c * NWAVES + wave, NGW = F.G * NWAVES;

    const float* x = args.in[0]; const float* meta_tok = args.in[1]; const float* g_mix = args.in[2]; const float* w_in = args.in[3];
    const float* lam_re = args.in[4]; const float* lam_im = args.in[5]; const float* log_dt = args.in[6];
    const float* b_re = args.in[7]; const float* b_im = args.in[8]; const float* c_re = args.in[9]; const float* c_im = args.in[10];
    const float* ssm_d = args.in[11]; const float* glu_w = args.in[12]; const float* glu_b = args.in[13];
    const float* w_pa = args.in[14]; const float* w_pb = args.in[15]; const float* w_out = args.in[16]; const float* g_ffn = args.in[17];
    const float* rg_w = args.in[18]; const float* rg_b = args.in[19]; const float* re_w = args.in[20]; const float* re_b = args.in[21];
    const float* ew1 = args.in[22]; const float* ew3 = args.in[23]; const float* ew2 = args.in[24]; const float* g_fin = args.in[25];
    float* out = args.out;
    float* rstd1 = (float*)(ws + SM_RSTD1); float* rstd2 = (float*)(ws + SM_RSTD2);
    int* eid = (int*)(ws + SM_EID); float* gatev = (float*)(ws + SM_GATE); int* cntg = (int*)(ws + SM_CNT);
    float* umeta = (float*)(ws + SM_UMETA); float* bbar_g = (float*)(ws + SM_BBAR); float* lbar_g = (float*)(ws + SM_LBAR); float* l64_g = (float*)(ws + SM_L64);
    int* sdst = (int*)(ws + SM_SDST); float* sgate = (float*)(ws + SM_SGATE); float* srs = (float*)(ws + SM_SRS);
    float* metapart = (float*)(ws + SM_METAP);
    bf16* wr_t = (bf16*)(ws + SM_WR); float* rbias = (float*)(ws + SM_RB); int* moemeta = (int*)(ws + SM_MOEMETA); float* ssqp = (float*)(ws + SM_SSQP);
    bf16* WinT = (bf16*)(ws + WS_WIN); bf16* WpabT = (bf16*)(ws + WS_WPAB); bf16* WoT = (bf16*)(ws + WS_WO); bf16* GluT = (bf16*)(ws + WS_GLU);
    bf16* KT = (bf16*)(ws + WS_KT); bf16* T2 = (bf16*)(ws + WS_T2); bf16* T3 = (bf16*)(ws + WS_T3);
    bf16* WupT = (bf16*)(ws + WS_WUP); bf16* W2T = (bf16*)(ws + WS_W2);
    unsigned char* XB = ws + WS_XB; bf16* MRG = (bf16*)(ws + WS_XB);
    bf16* Qb = (bf16*)(ws + WS_Q); bf16* SSMb = (bf16*)(ws + WS_SSM); bf16* Kb = (bf16*)(ws + WS_K); bf16* VT = (bf16*)(ws + WS_VT);
    bf16* UG = (bf16*)(ws + WS_UG); bf16* Yb = (bf16*)(ws + WS_Y); float* Sst = (float*)(ws + WS_S); bf16* Xs = (bf16*)(ws + WS_XS);
    bf16* H1B = (bf16*)(ws + WS_H1B); unsigned char* H1B8 = ws + WS_H1B8; unsigned char* HID = ws + WS_HID; unsigned char* YB = (unsigned char*)(ws + WS_YB);
    unsigned char* SG = ws + WS_SG;
    int* inv_tok = (int*)(ws + WS_INV); float* inv_gate = (float*)(ws + WS_INV + (size_t)NE * CAPE * 4); float* inv_rs = (float*)(ws + WS_INV + (size_t)2 * NE * CAPE * 4);
    int* mymeta = (int*)(ws + WS_MWG) + (size_t)blockIdx.x * 512; unsigned* etot = (unsigned*)(ctl + CW_TOT);

    for (int rep = 0; rep < REP_P0; ++rep) {
        int tid = threadIdx.x; asm volatile("" : "+v"(tid)); const int lane = tid & 63; (void)lane;
        if (rep) { __syncthreads(); if (tid == 0) F.MISC[0] = 0u; __syncthreads(); }
        if (c & 1) {
            LAS float* scr = (LAS float*)(F.lds + wave * P0_SCR);
            constexpr int I_IN = 16 * 64, I_PA = 8 * 16, I_PB = 8 * 16, I_O = 16 * 16, I_G = 8 * 8;
            constexpr int NTR = I_IN + I_PA + I_PB + I_O + I_G, NXR = M / 4, NITEMS = NTR + NXR;
            const int per_wg = (REP_P0S * NITEMS + F.G - 1) / F.G;
            for (;;) {
                int kq = 0; if (lane == 0) kq = (int)__hip_atomic_fetch_add((unsigned*)(F.MISC + 0), 1u, __ATOMIC_RELAXED, __HIP_MEMORY_SCOPE_WORKGROUP);
                kq = __builtin_amdgcn_readfirstlane(kq);
                if (kq >= per_wg) break;
                int it = kq * F.G + c; if (it >= REP_P0S * NITEMS) break;
                if (REP_P0S > 1) it %= NITEMS;
                if (it >= NTR) {
                    const int m0 = (it - NTR) * 4; f32x4 v[4][4];
#pragma unroll
                    for (int q = 0; q < 4; ++q) { const f32x4* xr = (const f32x4*)(x + (size_t)(m0 + q) * D) + lane;
#pragma unroll
                        for (int jj = 0; jj < 4; ++jj) v[q][jj] = __builtin_nontemporal_load(&xr[64 * jj]); }
#pragma unroll
                    for (int q = 0; q < 4; ++q) { float ss = 0.f;
#pragma unroll
                        for (int jj = 0; jj < 4; ++jj) ss += (v[q][jj][0] * v[q][jj][0] + v[q][jj][1] * v[q][jj][1]) + (v[q][jj][2] * v[q][jj][2] + v[q][jj][3] * v[q][jj][3]);
                        ss = wave_sum(ss, lane);
                        if (lane == 0) rstd1[m0 + q] = 1.0f / sqrtf(ss * (1.0f / D) + RMS_EPS);
                        unsigned* o4 = (unsigned*)(XB + (size_t)(m0 + q) * D) + lane;
#pragma unroll
                        for (int jj = 0; jj < 4; ++jj) { int p = 0; p = __builtin_amdgcn_cvt_pk_fp8_f32(v[q][jj][0], v[q][jj][1], p, false); p = __builtin_amdgcn_cvt_pk_fp8_f32(v[q][jj][2], v[q][jj][3], p, true); o4[64 * jj] = (unsigned)p; } }
                    continue;
                }
                int r = it; const float* W; int N, k0, n0, ldk; bf16* dst; const float* ksc = nullptr; int f8 = 0; float osc = 1.0f;
                if (r < I_IN) { W = w_in; N = INC; k0 = 64 * (r >> 6); n0 = 64 * (r & 63); dst = (bf16*)((unsigned char*)WinT + (size_t)n0 * 1024); ldk = 1024; ksc = g_mix; f8 = 1; osc = 32.0f; }
                else if ((r -= I_IN) < I_PA) { W = w_pa; N = D; k0 = 64 * (r >> 4); n0 = 64 * (r & 15); dst = WpabT + (size_t)n0 * 512; ldk = 512; }
                else if ((r -= I_PA) < I_PB) { W = w_pb; N = D; k0 = 64 * (r >> 4); n0 = 64 * (r & 15); dst = WpabT + (size_t)(1024 + n0) * 512; ldk = 512; }
                else if ((r -= I_PB) < I_O) { W = w_out; N = D; k0 = 64 * (r >> 4); n0 = 64 * (r & 15); dst = WoT + (size_t)n0 * 1024; ldk = 1024; }
                else { r -= I_O; W = glu_w; N = SW; k0 = 64 * (r >> 3); n0 = 64 * (r & 7); dst = GluT + (size_t)n0 * 512; ldk = 512; }
                { Tr64 t; t.W = W; t.N = N; t.k0 = k0; t.n0 = n0; t.ldk = ldk; t.dst = dst; t.ksc = ksc; t.f8 = f8; t.osc = osc; f32x4 tv[16]; tr64_load(t, tv, lane); tr64_store(t, tv, scr, lane); }
            }
            __syncthreads();
        }
        {
            const int g = c >> 3, j = c & 7;
            LAS f32x2* LP = (LAS f32x2*)(F.lds);
            LAS f32x2* BB = (LAS f32x2*)(F.lds + 33792);
            LAS f32x2* CC = (LAS f32x2*)(F.lds + 33792 + 8192);
            LAS f32x2* CL = (LAS f32x2*)(F.lds + 33792 + 16384);
            LAS float* mrs = (LAS float*)(F.lds + 33792 + 16384 + 65536);
            const float dt = expf(log_dt[g]);
#pragma unroll 1
            for (int idx = tid; idx < 65 * 64; idx += 512) {
                const int n = idx >> 6, p = idx & 63; const float lr = lam_re[g * 64 + p], li = lam_im[g * 64 + p];
                const float mag = expf((float)n * (lr * dt));
                const float rev1 = (li * dt) * 0.15915494309189535f; const float hi = (float)n * rev1; const float lo = fmaf((float)n, rev1, -hi);
                const float fr_ = (hi - rintf(hi)) + lo; const float sn = __builtin_amdgcn_sinf(fr_), cs = __builtin_amdgcn_cosf(fr_);
                LP[idx] = (f32x2){mag * cs, mag * sn};
            }
            for (int idx = tid; idx < 1024; idx += 512) { const int cc = idx >> 6, p = idx & 63; CC[idx] = (f32x2){c_re[(g * 16 + cc) * 64 + p], c_im[(g * 16 + cc) * 64 + p]}; }
            for (int r = 2 * wave; r < 2 * wave + 2; ++r) {
                float ss = 0.f;
#pragma unroll
                for (int i = 0; i < 16; ++i) { const float v = meta_tok[r * 1024 + lane + 64 * i]; ss += v * v; }
                ss = wave_sum(ss, lane);
                if (lane == 0) mrs[r] = 1.0f / sqrtf(ss * (1.0f / 1024.0f) + RMS_EPS);
            }
            __syncthreads();
            for (int idx = tid; idx < 1024; idx += 512) {
                const int p = idx >> 4, cp = idx & 15; const float lr = lam_re[g * 64 + p], li = lam_im[g * 64 + p];
                const f32x2 L1 = LP[64 + p]; const float nr = L1.x - 1.0f, ni = L1.y, den = lr * lr + li * li;
                const float fre = (nr * lr + ni * li) / den, fim = (ni * lr - nr * li) / den;
                const float br = b_re[(g * 64 + p) * 16 + cp], bi = b_im[(g * 64 + p) * 16 + cp];
                const f32x2 v = (f32x2){fre * br - fim * bi, fre * bi + fim * br};
                BB[idx] = v;
                if (j == 0) { bbar_g[((g * 64 + p) * 16 + cp) * 2] = v.x; bbar_g[((g * 64 + p) * 16 + cp) * 2 + 1] = v.y; }
            }
#pragma unroll 2
            for (int idx = tid; idx < 8192; idx += 512) { const int nl = idx >> 10, cc = (idx >> 6) & 15, p = idx & 63; const f32x2 C = CC[cc * 64 + p], L = LP[(8 * j + nl) * 64 + p];
                CL[idx] = (f32x2){C.x * L.x - C.y * L.y, C.x * L.y + C.y * L.x}; }
            if (j == 0 && tid < 64) { const f32x2 L1 = LP[64 + tid], L64 = LP[64 * 64 + tid];
                lbar_g[(g * 64 + tid) * 2] = L1.x; lbar_g[(g * 64 + tid) * 2 + 1] = L1.y; l64_g[(g * 64 + tid) * 2] = L64.x; l64_g[(g * 64 + tid) * 2 + 1] = L64.y; }
            __syncthreads();
#pragma unroll 1
            for (int idx = tid; idx < 2048; idx += 512) {
                const int nl = idx >> 8, cc = (idx >> 4) & 15, cp = idx & 15; float a = 0.f;
                const LAS f32x2* clp = CL + (nl * 16 + cc) * 64;
#pragma unroll 8
                for (int p = 0; p < 64; ++p) { const f32x2 X = clp[p], B = BB[p * 16 + cp]; a += X.x * B.x - X.y * B.y; }
                const int n = 8 * j + nl;
                if (n == 0 && cc == cp) a += ssm_d[g * 16 + cc];
                KT[((size_t)(g * KT_ROWS + n + 1)) * 256 + cc * 16 + cp] = (bf16)(cvt_pk_bf16(a, 0.f) & 0xffffu);
            }
            if (j == 0 && tid < 256) KT[((size_t)(g * KT_ROWS)) * 256 + tid] = 0;
#pragma unroll 2
            for (int idx = tid; idx < 16384; idx += 512) {
                const int kk = idx & 127, nn = idx >> 7; const int s2 = 8 * j + (kk >> 4), cp = kk & 15, ri = nn >> 6, p = nn & 63;
                const f32x2 L = LP[(63 - s2) * 64 + p], B = BB[p * 16 + cp];
                const float v = ri ? (L.x * B.y + L.y * B.x) : (L.x * B.x - L.y * B.y);
                T2[((((size_t)(g * 4 + (nn >> 5)) * 64 + s2) * 2 + (cp >> 3)) * 32 + (nn & 31)) * 8 + (cp & 7)] = (bf16)(cvt_pk_bf16(v, 0.f) & 0xffffu);
            }
#pragma unroll 2
            for (int idx = tid; idx < 16384; idx += 512) {
                const int kk = idx & 127, nl = idx >> 7; const int t = 8 * j + (nl >> 4), cc = nl & 15, ri = kk >> 6, p = kk & 63;
                const f32x2 L = LP[(t + 1) * 64 + p], C = CC[cc * 64 + p];
                const float v = ri ? -(C.x * L.y + C.y * L.x) : (C.x * L.x - C.y * L.y);
                T3[((((size_t)(g * 32 + (t >> 1)) * 8 + (kk >> 4)) * 2 + ((kk >> 3) & 1)) * 32 + (t & 1) * 16 + cc) * 8 + (kk & 7)] = (bf16)(cvt_pk_bf16(v, 0.f) & 0xffffu);
            }
            float my_rs[16];
            if (wave == 0 && c < 192) {
#pragma unroll
                for (int r = 0; r < 16; ++r) my_rs[r] = mrs[r];
            }
            __syncthreads();
            LAS float* scr = (LAS float*)(F.lds + wave * P0_SCR);
            if (wave == 0 && c < 192) {
                const int cb = c >> 3, kp = c & 7, k0 = 128 * kp, n = 512 + 64 * cb + lane;
#pragma unroll
                for (int r = 0; r < 16; ++r) { const float g0 = g_mix[k0 + lane], g1 = g_mix[k0 + 64 + lane];
                    scr[r * 128 + lane] = meta_tok[r * 1024 + k0 + lane] * my_rs[r] * g0; scr[r * 128 + 64 + lane] = meta_tok[r * 1024 + k0 + 64 + lane] * my_rs[r] * g1; }
                LDS_WAIT(); asm volatile("" ::: "memory");
                float a[16];
#pragma unroll
                for (int r = 0; r < 16; ++r) a[r] = 0.f;
#pragma unroll 4
                for (int k = 0; k < 128; k += 4) {
                    const float w0 = w_in[(size_t)(k0 + k) * INC + n], w1 = w_in[(size_t)(k0 + k + 1) * INC + n], w2 = w_in[(size_t)(k0 + k + 2) * INC + n], w3 = w_in[(size_t)(k0 + k + 3) * INC + n];
#pragma unroll
                    for (int r = 0; r < 16; ++r) { const f32x4 xv = *(const LAS f32x4*)(scr + r * 128 + k); a[r] += xv[0] * w0 + xv[1] * w1 + xv[2] * w2 + xv[3] * w3; }
                }
#pragma unroll
                for (int r = 0; r < 16; ++r) metapart[((size_t)kp * 16 + r) * 1536 + 64 * cb + lane] = a[r];
                LDS_WAIT(); asm volatile("" ::: "memory");
            } else if (wave == 1 && c < 64) {
                const int n = c;
#pragma unroll 4
                for (int i = 0; i < 16; ++i) { const int k = lane + 64 * i; float v = 0.f;
                    if (n < 4) v = rg_w[k * 4 + n] * g_ffn[k]; else if (n < 36) v = re_w[k * 32 + (n - 4)] * g_ffn[k];
                    const unsigned hi = cvt_pk_bf16(v, 0.f) & 0xffffu; const float lo = v - bf2f((unsigned short)hi);
                    const int fo = ((((n >> 5) * 64 + (k >> 4)) * 2 + ((k >> 3) & 1)) * 32 + (n & 31)) * 8 + (k & 7);
                    wr_t[fo] = (bf16)hi; wr_t[65536 + fo] = (bf16)(cvt_pk_bf16(lo, 0.f) & 0xffffu); }
                if (lane == 0) rbias[n] = n < 4 ? rg_b[n] : (n < 36 ? re_b[n - 4] : 0.f);
            } else if (wave == 1 && c < 72) {
                const int it = c - 64, b = it >> 1;
                if (it & 1) { for (int idx = lane; idx < 512 * 16; idx += 64) { const int cc = idx >> 4, r = idx & 15; VT[((size_t)(b * 512 + cc)) * LPB + r] = 0; } }
                else { for (int idx = lane; idx < 16 * 512; idx += 64) Kb[((size_t)(b * LPB)) * 512 + idx] = 0; }
            }
            if (!(c & 1)) {
            constexpr int I_IN = 16 * 64, I_PA = 8 * 16, I_PB = 8 * 16, I_O = 16 * 16, I_G = 8 * 8;
            constexpr int NTR = I_IN + I_PA + I_PB + I_O + I_G, NXR = M / 4, NITEMS = NTR + NXR;
            const int per_wg = (REP_P0S * NITEMS + F.G - 1) / F.G;
            for (;;) {
                int kq = 0; if (lane == 0) kq = (int)__hip_atomic_fetch_add((unsigned*)(F.MISC + 0), 1u, __ATOMIC_RELAXED, __HIP_MEMORY_SCOPE_WORKGROUP);
                kq = __builtin_amdgcn_readfirstlane(kq);
                if (kq >= per_wg) break;
                int it = kq * F.G + c; if (it >= REP_P0S * NITEMS) break;
                if (REP_P0S > 1) it %= NITEMS;
                if (it >= NTR) {
                    const int m0 = (it - NTR) * 4; f32x4 v[4][4];
#pragma unroll
                    for (int q = 0; q < 4; ++q) { const f32x4* xr = (const f32x4*)(x + (size_t)(m0 + q) * D) + lane;
#pragma unroll
                        for (int jj = 0; jj < 4; ++jj) v[q][jj] = __builtin_nontemporal_load(&xr[64 * jj]); }
#pragma unroll
                    for (int q = 0; q < 4; ++q) { float ss = 0.f;
#pragma unroll
                        for (int jj = 0; jj < 4; ++jj) ss += (v[q][jj][0] * v[q][jj][0] + v[q][jj][1] * v[q][jj][1]) + (v[q][jj][2] * v[q][jj][2] + v[q][jj][3] * v[q][jj][3]);
                        ss = wave_sum(ss, lane);
                        if (lane == 0) rstd1[m0 + q] = 1.0f / sqrtf(ss * (1.0f / D) + RMS_EPS);
                        unsigned* o4 = (unsigned*)(XB + (size_t)(m0 + q) * D) + lane;
#pragma unroll
                        for (int jj = 0; jj < 4; ++jj) { int p = 0; p = __builtin_amdgcn_cvt_pk_fp8_f32(v[q][jj][0], v[q][jj][1], p, false); p = __builtin_amdgcn_cvt_pk_fp8_f32(v[q][jj][2], v[q][jj][3], p, true); o4[64 * jj] = (unsigned)p; } }
                    continue;
                }
                int r = it; const float* W; int N, k0, n0, ldk; bf16* dst; const float* ksc = nullptr; int f8 = 0; float osc = 1.0f;
                if (r < I_IN) { W = w_in; N = INC; k0 = 64 * (r >> 6); n0 = 64 * (r & 63); dst = (bf16*)((unsigned char*)WinT + (size_t)n0 * 1024); ldk = 1024; ksc = g_mix; f8 = 1; osc = 32.0f; }
                else if ((r -= I_IN) < I_PA) { W = w_pa; N = D; k0 = 64 * (r >> 4); n0 = 64 * (r & 15); dst = WpabT + (size_t)n0 * 512; ldk = 512; }
                else if ((r -= I_PA) < I_PB) { W = w_pb; N = D; k0 = 64 * (r >> 4); n0 = 64 * (r & 15); dst = WpabT + (size_t)(1024 + n0) * 512; ldk = 512; }
                else if ((r -= I_PB) < I_O) { W = w_out; N = D; k0 = 64 * (r >> 4); n0 = 64 * (r & 15); dst = WoT + (size_t)n0 * 1024; ldk = 1024; }
                else { r -= I_O; W = glu_w; N = SW; k0 = 64 * (r >> 3); n0 = 64 * (r & 7); dst = GluT + (size_t)n0 * 512; ldk = 512; }
                { Tr64 t; t.W = W; t.N = N; t.k0 = k0; t.n0 = n0; t.ldk = ldk; t.dst = dst; t.ksc = ksc; t.f8 = f8; t.osc = osc; f32x4 tv[16]; tr64_load(t, tv, lane); tr64_store(t, tv, scr, lane); }
            }
            }
        }
    }
    xcd_barrier(bar);

#if PH_MAX >= 1
    for (int rep = 0; rep < REP_P1; ++rep) {
        P1Order S; S.so.init(M / 256, INC / 256, F.G, (int)blockIdx.x, WGM_P1); S.X = (const char*)XB; S.W = (const char*)WinT; S.t = (size_t)256 * 1024;
        EpiIn E{Qb, Kb, VT, UG, SG, rstd1};
        pg8::gemm_phase<EpiIn, P1Order, true, false, false, true>(F.lds + RING_OFF, 512, S, E, 0x7f7a);
        if (rep == REP_P1 - 1) {
            int tid = threadIdx.x; asm volatile("" : "+v"(tid));
            const int t = c * 512 + tid;
            if (t < 16 * 1536) {
                const int r = t / 1536, n = t % 1536; float sacc = 0.f;
#pragma unroll
                for (int kp = 0; kp < 8; ++kp) sacc += metapart[((size_t)kp * 16 + r) * 1536 + n];
                const bf16 hv = (bf16)(cvt_pk_bf16(sacc, 0.f) & 0xffffu);
                if (n < 512) { for (int b = 0; b < NB; ++b) Kb[((size_t)(b * LPB + 16 + r)) * 512 + n] = hv; }
                else if (n < 1024) { for (int b = 0; b < NB; ++b) VT[((size_t)(b * 512 + (n - 512))) * LPB + 16 + r] = hv; }
                else umeta[r * 512 + (n - 1024)] = sacc;
            }
        }
    }
    xcd_barrier(bar);
#endif


#if PH_MAX >= 2
    for (int rep = 0; rep < REP_SSM; ++rep) {
    if (c < 128) {
        int tid = threadIdx.x; asm volatile("" : "+v"(tid)); const int lane = tid & 63;
        const int b = c >> 5, g = c & 31;
        LAS float* SL = (LAS float*)(F.lds);
        LAS f32x2* ends = (LAS f32x2*)(F.lds + 128 * 129 * 4);
        {
            const int mbl = wave >> 1, nh = wave & 1, mb = 4 * b + mbl;
            const int l31 = lane & 31, h = lane >> 5;
            f32x16 a2[2];
#pragma unroll
            for (int r = 0; r < 16; ++r) { a2[0][r] = 0.f; a2[1][r] = 0.f; }
            const bf16* ua = UG + (size_t)(g * 16 + mb) * 64 * 512 + lane * 8;
            const bf16* t2 = T2 + (size_t)(g * 4 + 2 * nh) * 64 * 512 + lane * 8;
#pragma unroll 8
            for (int s2 = 0; s2 < 64; ++s2) {
                const bf16x8 a = *(const bf16x8*)(ua + s2 * 512);
                const bf16x8 b0 = *(const bf16x8*)(t2 + s2 * 512), b1 = *(const bf16x8*)(t2 + 64 * 512 + s2 * 512);
                a2[0] = __builtin_amdgcn_mfma_f32_32x32x16_bf16(a, b0, a2[0], 0, 0, 0);
                a2[1] = __builtin_amdgcn_mfma_f32_32x32x16_bf16(a, b1, a2[1], 0, 0, 0);
            }
#pragma unroll
            for (int t = 0; t < 2; ++t)
#pragma unroll
                for (int r = 0; r < 16; ++r) SL[(32 * mbl + (r & 3) + 8 * (r >> 2) + 4 * h) * 129 + (2 * nh + t) * 32 + l31] = a2[t][r];
        }
        __syncthreads();
        {
            const int seg = wave & 3, p = lane;
            const float lr = lbar_g[(g * 64 + p) * 2], li = lbar_g[(g * 64 + p) * 2 + 1], qr = l64_g[(g * 64 + p) * 2], qi = l64_g[(g * 64 + p) * 2 + 1];
            float vr[32], vi[32];
            float cr = 0.f, ci = 0.f, q32r = qr, q32i = qi;
            if (wave < 4) {
#pragma unroll
                for (int m = 0; m < 32; ++m) { vr[m] = SL[(32 * seg + m) * 129 + p]; vi[m] = SL[(32 * seg + m) * 129 + 64 + p]; }
                float xr = 0.f, xi = 0.f;
#pragma unroll
                for (int m = 0; m < 32; ++m) { const float sr = vr[m], si = vi[m]; vr[m] = xr; vi[m] = xi; const float nr = qr * xr - qi * xi + sr, ni = qr * xi + qi * xr + si; xr = nr; xi = ni; }
                ends[seg * 64 + p] = (f32x2){xr, xi};
                for (int r = 0; r < NMETA; ++r) {
                    float bur = 0.f, bui = 0.f;
#pragma unroll
                    for (int cp = 0; cp < 16; ++cp) { const float uv = umeta[r * 512 + 16 * g + cp]; bur += bbar_g[((g * 64 + p) * 16 + cp) * 2] * uv; bui += bbar_g[((g * 64 + p) * 16 + cp) * 2 + 1] * uv; }
                    const float nr = lr * cr - li * ci + bur, ni = lr * ci + li * cr + bui; cr = nr; ci = ni;
                }
#pragma unroll
                for (int k = 0; k < 5; ++k) { const float nr = q32r * q32r - q32i * q32i, ni = 2.0f * q32r * q32i; q32r = nr; q32i = ni; }
            }
            __syncthreads();
            if (wave < 4) {
                for (int k = 0; k < seg; ++k) { const f32x2 e = ends[k * 64 + p]; const float nr = q32r * cr - q32i * ci + e.x, ni = q32r * ci + q32i * cr + e.y; cr = nr; ci = ni; }
                float pr_ = 1.f, pi_ = 0.f;
#pragma unroll
                for (int m = 0; m < 32; ++m) {
                    const float Xr = vr[m] + (pr_ * cr - pi_ * ci), Xi = vi[m] + (pr_ * ci + pi_ * cr);
                    { const int mrow = b * 128 + 32 * seg + m;
                      const size_t xo = ((((size_t)(g * 16 + (mrow >> 5)) * 8 + (p >> 4)) * 2 + ((p >> 3) & 1)) * 32 + (mrow & 31)) * 8 + (p & 7);
                      Xs[xo] = (bf16)(cvt_pk_bf16(Xr, 0.f) & 0xffffu); Xs[xo + 4 * 512] = (bf16)(cvt_pk_bf16(Xi, 0.f) & 0xffffu); }
                    const float nr = pr_ * qr - pi_ * qi, ni = pr_ * qi + pi_ * qr; pr_ = nr; pi_ = ni;
                }
            }
        }
        __syncthreads();
    }
    if (rep == 0) {
        int tid = threadIdx.x; asm volatile("" : "+v"(tid)); const int lane = tid & 63; (void)lane;
        LAS float* scr = (LAS float*)(F.lds + wave * P0_SCR);
#pragma unroll 1
        for (int pass = 0; pass < 2; ++pass) {
            const bool do_att = (pass == 0) != (wave >= 4);
            if (do_att) {
                const int nu = (c < 128) ? 3 : 5;
#pragma unroll 1
                for (int rp = 0; rp < REP_ATT; ++rp)
#pragma unroll 1
                for (int i = 0; i < nu; ++i) { const int cc = (i < 4) ? c : c - 128; const int qi = (i < 4) ? i : 3;
                    attn_unit(Qb, Kb, VT, (rp == REP_ATT - 1) ? Qb : SSMb, cc >> 6, wave, (cc & 63) * 4 + qi, lane, (LAS unsigned char*)scr); }
            } else {
#pragma unroll 1
                for (int k = 0; k < 4; k += 2) {
                    const Tr64 ta = expert_item(c + 256 * (wave + 8 * k), ew1, ew3, ew2, g_ffn, WupT, W2T);
                    const Tr64 tb = expert_item(c + 256 * (wave + 8 * (k + 1)), ew1, ew3, ew2, g_ffn, WupT, W2T);
                    f32x4 va[16], vb[16];
                    tr64_load(ta, va, lane); tr64_load(tb, vb, lane);
                    tr64_store(ta, va, scr, lane); tr64_store(tb, vb, scr, lane);
                }
            }
        }
    }
    xcd_barrier(bar);
    for (int ui = 0; ui < 2; ++ui) {
        int tid = threadIdx.x; asm volatile("" : "+v"(tid)); const int lane = tid & 63; (void)lane;
        const int U = c * 2 + ui; const int g = U >> 4, mb = U & 15;
        const int l31 = lane & 31, h = lane >> 5;
        LAS unsigned char* UT = F.lds;
        LAS unsigned char* KTl = F.lds + 65536;
        __syncthreads();
        {
            const unsigned char* usrc = (const unsigned char*)(UG + (size_t)(g * 16 + mb) * 64 * 512);
#pragma unroll
            for (int i = 0; i < 8; ++i) { const int idx = tid + 512 * i; *(LAS v4u*)(UT + idx * 16) = *(const v4u*)(usrc + (size_t)idx * 16); }
            const unsigned char* ksrc = (const unsigned char*)(KT + (size_t)g * KT_ROWS * 256);
            for (int idx = tid; idx < 2080; idx += 512) *(LAS v4u*)(KTl + idx * 16) = *(const v4u*)(ksrc + (size_t)idx * 16);
        }
        f32x16 ac[4];
#pragma unroll
        for (int j = 0; j < 4; ++j)
#pragma unroll
            for (int r = 0; r < 16; ++r) ac[j][r] = 0.f;
        {
            const bf16* xa = Xs + (size_t)(g * 16 + mb) * 8 * 512 + lane * 8;
            const bf16* t3 = T3 + (size_t)(g * 32) * 8 * 512 + lane * 8;
#pragma unroll
            for (int kh = 0; kh < 2; ++kh) {
                bf16x8 xa4[4], tb[4][4];
#pragma unroll
                for (int k2 = 0; k2 < 4; ++k2) { xa4[k2] = *(const bf16x8*)(xa + (kh * 4 + k2) * 512);
#pragma unroll
                    for (int j = 0; j < 4; ++j) { const int tp = (j == 0) ? 2 * wave : (j == 1) ? 2 * wave + 1 : (j == 2) ? 30 - 2 * wave : 31 - 2 * wave; tb[k2][j] = *(const bf16x8*)(t3 + ((size_t)tp * 8 + (kh * 4 + k2)) * 512); } }
#pragma unroll
                for (int k2 = 0; k2 < 4; ++k2)
#pragma unroll
                    for (int j = 0; j < 4; ++j) ac[j] = __builtin_amdgcn_mfma_f32_32x32x16_bf16(xa4[k2], tb[k2][j], ac[j], 0, 0, 0);
            }
        }
        __syncthreads();
        {
            const LAS unsigned char* ap = UT + lane * 16;
            const LAS unsigned char* kp = KTl + (l31 >> 4) * 512 + (l31 & 15) * 32 + 16 * h;
            const int tA0 = 2 * wave, tA1 = 30 - 2 * wave;
            bf16x8 pv0[2], pv1[2];
            pv0[0] = *(const LAS bf16x8*)(kp + (2 * tA0 + 3) * 512); pv0[1] = *(const LAS bf16x8*)(kp + (2 * tA0 + 2) * 512);
            pv1[0] = *(const LAS bf16x8*)(kp + (2 * tA1 + 3) * 512); pv1[1] = *(const LAS bf16x8*)(kp + (2 * tA1 + 2) * 512);
#pragma unroll 1
            for (int s0 = 0; s0 < 64; s0 += 2) {
#pragma unroll
                for (int par = 0; par < 2; ++par) {
                    const int s2 = s0 + par;
                    const bf16x8 a = *(const LAS bf16x8*)(ap + s2 * 1024);
                    if (s2 <= 2 * tA0 + 3) { ac[1] = __builtin_amdgcn_mfma_f32_32x32x16_bf16(a, pv0[par], ac[1], 0, 0, 0);
                        if (s2 <= 2 * tA0 + 1) { const bf16x8 f = *(const LAS bf16x8*)(kp + (2 * tA0 - s2 + 1) * 512); ac[0] = __builtin_amdgcn_mfma_f32_32x32x16_bf16(a, f, ac[0], 0, 0, 0); pv0[par] = f; } }
                    if (s2 <= 2 * tA1 + 3) { ac[3] = __builtin_amdgcn_mfma_f32_32x32x16_bf16(a, pv1[par], ac[3], 0, 0, 0);
                        if (s2 <= 2 * tA1 + 1) { const bf16x8 f = *(const LAS bf16x8*)(kp + (2 * tA1 - s2 + 1) * 512); ac[2] = __builtin_amdgcn_mfma_f32_32x32x16_bf16(a, f, ac[2], 0, 0, 0); pv1[par] = f; } }
                }
            }
        }
#pragma unroll
        for (int j = 0; j < 4; ++j) { const int tp = (j == 0) ? 2 * wave : (j == 1) ? 2 * wave + 1 : (j == 2) ? 30 - 2 * wave : 31 - 2 * wave; const int t = 2 * tp + (l31 >> 4);
#pragma unroll
            for (int r = 0; r < 16; ++r) { const int m = 32 * mb + (r & 3) + 8 * (r >> 2) + 4 * h;
                Yb[((size_t)m * 64 + t) * 512 + 16 * g + (l31 & 15)] = (bf16)(cvt_pk_bf16(gelu_tanh(ac[j][r]), 0.f) & 0xffffu); } }
    }

    xcd_barrier(bar);
    }
    for (int rep = 0; rep < REP_MIX; ++rep) {
    {
        GOrder S; S.so.init(M / 256, SW / 256, F.G, (int)blockIdx.x, WGM_GLU); S.A = (const char*)Yb; S.B = (const char*)GluT; S.ta = (size_t)256 * 512 * 2; S.tb = (size_t)256 * 512 * 2;
        EpiGlu E{Yb, SSMb, glu_b};
        pg8::gemm_phase<EpiGlu, GOrder, true>(F.lds + RING_OFF, 512, S, E);
    }
    xcd_barrier(bar);
    {
        MergeOrder S; S.so.init(M / 256, D / 256, F.G, (int)blockIdx.x, WGM_MRG); S.A = (const char*)Qb; S.B = (const char*)WpabT; S.ta = (size_t)256 * 512 * 2; S.tb = (size_t)256 * 512 * 2;
        EpiMerge E{SG, MRG};
        pg8::gemm_phase<EpiMerge, MergeOrder, true, false, true>(F.lds + RING_OFF, 512, S, E);
    }
    xcd_barrier(bar);
    {
        GOrder S; S.so.init(M / 256, D / 256, F.G, (int)blockIdx.x, WGM_WO); S.A = (const char*)MRG; S.B = (const char*)WoT; S.ta = (size_t)256 * 1024 * 2; S.tb = (size_t)256 * 1024 * 2;
        EpiOut E{x, H1B, H1B8, ssqp};
        pg8::gemm_phase<EpiOut, GOrder, true>(F.lds + RING_OFF, 1024, S, E);
    }
    xcd_barrier(bar);
    }
#endif

#if PH_MAX >= 3
    for (int rep = 0; rep < REP_RT; ++rep) {
    {
        int tid = threadIdx.x; asm volatile("" : "+v"(tid)); const int lane = tid & 63; (void)lane;
        LAS float* lg = (LAS float*)(F.lds);
        LAS int* cntl = (LAS int*)(F.lds + 2 * 128 * 65 * 4);
        LAS int* basel = cntl + 32; LAS int* eloc = basel + 32; LAS float* gloc = (LAS float*)(eloc + 256); LAS float* rloc = gloc + 256;
        if (tid < 32) cntl[tid] = 0;
        const int mt = wave & 3, kh = wave >> 2, l31 = lane & 31, h = lane >> 5;
        {
            const int row = 128 * c + 32 * mt + l31;
            f32x16 a0, a1;
#pragma unroll
            for (int r = 0; r < 16; ++r) { a0[r] = 0.f; a1[r] = 0.f; }
            const bf16* hp = H1B + (size_t)row * D + 512 * kh + 8 * h;
            const bf16* w0 = wr_t + (size_t)(32 * kh) * 512 + lane * 8;
#pragma unroll 8
            for (int ks = 0; ks < 32; ++ks) {
                const bf16x8 av = *(const bf16x8*)(hp + 16 * ks);
                const bf16x8 bh0 = *(const bf16x8*)(w0 + 512 * ks), bl0 = *(const bf16x8*)(w0 + 65536 + 512 * ks);
                const bf16x8 bh1 = *(const bf16x8*)(w0 + 32768 + 512 * ks), bl1 = *(const bf16x8*)(w0 + 32768 + 65536 + 512 * ks);
                a0 = __builtin_amdgcn_mfma_f32_32x32x16_bf16(av, bh0, a0, 0, 0, 0);
                a0 = __builtin_amdgcn_mfma_f32_32x32x16_bf16(av, bl0, a0, 0, 0, 0);
                a1 = __builtin_amdgcn_mfma_f32_32x32x16_bf16(av, bh1, a1, 0, 0, 0);
                a1 = __builtin_amdgcn_mfma_f32_32x32x16_bf16(av, bl1, a1, 0, 0, 0);
            }
#pragma unroll
            for (int r = 0; r < 16; ++r) { const int rr = 32 * mt + (r & 3) + 8 * (r >> 2) + 4 * h; lg[(kh * 128 + rr) * 65 + l31] = a0[r]; lg[(kh * 128 + rr) * 65 + 32 + l31] = a1[r]; }
        }
        __syncthreads();
        if (tid < 128) {
            const int row = 128 * c + tid; float ss = 0.f;
#pragma unroll
            for (int j = 0; j < 16; ++j) ss += ssqp[(size_t)row * 16 + j];
            const float rs = 1.0f / sqrtf(ss * (1.0f / D) + RMS_EPS); rstd2[row] = rs;
            const LAS float* l = lg + tid * 65; const LAS float* l2 = lg + (128 + tid) * 65;
            float gl[4]; int gi = 0; float gm;
#pragma unroll
            for (int j = 0; j < 4; ++j) gl[j] = rs * (l[j] + l2[j]) + rbias[j];
            gm = gl[0];
#pragma unroll
            for (int j = 1; j < 4; ++j) if (gl[j] > gm) { gm = gl[j]; gi = j; }
            float den = 0.f;
#pragma unroll
            for (int j = 0; j < 4; ++j) den += expf(gl[j] - gm);
            const float ptop = 1.0f / den;
            float v0 = -3.0e38f, v1 = -3.0e38f; int i0 = 0, i1 = 0;
            for (int j = 0; j < 8; ++j) { const float v = rs * (l[4 + gi * 8 + j] + l2[4 + gi * 8 + j]) + rbias[4 + gi * 8 + j];
                if (v > v0) { v1 = v0; i1 = i0; v0 = v; i0 = j; } else if (v > v1) { v1 = v; i1 = j; } }
            const float e1 = expf(v1 - v0); const float g0 = ptop / (1.0f + e1), g1 = ptop * e1 / (1.0f + e1);
            const int ea = gi * 8 + i0, eb = gi * 8 + i1;
            eloc[2 * tid] = ea; eloc[2 * tid + 1] = eb; gloc[2 * tid] = g0; gloc[2 * tid + 1] = g1; rloc[tid] = rs;
            atomicAdd((int*)(cntl + ea), 1); atomicAdd((int*)(cntl + eb), 1);
        }
        __syncthreads();
        if (tid < 32) basel[tid] = (int)__hip_atomic_fetch_add(etot + tid, (unsigned)cntl[tid], __ATOMIC_RELAXED, __HIP_MEMORY_SCOPE_AGENT);
        __syncthreads();
        if (tid < 256) {
            const int e = eloc[tid]; int rank = 0;
            for (int a = 0; a < tid; ++a) rank += (eloc[a] == e) ? 1 : 0;
            const int idx = e * CAPE + basel[e] + rank;
            inv_tok[idx] = 128 * c * 2 + tid; inv_gate[idx] = gloc[tid]; inv_rs[idx] = rloc[tid >> 1];
        }
    }
    xcd_barrier(bar);
    }
    for (int rep = 0; rep < REP_MOE; ++rep) {
    {
        LAS int* rowtok = (LAS int*)(F.lds + ROWTOK_OFF);
        { int tid = threadIdx.x; asm volatile("" : "+v"(tid));
          LAS int* tot = (LAS int*)(F.lds); LAS int* pst = tot + 32; LAS int* blke = pst + 40;
          if (tid < 32) tot[tid] = (int)etot[tid];
          __syncthreads();
          if (tid == 0) { int p = 0; for (int e = 0; e < 32; ++e) { pst[e] = p; p += ((tot[e] + 255) >> 8) << 8; } pst[32] = p; mymeta[0] = p >> 8; }
          __syncthreads();
          if (tid < 32) { for (int rb = pst[tid] >> 8; rb < (pst[tid + 1] >> 8); ++rb) { blke[rb] = tid; mymeta[16 + rb] = tid; } }
          __syncthreads();
          const int nrb = pst[32] >> 8; const int cb = (int)blockIdx.x;
          for (int idx = tid; idx < 5 * 256; idx += 512) { const int rb = (idx >> 8) * 64 + (cb & 7) * 8 + (cb >> 5); int tk = 0;
              if (rb < nrb) { const int e = blke[rb]; const int slot = rb * 256 + (idx & 255); const int rel = slot - pst[e]; const bool ok = rel < tot[e];
                  const int t2 = ok ? inv_tok[e * CAPE + rel] : -1; tk = ok ? (t2 >> 1) : 0;
                  sdst[slot] = t2; sgate[slot] = ok ? inv_gate[e * CAPE + rel] : 0.f; srs[slot] = ok ? inv_rs[e * CAPE + rel] : 0.f; }
              rowtok[idx] = tk; }
          asm volatile("s_waitcnt vmcnt(0)" ::: "memory");
          __syncthreads(); }
        MoeOrderG S; S.meta = mymeta; S.rowtok = rowtok; S.G = F.G; S.c = (int)blockIdx.x; S.A = (const char*)H1B8; S.B = (const char*)WupT; S.tb = (size_t)256 * 1024;
        EpiUp E{srs, HID};
        pg8::gemm_phase<EpiUp, MoeOrderG, true, true, false, true>(F.lds + RING_OFF, 512, S, E, 0x7f7a);
        if (rep == 0) {
            int tid = threadIdx.x; asm volatile("" : "+v"(tid)); const int lane = tid & 63;
            const int nrb = __builtin_amdgcn_readfirstlane(mymeta[0]); const int cb = (int)blockIdx.x;
            int T = nrb - 256; T = T < 0 ? 0 : (T > 32 ? 32 : T);
            const int r5 = (cb & 7) * 8 + (cb >> 5);
            if (r5 >= T) {
                const int nidle = (64 - T) * 4, me = (r5 - T) * 4 + ((cb >> 3) & 3);
                LAS float* scr = (LAS float*)(F.lds + wave * P0_SCR);
#pragma unroll 1
                for (int it = me + nidle * wave; it < I_E2; it += nidle * 8) {
                    const Tr64 t = expert_item(I_E1 + I_E3 + it, ew1, ew3, ew2, g_ffn, WupT, W2T);
                    f32x4 tv[16]; tr64_load(t, tv, lane); tr64_store(t, tv, scr, lane);
                }
            }
        }
    }
    xcd_barrier(bar);
    {
        MoeOrder S; S.meta = mymeta; S.G = F.G; S.c = (int)blockIdx.x; S.A = (const char*)HID; S.B = (const char*)W2T; S.ta = (size_t)256 * 512; S.tb = (size_t)256 * 512;
        EpiDown E{sdst, sgate, YB};
        pg8::gemm_phase<EpiDown, MoeOrder, true, false, false, true>(F.lds + RING_OFF, 256, S, E, 0x7d7b);
    }
    xcd_barrier(bar);
    }
#endif

#ifdef DBG_COPYSG
    for (int m = gw; m < M; m += NGW) { for (int j = 0; j < 16; ++j) HID[(size_t)m * 512 + ((lane + 64 * j) & 511)] = SG[(size_t)m * 2048 + DBG_COL0 + ((lane + 64 * j) & 511)]; }
    xcd_barrier(bar);
#endif
#ifdef DBG_BUF
    {
        for (int m = gw; m < M; m += NGW) {
            const bf16* src = DBG_BUF; const size_t ld = DBG_LD;
            float v[16];
#pragma unroll
            for (int j = 0; j < 16; ++j) v[j] = DBG_SCALE * bf2f(src[(size_t)(m % DBG_ROWS) * ld + ((lane + 64 * j) % ld)]);
            asm volatile("" ::: "memory");
#pragma unroll
            for (int j = 0; j < 16; ++j) out[(size_t)m * D + lane + 64 * j] = v[j];
        }
    }
#else
    for (int rep = 0; rep < REP_FIN; ++rep) {
        int tid = threadIdx.x; asm volatile("" : "+v"(tid)); const int lane = tid & 63; (void)lane;
        for (int m = gw; m < M; m += NGW) {
            f32x4 v[4]; float s = 0.f;
            { const v2u* hr = (const v2u*)(H1B + (size_t)m * D) + lane;
#pragma unroll
              for (int j = 0; j < 4; ++j) { const v2u a = hr[64 * j]; v[j][0] = bflo(a.x); v[j][1] = bfhi(a.x); v[j][2] = bflo(a.y); v[j][3] = bfhi(a.y); } }
#if PH_MAX >= 3
            const unsigned* y0 = (const unsigned*)(YB + (size_t)(2 * m) * D) + lane; const unsigned* y1 = (const unsigned*)(YB + (size_t)(2 * m + 1) * D) + lane;
#pragma unroll
            for (int j = 0; j < 4; ++j) { const int a = (int)y0[64 * j], b = (int)y1[64 * j];
                v[j][0] += (__builtin_amdgcn_cvt_f32_fp8(a, 0) + __builtin_amdgcn_cvt_f32_fp8(b, 0)) * 0.0625f; v[j][1] += (__builtin_amdgcn_cvt_f32_fp8(a, 1) + __builtin_amdgcn_cvt_f32_fp8(b, 1)) * 0.0625f;
                v[j][2] += (__builtin_amdgcn_cvt_f32_fp8(a, 2) + __builtin_amdgcn_cvt_f32_fp8(b, 2)) * 0.0625f; v[j][3] += (__builtin_amdgcn_cvt_f32_fp8(a, 3) + __builtin_amdgcn_cvt_f32_fp8(b, 3)) * 0.0625f; }
#endif
#pragma unroll
            for (int j = 0; j < 4; ++j) s += (v[j][0] * v[j][0] + v[j][1] * v[j][1]) + (v[j][2] * v[j][2] + v[j][3] * v[j][3]);
            const float rs = 1.0f / sqrtf(wave_sum(s, lane) * (1.0f / D) + RMS_EPS);
            f32x4* o = (f32x4*)(out + (size_t)m * D) + lane;
#pragma unroll
            for (int j = 0; j < 4; ++j) { const f32x4 g = *((const f32x4*)g_fin + lane + 64 * j); __builtin_nontemporal_store(v[j] * rs * g, &o[64 * j]); }
        }
    }
#endif
}

extern "C" void kernel_launch(void* const* d_in, const int* in_sizes, int n_in, void* d_out, int out_size, void* d_ws, size_t ws_size, hipStream_t stream) {
    static int grid = 0;
    if (grid == 0) {
        if (n_in != 26 || out_size != M * D || ws_size < WS_END) { fprintf(stderr, "kernel_launch: unexpected sizes n_in %d out %d ws %zu\n", n_in, out_size, ws_size); grid = -1; return; }
        int dev = 0, cus = 0, per_cu = 0;
        if (hipGetDevice(&dev) != hipSuccess || hipDeviceGetAttribute(&cus, hipDeviceAttributeMultiprocessorCount, dev) != hipSuccess) { grid = -1; return; }
        if (hipFuncSetAttribute((const void*)fwd_kernel, hipFuncAttributeMaxDynamicSharedMemorySize, LDS_BYTES) != hipSuccess) { fprintf(stderr, "kernel_launch: hipFuncSetAttribute failed\n"); grid = -1; return; }
        if (hipOccupancyMaxActiveBlocksPerMultiprocessor(&per_cu, (const void*)fwd_kernel, NWAVES * 64, LDS_BYTES) != hipSuccess || per_cu < 1)
            fprintf(stderr, "kernel_launch: occupancy query reports %d\n", per_cu);
        (void)hipGetLastError();
        grid = cus;
        if (grid != 256) fprintf(stderr, "kernel_launch: %d CUs (built for 256)\n", grid);
    }
    if (grid < 0) return;
    if (hipMemsetAsync((char*)d_ws + WS_CTL, 0, CTL_ZERO_BYTES, stream) != hipSuccess) return;
    Args a{};
    for (int i = 0; i < 26; ++i) a.in[i] = (const float*)d_in[i];
    a.out = (float*)d_out; a.ws = (unsigned char*)d_ws;
    hipLaunchKernelGGL(fwd_kernel, dim3(grid), dim3(NWAVES * 64), LDS_BYTES, stream, a);
}
```

```cpp
#include <hip/hip_runtime.h>
#include <cstdio>
#include <cstdint>

#ifndef REP_P0
#define REP_P0 1
#endif
#ifndef WGM_P1
#define WGM_P1 4
#endif
#ifndef WGM_GLU
#define WGM_GLU 4
#endif
#ifndef WGM_MRG
#define WGM_MRG 4
#endif
#ifndef WGM_WO
#define WGM_WO 4
#endif
#ifndef REP_P0S
#define REP_P0S 1
#endif
#ifndef REP_P1
#define REP_P1 1
#endif
#ifndef REP_SSM
#define REP_SSM 1
#endif
#ifndef REP_ATT
#define REP_ATT 1
#endif
#ifndef REP_MIX
#define REP_MIX 1
#endif
#ifndef REP_RT
#define REP_RT 1
#endif
#ifndef REP_MOE
#define REP_MOE 1
#endif
#ifndef REP_FIN
#define REP_FIN 1
#endif
#ifndef PH_MAX
#define PH_MAX 3
#endif

#define GAS __attribute__((address_space(1)))
#define LAS __attribute__((address_space(3)))
typedef unsigned short bf16;
typedef unsigned v4u __attribute__((ext_vector_type(4)));
typedef unsigned v2u __attribute__((ext_vector_type(2)));
typedef float f32x2 __attribute__((ext_vector_type(2)));
typedef float f32x4 __attribute__((ext_vector_type(4)));
typedef float f32x16 __attribute__((ext_vector_type(16)));
typedef short bf16x8 __attribute__((ext_vector_type(8)));
typedef GAS unsigned gu32;

constexpr int D = 1024, NB = 4, SEQ = 8192, M = NB * SEQ, NMETA = 16;
constexpr int ATW = 512, NH = 8, HD = 64, SW = 512, NG = 32, GC = 16, NP = 64, INC = 4096;
constexpr int NE = 32, FF = 512;
constexpr int LPB = 8224;
constexpr int KT_ROWS = 66;
constexpr int MAXRB = 288;
constexpr float RMS_EPS = 1e-6f;
constexpr float QSCALE = 0.125f * 1.4426950408889634f;

constexpr size_t MiB = 1u << 20;
constexpr size_t WS_CTL = 0, CTL_ZERO_BYTES = 1 * MiB;
constexpr size_t WS_SMALL = 1 * MiB;
constexpr size_t SM_RSTD1 = WS_SMALL;
constexpr size_t SM_RSTD2 = SM_RSTD1 + 128 * 1024;
constexpr size_t SM_EID = SM_RSTD2 + 128 * 1024;
constexpr size_t SM_GATE = SM_EID + 256 * 1024;
constexpr size_t SM_CNT = SM_GATE + 256 * 1024;
constexpr size_t SM_UMETA = SM_CNT + 32 * 1024;
constexpr size_t SM_BBAR = SM_UMETA + 32 * 1024;
constexpr size_t SM_LBAR = SM_BBAR + 256 * 1024;
constexpr size_t SM_L64 = SM_LBAR + 16 * 1024;
constexpr size_t SM_SDST = SM_L64 + 16 * 1024;
constexpr size_t SM_SGATE = SM_SDST + 288 * 1024;
constexpr size_t SM_SRS = SM_SGATE + 288 * 1024;
constexpr size_t SM_WR = SM_SRS + 288 * 1024;
constexpr size_t SM_RB = SM_WR + 256 * 1024;
constexpr size_t SM_MOEMETA = SM_RB + 1024;
constexpr size_t SM_METAP = SM_MOEMETA + 4096;
constexpr size_t SM_SSQP = 4 * MiB;
static_assert(SM_METAP + 8 * 16 * 1536 * 4 <= SM_SSQP, "small map");
constexpr size_t WS_WIN = 6 * MiB;
constexpr size_t WS_WPAB = 14 * MiB;
constexpr size_t WS_WO = 16 * MiB;
constexpr size_t WS_GLU = 18 * MiB;
constexpr size_t WS_KT = 19 * MiB;
constexpr size_t WS_T2 = 21 * MiB;
constexpr size_t WS_T3 = 29 * MiB;
constexpr size_t WS_WUP = 37 * MiB;
constexpr size_t WS_W2 = 101 * MiB;
constexpr size_t WS_XB = 133 * MiB;
constexpr size_t WS_Y = 133 * MiB;
constexpr size_t WS_S = 165 * MiB;
constexpr size_t WS_XS = 173 * MiB;
constexpr size_t WS_Q = 197 * MiB;
constexpr size_t WS_SSM = 229 * MiB;
constexpr size_t WS_K = 261 * MiB;
constexpr size_t WS_VT = 295 * MiB;
constexpr size_t WS_UG = 329 * MiB;
constexpr size_t WS_SG = 361 * MiB;
constexpr size_t WS_H1B = 361 * MiB;
constexpr size_t WS_H1B8 = 425 * MiB;
constexpr size_t WS_HID = 277 * MiB;
constexpr size_t WS_YB = 133 * MiB;
constexpr size_t WS_INV = 489 * MiB;
constexpr size_t WS_MWG = 502 * MiB;
constexpr size_t WS_END = 503 * MiB;
constexpr int CAPE = 32768;
constexpr int CW_TOT = 8192;

constexpr int CW_BAR = 4096;

constexpr int RING_OFF = 0, RING_BYTES = 131072;
constexpr int P0_SCR = 16896;
constexpr int LDSCTL_OFF = 8 * P0_SCR, MISC_OFF = LDSCTL_OFF + 320;
static_assert(LDSCTL_OFF >= RING_BYTES, "lds map");
constexpr int LDS_BYTES = 147456;
constexpr int ROWTOK_OFF = 8 * 16896 + 512;
static_assert(ROWTOK_OFF + 5 * 256 * 4 <= LDS_BYTES, "lds map");
constexpr int NWAVES = 8;

#define LDS_WAIT() asm volatile("s_waitcnt lgkmcnt(0)" ::: "memory")
#define VM_WAIT() asm volatile("s_waitcnt vmcnt(0)" ::: "memory")

typedef __bf16 bf16x2_t __attribute__((ext_vector_type(2)));
__device__ __forceinline__ unsigned cvt_pk_bf16(float lo, float hi) { bf16x2_t v; v[0] = (__bf16)lo; v[1] = (__bf16)hi; return __builtin_bit_cast(unsigned, v); }
__device__ __forceinline__ float bf2f(unsigned short b) { return __builtin_bit_cast(float, (unsigned)b << 16); }
__device__ __forceinline__ float bflo(unsigned w) { return __builtin_bit_cast(float, w << 16); }
__device__ __forceinline__ float bfhi(unsigned w) { return __builtin_bit_cast(float, w & 0xffff0000u); }
__device__ __forceinline__ float fast_sigmoid(float x) { return __builtin_amdgcn_rcpf(1.0f + __expf(-x)); }
__device__ __forceinline__ float shx(float v, int k, int lane) { return __builtin_bit_cast(float, __builtin_amdgcn_ds_bpermute((lane ^ k) << 2, __builtin_bit_cast(int, v))); }
__device__ __forceinline__ float wave_sum(float v, int lane) {
#pragma unroll
    for (int o = 1; o < 64; o <<= 1) v += shx(v, o, lane);
    return v;
}

#define XB_TMO      128
#define XB_XCNT(j)  (256  + 64 * (j))
#define XB_XSUB(j)  (1280 + 64 * (j))
#define XB_XGEN(j)  (2304 + 64 * (j))
#define XB_TOP      3328
#define XB_TOPGEN   3392
#define XCD_BAR_WORDS 3456
#define XB_SPIN_CAP (1u << 18)
__device__ __forceinline__ unsigned xb_ld(unsigned* p)              { return __hip_atomic_load(p, __ATOMIC_RELAXED, __HIP_MEMORY_SCOPE_AGENT); }
__device__ __forceinline__ unsigned xb_add(unsigned* p, unsigned v) { return __hip_atomic_fetch_add(p, v, __ATOMIC_RELAXED, __HIP_MEMORY_SCOPE_AGENT); }
__device__ __forceinline__ unsigned xb_xcc_id() { return (unsigned)__builtin_amdgcn_s_getreg((3 << 11) | 20) & 0xFu; }
#define XB_SPIN(cond, bar) do { unsigned _sp = 0; while (cond) { __builtin_amdgcn_s_sleep(1); \
    if ((++_sp & 255u) == 0u) { if (xb_ld(&(bar)[XB_TMO])) break; if (_sp > XB_SPIN_CAP) { atomicAdd(&(bar)[XB_TMO], 1u); break; } } } } while (0)
struct XcdBarrier { unsigned* bar; unsigned x; volatile LAS unsigned* st; };
__device__ __forceinline__ XcdBarrier xcd_barrier_post(unsigned* bar, volatile LAS unsigned* st) {
    XcdBarrier b; b.bar = bar; b.x = (unsigned)__builtin_amdgcn_readfirstlane((int)xb_xcc_id()); b.st = st;
    if (threadIdx.x == 0) (void)xb_add(&bar[XB_XCNT(b.x)], 1u);
    return b;
}
__device__ __forceinline__ void xcd_barrier_complete(unsigned* bar, unsigned x, unsigned& nloc, unsigned& nx) {
    const unsigned G = gridDim.x * gridDim.y * gridDim.z;
    unsigned sum, cnt, mine, sp = 0u;
    for (;;) {
        sum = 0u; cnt = 0u; mine = 0u;
#pragma unroll
        for (unsigned j = 0; j < 16; ++j) { const unsigned c = xb_ld(&bar[XB_XCNT(j)]); sum += c; cnt += (c > 0u) ? 1u : 0u; mine = (j == x) ? c : mine; }
        if (sum == G) break;
        __builtin_amdgcn_s_sleep(1);
        if ((++sp & 255u) == 0u) { if (xb_ld(&bar[XB_TMO])) break; if (sp > XB_SPIN_CAP) { atomicAdd(&bar[XB_TMO], 1u); break; } }
    }
    nloc = mine > 0u ? mine : 1u; nx = cnt > 0u ? cnt : 1u;
}
__device__ __forceinline__ void xcd_barrier(const XcdBarrier& b) {
    asm volatile("s_waitcnt vmcnt(0)" ::: "memory");
    __syncthreads();
    if (threadIdx.x == 0) {
        unsigned* bar = b.bar; asm volatile("" : "+s"(bar));
        __builtin_amdgcn_s_waitcnt(0);
        unsigned bx = b.x; asm volatile("" : "+s"(bx));
        const unsigned osub = (unsigned)__builtin_amdgcn_readfirstlane((int)XB_XSUB(bx)), ogen = (unsigned)__builtin_amdgcn_readfirstlane((int)XB_XGEN(bx));
        unsigned nloc = b.st[0], nx = b.st[1];
        if (nloc == 0u) { xcd_barrier_complete(bar, bx, nloc, nx); b.st[0] = nloc; b.st[1] = nx; }
        const unsigned old = xb_add(&bar[osub], 1u);
        const unsigned gen = old / nloc;
        if (old + 1u == (gen + 1u) * nloc) {
            __builtin_amdgcn_fence(__ATOMIC_RELEASE, "agent");
            asm volatile("s_waitcnt vmcnt(0)" ::: "memory");
            const unsigned og = xb_add(&bar[XB_TOP], 1u);
            const unsigned tg = og / nx;
            if (og + 1u == (tg + 1u) * nx) xb_add(&bar[XB_TOPGEN], 1u);
            else XB_SPIN(xb_ld(&bar[XB_TOPGEN]) == tg, bar);
            __builtin_amdgcn_fence(__ATOMIC_ACQUIRE, "agent");
            xb_add(&bar[ogen], 1u);
            asm volatile("s_waitcnt vmcnt(0)" ::: "memory");
        } else {
            XB_SPIN(xb_ld(&bar[ogen]) == gen, bar);
            __builtin_amdgcn_fence(__ATOMIC_ACQUIRE, "agent");
            asm volatile("s_waitcnt vmcnt(0)" ::: "memory");
        }
    }
    __syncthreads();
}

namespace pg8 {
typedef int pg8_v4i __attribute__((ext_vector_type(4)));
typedef int pg8_v8i __attribute__((ext_vector_type(8)));
constexpr int BM = 256, BK = 64, HALF = 128, HTB = HALF * BK * 2, STAGE_BYTES = 8 * HTB, NXCD = 8, WGM = 4;
__host__ __device__ __forceinline__ int lds_byte(int r, int c) { const int st = (r >> 4) * 2 + (c >> 5), rr = r & 15, cc = c & 31, ob = rr * 64 + cc * 2; return st * 1024 + (ob ^ (((ob >> 9) & 1) << 5)); }
__host__ __device__ __forceinline__ void stage_rc(int b, int& R, int& C) { const int st = b / 1024, sb = b % 1024, swz = sb ^ (((sb >> 9) & 1) << 5); R = (st >> 1) * 16 + swz / 64; C = (st & 1) * 32 + (swz % 64) / 2; }
__host__ __device__ __forceinline__ int perm32(int rho) { const int n = rho >> 4, i = rho & 15; return 8 * (i >> 2) + 4 * n + (i & 3); }
struct Unit { int pm, pn; };
struct StaticOrder {
    int nM, nN, nwg, G, c, wgm;
    __host__ __device__ void init(int nM_, int nN_, int G_, int c_, int wgm_ = WGM) { nM = nM_; nN = nN_; nwg = nM * nN; G = G_; c = c_; wgm = wgm_; }
    __host__ __device__ bool next(int i, Unit& u) const {
        const long L = (long)i * G + c; if (L >= nwg) return false;
        int wgid = (int)L; { const int q = nwg / NXCD, r = nwg % NXCD, xcd = wgid % NXCD, off = wgid / NXCD; wgid = (xcd < r ? xcd * (q + 1) : r * (q + 1) + (xcd - r) * q) + off; }
        const int nig = wgm * nN, gid = wgid / nig, fm = gid * wgm, gsz = (nM - fm) < wgm ? (nM - fm) : wgm;
        u.pm = fm + ((wgid % nig) % gsz); u.pn = (wgid % nig) / gsz; return true;
    }
};
template <class Epi, class Sched, bool ALIGN_EPI, bool GATHER = false, bool KS = false, bool F8 = false>
__device__ __forceinline__ void gemm_phase(LAS unsigned char* lds, const int K, const Sched& S, const Epi& E, const int sc_wa = 0x7f7f) {
    int tid = threadIdx.x; asm volatile("" : "+v"(tid));
    const int wid = __builtin_amdgcn_readfirstlane(tid >> 6), lane = tid & 63, wr = wid >> 2, wc = wid & 3, fr = lane & 15, fq = lane >> 4;
    const int nt = KS ? 16 : K / BK;
    unsigned voffA[2], voffB[2]; int Rr[2], Cc[2];
#pragma unroll
    for (int i = 0; i < 2; ++i) { int R, C; stage_rc(tid * 16 + i * 8192, R, C); const int Rb = Epi::PERM ? ((R & ~31) + perm32(R & 31)) : R; Rr[i] = R; Cc[i] = C;
        voffA[i] = (unsigned)(R * K + C) * 2u; voffB[i] = (unsigned)(Rb * K + C) * 2u; }
    unsigned gA[2][2], gAn[2][2];
#pragma unroll
    for (int h2 = 0; h2 < 2; ++h2) { gA[h2][0] = gA[h2][1] = gAn[h2][0] = gAn[h2][1] = 0u; }
    const size_t kstep = (size_t)(BK * 2);
    const size_t hstep = (size_t)HALF * K * 2;
    const unsigned ldsw = (unsigned)wid * 1024u;
    const int aoff = lds_byte(wr * 64 + fr, fq * 8), boff = lds_byte(wc * 32 + fr, fq * 8);
#define PG8_SA(b, h) (((b) * 2 + (h)) * HTB)
#define PG8_SB(b, h) ((4 + (b) * 2 + (h)) * HTB)
#define PG8_STAGE(bufoff, gbase, voff) do { _Pragma("unroll") for (int _i = 0; _i < 2; ++_i) \
        __builtin_amdgcn_global_load_lds((const unsigned*)((const char*)(gbase) + (voff)[_i]), (LAS unsigned*)(lds + (bufoff) + ldsw + _i * 8192), 16, 0, 0); } while (0)
#define PG8_LD8(dst8, addr) do { const pg8_v4i lo_ = *(const LAS pg8_v4i*)(addr), hi_ = *(const LAS pg8_v4i*)((addr) + 1024); dst8 = __builtin_shufflevector(lo_, hi_, 0, 1, 2, 3, 4, 5, 6, 7); } while (0)
#define PG8_LDA(dst, b, h) do { if constexpr (F8) { _Pragma("unroll") for (int m = 0; m < 4; ++m) PG8_LD8(dst##8[m], lds + PG8_SA(b, h) + aoff + m * 2048); } \
        else { _Pragma("unroll") for (int m = 0; m < 4; ++m) _Pragma("unroll") for (int k = 0; k < 2; ++k) dst[m][k] = *(const LAS bf16x8*)(lds + PG8_SA(b, h) + aoff + m * 2048 + k * 1024); } } while (0)
#define PG8_LDB(dst, b, h) do { if constexpr (F8) { _Pragma("unroll") for (int n = 0; n < 2; ++n) PG8_LD8(dst##8[n], lds + PG8_SB(b, h) + boff + n * 2048); } \
        else { _Pragma("unroll") for (int n = 0; n < 2; ++n) _Pragma("unroll") for (int k = 0; k < 2; ++k) dst[n][k] = *(const LAS bf16x8*)(lds + PG8_SB(b, h) + boff + n * 2048 + k * 1024); } } while (0)
#define PG8_MMA(ai, bj, At, Bt) do { __builtin_amdgcn_s_setprio(1); _Pragma("unroll") for (int m = 0; m < 4; ++m) _Pragma("unroll") for (int n = 0; n < 2; ++n) { \
        if constexpr (F8) { acc[ai][bj][m][n] = __builtin_amdgcn_mfma_scale_f32_16x16x128_f8f6f4(Bt##8[n], At##8[m], acc[ai][bj][m][n], 0, 0, 0, sc_wa, 1, sc_wa); } \
        else { _Pragma("unroll") for (int k = 0; k < 2; ++k) acc[ai][bj][m][n] = __builtin_amdgcn_mfma_f32_16x16x32_bf16(Bt[n][k], At[m][k], acc[ai][bj][m][n], 0, 0, 0); } } \
        if constexpr (F8) asm volatile("" : "+v"(acc[ai][bj][0][0]), "+v"(acc[ai][bj][0][1]), "+v"(acc[ai][bj][1][0]), "+v"(acc[ai][bj][1][1]), "+v"(acc[ai][bj][2][0]), "+v"(acc[ai][bj][2][1]), "+v"(acc[ai][bj][3][0]), "+v"(acc[ai][bj][3][1]));   \
        __builtin_amdgcn_s_setprio(0); } while (0)
#define PG8_WAIT_V(n) asm volatile("s_waitcnt vmcnt(" #n ")" ::: "memory")
#define PG8_WAIT_L(n) asm volatile("s_waitcnt lgkmcnt(" #n ")" ::: "memory")
#define PG8_BAR __builtin_amdgcn_s_barrier()
#define PG8_SCHED __builtin_amdgcn_sched_barrier(0)
    Unit cur, nxt; int ui = 0;
    if (!S.next(0, cur)) return;
    f32x4 acc[2][2][4][2];
#pragma unroll
    for (int a = 0; a < 2; ++a)
#pragma unroll
        for (int b = 0; b < 2; ++b)
#pragma unroll
            for (int m = 0; m < 4; ++m)
#pragma unroll
                for (int n = 0; n < 2; ++n) acc[a][b][m][n] = (f32x4){0.f, 0.f, 0.f, 0.f};
    if constexpr (F8) {
#pragma unroll
        for (int a = 0; a < 2; ++a)
#pragma unroll
            for (int b = 0; b < 2; ++b)
#pragma unroll
                for (int m = 0; m < 4; ++m)
#pragma unroll
                    for (int n = 0; n < 2; ++n) asm volatile("" : "+v"(acc[a][b][m][n]));
    }
    bf16x8 At[4][2], B0[2][2], B1[2][2];
    pg8_v8i At8[4], B08[2], B18[2];
    const char* cA = S.aptr(cur); const char* cB = S.bptr(cur);
    if constexpr (GATHER) { S.gather(cur, Rr, Cc, K, gA); }
#define PG8_STAGE_A(bufoff, h, ko, usenext) PG8_STAGE_A2(bufoff, h, cA, ko, usenext)
#define PG8_STAGE_A2(bufoff, h, cur_base, ko, usenext) do { if constexpr (GATHER) { unsigned _v[2] = { (usenext) ? gAn[h][0] : gA[h][0], (usenext) ? gAn[h][1] : gA[h][1] }; PG8_STAGE(bufoff, cA + (ko), _v); } \
        else { PG8_STAGE(bufoff, ((usenext) ? nA : (cur_base)) + (size_t)(h) * hstep + (ko), voffA); } } while (0)
    { const char* nA = cA; (void)nA;
    PG8_STAGE(PG8_SB(0, 0), cB, voffB); PG8_STAGE(PG8_SB(0, 1), cB + hstep, voffB); PG8_STAGE_A(PG8_SA(0, 0), 0, 0, false); PG8_STAGE_A(PG8_SA(0, 1), 1, 0, false);
    if (wr == 1) PG8_BAR;
    PG8_WAIT_V(2); PG8_BAR;
    PG8_STAGE(PG8_SB(1, 0), cB + kstep, voffB); PG8_STAGE_A(PG8_SA(1, 0), 0, kstep, false); PG8_STAGE(PG8_SB(1, 1), cB + hstep + kstep, voffB);
    PG8_WAIT_V(6); PG8_BAR; }
    for (;;) {
        { int tid2 = threadIdx.x; asm volatile("" : "+v"(tid2));
#pragma unroll
          for (int i = 0; i < 2; ++i) { int R, C; stage_rc(tid2 * 16 + i * 8192, R, C); const int Rb = Epi::PERM ? ((R & ~31) + perm32(R & 31)) : R;
              voffA[i] = (unsigned)(R * K + C) * 2u; voffB[i] = (unsigned)(Rb * K + C) * 2u; } }
        const bool has_next = S.next(ui + 1, nxt);
        const char* nA = has_next ? S.aptr(nxt) : cA; const char* nB = has_next ? S.bptr(nxt) : cB;
        const char* dA = cA; const char* dB = cB; if constexpr (KS) { dA = S.aptr2(cur); dB = S.bptr2(cur); }
        if constexpr (GATHER) { if (has_next) S.gather(nxt, Rr, Cc, K, gAn); else {
#pragma unroll
            for (int h2 = 0; h2 < 2; ++h2) { gAn[h2][0] = gA[h2][0]; gAn[h2][1] = gA[h2][1]; } } }
#pragma unroll 1
        for (int t = 0; t < nt; t += 2) {
            const bool last = (t == nt - 2);
            const char* pa1 = (KS && t >= 8) ? dA : cA; const char* pa2 = (KS && t >= 6) ? dA : cA; const char* pb2 = (KS && t >= 6) ? dB : cB;
            const size_t ko1 = KS ? (size_t)((t + 1) & 7) * kstep : (size_t)(t + 1) * kstep;
            const size_t ko2 = last ? (size_t)0 : (KS ? (size_t)((t + 2) & 7) * kstep : (size_t)(t + 2) * kstep), ko3 = ko2 + kstep;
            const char* b2 = last ? nB : pb2 + ko2; const char* b3 = b2 + kstep;
            PG8_LDB(B0, 0, 0); PG8_LDB(B1, 0, 1); PG8_SCHED; PG8_LDA(At, 0, 0); PG8_STAGE_A2(PG8_SA(1, 1), 1, pa1, ko1, false);
            PG8_WAIT_V(8); PG8_WAIT_L(0); PG8_BAR; PG8_MMA(0, 0, At, B0); PG8_MMA(0, 1, At, B1); PG8_BAR; PG8_SCHED;
            PG8_LDA(At, 0, 1); PG8_STAGE(PG8_SB(0, 0), b2, voffB); PG8_STAGE(PG8_SB(0, 1), b2 + hstep, voffB); PG8_STAGE_A2(PG8_SA(0, 0), 0, pa2, ko2, last);
            PG8_WAIT_V(8); PG8_WAIT_L(0); PG8_BAR; PG8_MMA(1, 0, At, B0); PG8_MMA(1, 1, At, B1); PG8_BAR; PG8_SCHED;
            PG8_LDB(B0, 1, 0); PG8_LDB(B1, 1, 1); PG8_SCHED; PG8_LDA(At, 1, 0); PG8_STAGE_A2(PG8_SA(0, 1), 1, pa2, ko2, last);
            PG8_WAIT_V(8); PG8_WAIT_L(0); PG8_BAR; PG8_MMA(0, 0, At, B0); PG8_MMA(0, 1, At, B1); PG8_BAR; PG8_SCHED;
            PG8_LDA(At, 1, 1); PG8_STAGE(PG8_SB(1, 0), b3, voffB); PG8_STAGE(PG8_SB(1, 1), b3 + hstep, voffB); PG8_STAGE_A2(PG8_SA(1, 0), 0, pa2, ko3, last);
            PG8_WAIT_V(8); PG8_WAIT_L(0); PG8_BAR; PG8_MMA(1, 0, At, B0); PG8_MMA(1, 1, At, B1); PG8_BAR; PG8_SCHED;
            if constexpr (KS) { if (t == 6) { int efr = fr, efq = fq; asm volatile("" : "+v"(efr), "+v"(efq)); E.mid(acc, cur, wr, wc, efr, efq); } }
        }
        if constexpr (ALIGN_EPI) { if (wr == 0) PG8_BAR; }
        { int efr = fr, efq = fq; asm volatile("" : "+v"(efr), "+v"(efq));
          E(acc, cur, wr, wc, efr, efq); }
        if (!has_next) break;
#pragma unroll
        for (int a = 0; a < 2; ++a)
#pragma unroll
            for (int b = 0; b < 2; ++b)
#pragma unroll
                for (int m = 0; m < 4; ++m)
#pragma unroll
                    for (int n = 0; n < 2; ++n) { acc[a][b][m][n] = (f32x4){0.f, 0.f, 0.f, 0.f}; if constexpr (F8) asm volatile("" : "+v"(acc[a][b][m][n])); }
        cur = nxt; cA = nA; cB = nB; ++ui;
        if constexpr (GATHER) {
#pragma unroll
            for (int h2 = 0; h2 < 2; ++h2) { gA[h2][0] = gAn[h2][0]; gA[h2][1] = gAn[h2][1]; } }
        if constexpr (ALIGN_EPI) { if (wr == 1) PG8_BAR; }
    }
    PG8_WAIT_V(0);
    if constexpr (!ALIGN_EPI) { if (wr == 0) PG8_BAR; }
    PG8_BAR;
#undef PG8_SA
#undef PG8_SB
#undef PG8_STAGE
#undef PG8_STAGE_A
#undef PG8_STAGE_A2
#undef PG8_LDA
#undef PG8_LD8
#undef PG8_LDB
#undef PG8_MMA
#undef PG8_WAIT_V
#undef PG8_WAIT_L
#undef PG8_BAR
#undef PG8_SCHED
}
}
using pg8::Unit;

struct Args { const float* in[26]; float* out; unsigned char* ws; };
struct Frame {
    LAS unsigned char* lds;
    volatile LAS unsigned* MISC;
    int tid, lane, wave, vcu, G;
};

struct GOrder {
    pg8::StaticOrder so; const char* A; const char* B; size_t ta, tb;
    __device__ __forceinline__ bool next(int i, Unit& u) const { return so.next(i, u); }
    __device__ __forceinline__ const char* aptr(const Unit& u) const { return A + (size_t)u.pm * ta; }
    __device__ __forceinline__ const char* bptr(const Unit& u) const { return B + (size_t)u.pn * tb; }
};
struct P1Order {
    pg8::StaticOrder so; const char* X; const char* W; size_t t;
    __device__ __forceinline__ bool next(int i, Unit& u) const { return so.next(i, u); }
    __device__ __forceinline__ const char* aptr(const Unit& u) const { return (u.pn == 4 || u.pn == 5) ? W + (size_t)u.pn * t : X + (size_t)u.pm * t; }
    __device__ __forceinline__ const char* bptr(const Unit& u) const { return (u.pn == 4 || u.pn == 5) ? X + (size_t)u.pm * t : W + (size_t)u.pn * t; }
};
struct MergeOrder {
    pg8::StaticOrder so; const char* A; const char* B; size_t ta, tb;
    __device__ __forceinline__ bool next(int i, Unit& u) const { return so.next(i, u); }
    __device__ __forceinline__ const char* aptr(const Unit& u) const { return A + (size_t)u.pm * ta; }
    __device__ __forceinline__ const char* aptr2(const Unit& u) const { return A + (size_t)(u.pm + 128) * ta; }
    __device__ __forceinline__ const char* bptr(const Unit& u) const { return B + (size_t)u.pn * tb; }
    __device__ __forceinline__ const char* bptr2(const Unit& u) const { return B + (size_t)(u.pn + 4) * tb; }
};
struct MoeOrder {
    const int* meta; int G, c; const char* A; const char* B; size_t ta, tb;
    __device__ __forceinline__ bool next(int i, Unit& u) const {
        const int nrb = __builtin_amdgcn_readfirstlane(meta[0]);
        const int rb = i * 64 + (c & 7) * 8 + (c >> 5);
        if (rb >= nrb) return false;
        const int e = __builtin_amdgcn_readfirstlane(meta[16 + rb]);
        u.pm = rb; u.pn = e * 4 + ((c >> 3) & 3); return true;
    }
    __device__ __forceinline__ const char* aptr(const Unit& u) const { return A + (size_t)u.pm * ta; }
    __device__ __forceinline__ const char* bptr(const Unit& u) const { return B + (size_t)u.pn * tb; }
};

struct MoeOrderG {
    const int* meta; const LAS int* rowtok; int G, c; const char* A; const char* B; size_t tb;
    __device__ __forceinline__ bool next(int i, Unit& u) const {
        const int nrb = __builtin_amdgcn_readfirstlane(meta[0]);
        const int rb = i * 64 + (c & 7) * 8 + (c >> 5);
        if (rb >= nrb) return false;
        const int e = __builtin_amdgcn_readfirstlane(meta[16 + rb]);
        u.pm = rb; u.pn = e * 4 + ((c >> 3) & 3); return true;
    }
    __device__ __forceinline__ const char* aptr(const Unit&) const { return A; }
    __device__ __forceinline__ const char* bptr(const Unit& u) const { return B + (size_t)u.pn * tb; }
    __device__ __forceinline__ void gather(const Unit& u, const int (&Rr)[2], const int (&Cc)[2], int K, unsigned (&v)[2][2]) const {
        const LAS int* t = rowtok + (u.pm >> 6) * 256;
#pragma unroll
        for (int h = 0; h < 2; ++h)
#pragma unroll
            for (int i = 0; i < 2; ++i) v[h][i] = ((unsigned)t[h * 128 + Rr[i]] * (unsigned)K + (unsigned)Cc[i]) * 2u;
    }
};

#define EPI_ARGS const f32x4 (&acc)[2][2][4][2], const Unit& u, int wr, int wc, int fr, int fq
__device__ __forceinline__ v4u pack8(f32x4 a, f32x4 b) { v4u w; w.x = cvt_pk_bf16(a[0], a[1]); w.y = cvt_pk_bf16(a[2], a[3]); w.z = cvt_pk_bf16(b[0], b[1]); w.w = cvt_pk_bf16(b[2], b[3]); return w; }

struct EpiIn {
    static constexpr bool PERM = true;
    bf16 *Q, *Kb, *VT, *UG; unsigned char* SG; const float* rstd;
    __device__ __forceinline__ void operator()(EPI_ARGS) const {
        const int pn = u.pn;
        if (pn == 4 || pn == 5) {
#pragma unroll
            for (int bj = 0; bj < 2; ++bj) {
                const int t0 = u.pm * 256 + bj * 128 + wc * 32 + 8 * fq; const int b = t0 >> 13, i0 = t0 & 8191;
                const f32x4 rs0 = *(const f32x4*)(rstd + t0), rs1 = *(const f32x4*)(rstd + t0 + 4);
#pragma unroll
                for (int ai = 0; ai < 2; ++ai)
#pragma unroll
                    for (int m = 0; m < 4; ++m) {
                        const int vr = (pn - 4) * 256 + ai * 128 + wr * 64 + m * 16 + fr;
                        bf16* dst = VT + ((size_t)(b * 512 + vr)) * LPB + 32 + i0;
                        *(v4u*)dst = pack8(acc[ai][bj][m][0] * rs0, acc[ai][bj][m][1] * rs1);
                    }
            }
        } else {
#pragma unroll
            for (int ai = 0; ai < 2; ++ai)
#pragma unroll
                for (int m = 0; m < 4; ++m) {
                    const int row = u.pm * 256 + ai * 128 + wr * 64 + m * 16 + fr; const float rs = rstd[row];
#pragma unroll
                    for (int bj = 0; bj < 2; ++bj) {
                        const int col0 = pn * 256 + bj * 128 + wc * 32 + 8 * fq;
                        f32x4 v0 = acc[ai][bj][m][0] * rs, v1 = acc[ai][bj][m][1] * rs;
                        if (pn < 2) { *(v4u*)(Q + (size_t)row * 512 + col0) = pack8(v0 * QSCALE, v1 * QSCALE); }
                        else if (pn < 4) { const int b = row >> 13, i = row & 8191; *(v4u*)(Kb + ((size_t)(b * LPB + 32 + i)) * 512 + (col0 - 512)) = pack8(v0, v1); }
                        else if (pn < 8) { const int c = col0 - 1536; const int mrow = row >> 6;
                            *(v4u*)(UG + ((((size_t)((c >> 4) * 16 + (mrow >> 5)) * 64 + (row & 63)) * 2 + ((c & 15) >> 3)) * 32 + (mrow & 31)) * 8) = pack8(v0, v1); }
                        else {
                            unsigned g0 = 0u, g1 = 0u;
#pragma unroll
                            for (int e = 0; e < 4; ++e) { g0 = __builtin_amdgcn_cvt_pk_u8_f32(floorf(fast_sigmoid(v0[e]) * 256.0f), e, g0); g1 = __builtin_amdgcn_cvt_pk_u8_f32(floorf(fast_sigmoid(v1[e]) * 256.0f), e, g1); }
                            *(v2u*)(SG + (size_t)row * 2048 + (col0 - 2048)) = (v2u){g0, g1};
                        }
                    }
                }
        }
    }
};

struct EpiGlu {
    static constexpr bool PERM = true;
    const bf16* Y; bf16* O; const float* bias;
    __device__ __forceinline__ void operator()(EPI_ARGS) const {
#pragma unroll
        for (int bj = 0; bj < 2; ++bj) {
            const int col0 = u.pn * 256 + bj * 128 + wc * 32 + 8 * fq;
            const f32x4 b0 = *(const f32x4*)(bias + col0), b1 = *(const f32x4*)(bias + col0 + 4);
#pragma unroll
            for (int ai = 0; ai < 2; ++ai)
#pragma unroll
                for (int m = 0; m < 4; ++m) {
                    const int row = u.pm * 256 + ai * 128 + wr * 64 + m * 16 + fr;
                    const v4u yv = *(const v4u*)(Y + (size_t)row * 512 + col0);
                    f32x4 v0 = acc[ai][bj][m][0] + b0, v1 = acc[ai][bj][m][1] + b1;
                    v0[0] = bflo(yv.x) * fast_sigmoid(v0[0]); v0[1] = bfhi(yv.x) * fast_sigmoid(v0[1]); v0[2] = bflo(yv.y) * fast_sigmoid(v0[2]); v0[3] = bfhi(yv.y) * fast_sigmoid(v0[3]);
                    v1[0] = bflo(yv.z) * fast_sigmoid(v1[0]); v1[1] = bfhi(yv.z) * fast_sigmoid(v1[1]); v1[2] = bflo(yv.w) * fast_sigmoid(v1[2]); v1[3] = bfhi(yv.w) * fast_sigmoid(v1[3]);
                    *(v4u*)(O + (size_t)row * 512 + col0) = pack8(v0, v1);
                }
        }
    }
};

struct EpiMerge {
    static constexpr bool PERM = true;
    const unsigned char* SG; bf16* O;
    static __device__ __forceinline__ float gq(unsigned w, int i) { return (float)((w >> (8 * i)) & 0xffu) + 0.5f; }
    __device__ __forceinline__ void mid(f32x4 (&acc)[2][2][4][2], const Unit& u, int wr, int wc, int fr, int fq) const {
#pragma unroll
        for (int ai = 0; ai < 2; ++ai)
#pragma unroll
            for (int m = 0; m < 4; ++m) {
                const int row = u.pm * 256 + ai * 128 + wr * 64 + m * 16 + fr;
#pragma unroll
                for (int bj = 0; bj < 2; ++bj) {
                    const int col0 = u.pn * 256 + bj * 128 + wc * 32 + 8 * fq;
                    const v2u ga = *(const v2u*)(SG + (size_t)row * 2048 + col0), gb = *(const v2u*)(SG + (size_t)row * 2048 + 1024 + col0);
                    f32x4& v0 = acc[ai][bj][m][0]; f32x4& v1 = acc[ai][bj][m][1];
#pragma unroll
                    for (int e = 0; e < 4; ++e) { v0[e] *= gq(ga.x, e) * __builtin_amdgcn_rcpf(gq(gb.x, e)); v1[e] *= gq(ga.y, e) * __builtin_amdgcn_rcpf(gq(gb.y, e)); }
                }
            }
    }
    __device__ __forceinline__ void operator()(EPI_ARGS) const {
#pragma unroll
        for (int ai = 0; ai < 2; ++ai)
#pragma unroll
            for (int m = 0; m < 4; ++m) {
                const int row = u.pm * 256 + ai * 128 + wr * 64 + m * 16 + fr;
#pragma unroll
                for (int bj = 0; bj < 2; ++bj) {
                    const int col0 = u.pn * 256 + bj * 128 + wc * 32 + 8 * fq;
                    const v2u g = *(const v2u*)(SG + (size_t)row * 2048 + 1024 + col0);
                    f32x4 v0 = acc[ai][bj][m][0], v1 = acc[ai][bj][m][1];
#pragma unroll
                    for (int e = 0; e < 4; ++e) { v0[e] *= gq(g.x, e) * 0.00390625f; v1[e] *= gq(g.y, e) * 0.00390625f; }
                    *(v4u*)(O + (size_t)row * 1024 + col0) = pack8(v0, v1);
                }
            }
    }
};

struct EpiOut {
    static constexpr bool PERM = true;
    const float* X; bf16* HB; unsigned char* HB8; float* ssqp;
    __device__ __forceinline__ void operator()(EPI_ARGS) const {
#pragma unroll
        for (int ai = 0; ai < 2; ++ai)
#pragma unroll
            for (int m = 0; m < 4; ++m) {
                const int row = u.pm * 256 + ai * 128 + wr * 64 + m * 16 + fr; float ss = 0.f;
#pragma unroll
                for (int bj = 0; bj < 2; ++bj) {
                    const int col0 = u.pn * 256 + bj * 128 + wc * 32 + 8 * fq;
                    const f32x4 x0 = *(const f32x4*)(X + (size_t)row * D + col0), x1 = *(const f32x4*)(X + (size_t)row * D + col0 + 4);
                    const f32x4 v0 = acc[ai][bj][m][0] + x0, v1 = acc[ai][bj][m][1] + x1;
                    *(v4u*)(HB + (size_t)row * D + col0) = pack8(v0, v1);
                    { int p0 = 0, p1 = 0;
                      p0 = __builtin_amdgcn_cvt_pk_fp8_f32(v0[0], v0[1], p0, false); p0 = __builtin_amdgcn_cvt_pk_fp8_f32(v0[2], v0[3], p0, true);
                      p1 = __builtin_amdgcn_cvt_pk_fp8_f32(v1[0], v1[1], p1, false); p1 = __builtin_amdgcn_cvt_pk_fp8_f32(v1[2], v1[3], p1, true);
                      *(v2u*)(HB8 + (size_t)row * D + col0) = (v2u){(unsigned)p0, (unsigned)p1}; }
                    ss += (v0[0] * v0[0] + v0[1] * v0[1]) + (v0[2] * v0[2] + v0[3] * v0[3]) + (v1[0] * v1[0] + v1[1] * v1[1]) + (v1[2] * v1[2] + v1[3] * v1[3]);
                }
                { const int ln = fq * 16 + fr; ss += shx(ss, 16, ln); ss += shx(ss, 32, ln); }
                if (fq == 0) ssqp[(size_t)row * 16 + u.pn * 4 + wc] = ss;
            }
    }
};

struct EpiUp {
    static constexpr bool PERM = true;
    const float* srs; unsigned char* HID;
    __device__ __forceinline__ void operator()(EPI_ARGS) const {
        const int pnl = u.pn & 3;
#pragma unroll
        for (int ai = 0; ai < 2; ++ai)
#pragma unroll
            for (int m = 0; m < 4; ++m) {
                const int slot = u.pm * 256 + ai * 128 + wr * 64 + m * 16 + fr; const float rs = srs[slot];
                f32x4 h0, h1;
#pragma unroll
                for (int e = 0; e < 4; ++e) {
                    const float a0 = acc[ai][0][m][0][e] * rs, c0 = acc[ai][1][m][0][e] * rs; h0[e] = a0 * fast_sigmoid(a0) * c0 * 4.0f;
                    const float a1 = acc[ai][0][m][1][e] * rs, c1 = acc[ai][1][m][1][e] * rs; h1[e] = a1 * fast_sigmoid(a1) * c1 * 4.0f;
                }
                int p0 = 0, p1 = 0;
                p0 = __builtin_amdgcn_cvt_pk_fp8_f32(h0[0], h0[1], p0, false); p0 = __builtin_amdgcn_cvt_pk_fp8_f32(h0[2], h0[3], p0, true);
                p1 = __builtin_amdgcn_cvt_pk_fp8_f32(h1[0], h1[1], p1, false); p1 = __builtin_amdgcn_cvt_pk_fp8_f32(h1[2], h1[3], p1, true);
                *(v2u*)(HID + (size_t)slot * FF + pnl * 128 + wc * 32 + 8 * fq) = (v2u){(unsigned)p0, (unsigned)p1};
            }
    }
};

struct EpiDown {
    static constexpr bool PERM = true;
    const int* sdst; const float* sgate; unsigned char* YB;
    __device__ __forceinline__ void operator()(EPI_ARGS) const {
        const int pnl = u.pn & 3;
#pragma unroll
        for (int ai = 0; ai < 2; ++ai)
#pragma unroll
            for (int m = 0; m < 4; ++m) {
                const int slot = u.pm * 256 + ai * 128 + wr * 64 + m * 16 + fr; const int dst = sdst[slot]; const float gt = sgate[slot] * 16.0f;
                if (dst >= 0) {
#pragma unroll
                    for (int bj = 0; bj < 2; ++bj) {
                        const f32x4 a = acc[ai][bj][m][0] * gt, c2 = acc[ai][bj][m][1] * gt; int p0 = 0, p1 = 0;
                        p0 = __builtin_amdgcn_cvt_pk_fp8_f32(a[0], a[1], p0, false); p0 = __builtin_amdgcn_cvt_pk_fp8_f32(a[2], a[3], p0, true);
                        p1 = __builtin_amdgcn_cvt_pk_fp8_f32(c2[0], c2[1], p1, false); p1 = __builtin_amdgcn_cvt_pk_fp8_f32(c2[2], c2[3], p1, true);
                        *(v2u*)(YB + ((unsigned)dst * (unsigned)D + (unsigned)(pnl * 256 + bj * 128 + wc * 32 + 8 * fq))) = (v2u){(unsigned)p0, (unsigned)p1};
                    }
                }
            }
    }
};

__device__ __forceinline__ void p0_transpose_block(const float* W, int N, int k0, int n0, bf16* dst, int ldk, const float* ksc, LAS float* scr, int lane) {
#pragma unroll 8
    for (int i = 0; i < 32; ++i) { const int kk = 2 * i + (lane >> 5); float v = W[(size_t)(k0 + kk) * N + n0 + (lane & 31)]; if (ksc) v *= ksc[k0 + kk]; scr[kk * 33 + (lane & 31)] = v; }
    LDS_WAIT(); asm volatile("" ::: "memory");
    const int c = lane & 7;
#pragma unroll
    for (int j = 0; j < 4; ++j) { const int n = (lane >> 3) + 8 * j; const LAS float* s = scr + (8 * c) * 33 + n;
        v4u o; o.x = cvt_pk_bf16(s[0 * 33], s[1 * 33]); o.y = cvt_pk_bf16(s[2 * 33], s[3 * 33]); o.z = cvt_pk_bf16(s[4 * 33], s[5 * 33]); o.w = cvt_pk_bf16(s[6 * 33], s[7 * 33]);
        *(v4u*)(dst + (size_t)n * ldk + k0 + 8 * c) = o; }
    LDS_WAIT(); asm volatile("" ::: "memory");
}


__device__ __forceinline__ float gelu_tanh(float x) { const float u = 0.7978845608028654f * (x + 0.044715f * x * x * x); return x * fast_sigmoid(2.0f * u); }
typedef unsigned short us4 __attribute__((ext_vector_type(4)));

__device__ __forceinline__ void attn_unit(const bf16* Qb, const bf16* Kb, const bf16* VT, bf16* Ob, int b, int head, int qb, int lane, LAS unsigned char* wl) {
    const int l31 = lane & 31, h = lane >> 5;
    const int row = b * SEQ + qb * 32 + l31;
    bf16x8 qf[4];
#pragma unroll
    for (int st = 0; st < 4; ++st) qf[st] = *(const bf16x8*)(Qb + (size_t)row * 512 + head * 64 + 16 * st + 8 * h);
    const int Pq0 = 16 + qb * 32, qpos = Pq0 + l31;
    f32x16 o0, o1;
#pragma unroll
    for (int r = 0; r < 16; ++r) { o0[r] = 0.f; o1[r] = 0.f; }
    float carry = 1.f;
    LAS unsigned char* kl = wl; LAS unsigned char* vl = wl + 32 * 144;
    const bf16* kg = Kb + ((size_t)b * LPB + 16 + (lane >> 3)) * 512 + head * 64 + (lane & 7) * 8;
    const bf16* vg = VT + ((size_t)(b * 512 + head * 64 + (lane >> 2))) * LPB + 16 + (lane & 3) * 8;
    const int kwo = (lane >> 3) * 144 + (lane & 7) * 16, vwo = (lane >> 2) * 72 + (lane & 3) * 16;
    v4u krx[4], vrx[4], kry[4], vry[4];
#define ATT_GLOAD(kr, vr, kbx) do { _Pragma("unroll") for (int i = 0; i < 4; ++i) { kr[i] = *(const v4u*)(kg + (long)((kbx) + 8 * i) * 512); vr[i] = *(const v4u*)(vg + (size_t)(16 * i) * LPB + (long)(kbx)); } } while (0)
#define ATT_STAGE(kr, vr) do { _Pragma("unroll") for (int i = 0; i < 4; ++i) { *(LAS v4u*)(kl + kwo + i * 8 * 144) = kr[i]; \
        *(LAS v2u*)(vl + vwo + i * 16 * 72) = (v2u){vr[i].x, vr[i].y}; *(LAS v2u*)(vl + vwo + i * 16 * 72 + 8) = (v2u){vr[i].z, vr[i].w}; } } while (0)
#define ATT_FRAGS(Sx, vax, vbx) do { bf16x8 kf_[4]; _Pragma("unroll") for (int st = 0; st < 4; ++st) kf_[st] = *(const LAS bf16x8*)(kl + l31 * 144 + st * 32 + 16 * h); \
        _Pragma("unroll") for (int db = 0; db < 2; ++db) _Pragma("unroll") for (int s2 = 0; s2 < 2; ++s2) { const LAS unsigned char* vp = vl + (db * 32 + l31) * 72 + (16 * s2 + 4 * h) * 2; vax[db][s2] = *(const LAS v2u*)vp; vbx[db][s2] = *(const LAS v2u*)(vp + 16); } \
        _Pragma("unroll") for (int r = 0; r < 16; ++r) Sx[r] = 0.f; \
        _Pragma("unroll") for (int st = 0; st < 4; ++st) Sx = __builtin_amdgcn_mfma_f32_32x32x16_bf16(kf_[st], qf[st], Sx, 0, 0, 0); } while (0)
#define ATT_TILE(Sx, vax, vbx, kbx) do { \
        float be[16], kp[16]; \
        const bool boundary = ((kbx) + 31 >= Pq0) || ((kbx) < 0);        \
        _Pragma("unroll") for (int r = 0; r < 16; ++r) { const float e = __builtin_amdgcn_exp2f(-Sx[r]); be[r] = __builtin_amdgcn_rcpf(1.0f + e); kp[r] = 1.0f - be[r]; } \
        if (boundary) { _Pragma("unroll") for (int r = 0; r < 16; ++r) { const int key = (kbx) + (r & 3) + 8 * (r >> 2) + 4 * h; const bool valid = (key < qpos) && (key >= 0); \
                be[r] = valid ? be[r] : 0.f; kp[r] = valid ? kp[r] : 1.f; } } \
        float gs[4], pg[4]; \
        _Pragma("unroll") for (int g = 0; g < 4; ++g) { gs[g] = (kp[4 * g] * kp[4 * g + 1]) * (kp[4 * g + 2] * kp[4 * g + 3]); pg[g] = shx(gs[g], 32, lane); } \
        float w[16]; float later = carry; \
        _Pragma("unroll") for (int g = 3; g >= 0; --g) { \
            const float p3 = later * (h == 0 ? pg[g] : 1.f); \
            const float p2 = p3 * kp[4 * g + 3], p1 = p2 * kp[4 * g + 2], p0 = p1 * kp[4 * g + 1]; \
            w[4 * g + 3] = be[4 * g + 3] * p3; w[4 * g + 2] = be[4 * g + 2] * p2; w[4 * g + 1] = be[4 * g + 1] * p1; w[4 * g] = be[4 * g] * p0; \
            later *= gs[g] * pg[g]; } \
        carry = later; \
        _Pragma("unroll") for (int s2 = 0; s2 < 2; ++s2) { \
            v4u wp; wp.x = cvt_pk_bf16(w[8 * s2], w[8 * s2 + 1]); wp.y = cvt_pk_bf16(w[8 * s2 + 2], w[8 * s2 + 3]); wp.z = cvt_pk_bf16(w[8 * s2 + 4], w[8 * s2 + 5]); wp.w = cvt_pk_bf16(w[8 * s2 + 6], w[8 * s2 + 7]); \
            const bf16x8 wf = __builtin_bit_cast(bf16x8, wp); \
            v4u v0; v0.x = vax[0][s2].x; v0.y = vax[0][s2].y; v0.z = vbx[0][s2].x; v0.w = vbx[0][s2].y; \
            v4u v1; v1.x = vax[1][s2].x; v1.y = vax[1][s2].y; v1.z = vbx[1][s2].x; v1.w = vbx[1][s2].y; \
            o0 = __builtin_amdgcn_mfma_f32_32x32x16_bf16(__builtin_bit_cast(bf16x8, v0), wf, o0, 0, 0, 0); \
            o1 = __builtin_amdgcn_mfma_f32_32x32x16_bf16(__builtin_bit_cast(bf16x8, v1), wf, o1, 0, 0, 0); } } while (0)
#define ATT_STEP(kr, vr, kbx) do { ATT_STAGE(kr, vr); const int kb2_ = ((kbx) - 64 > -32) ? (kbx) - 64 : (kbx); ATT_GLOAD(kr, vr, kb2_); \
        f32x16 S_; v2u va_[2][2], vb_[2][2]; ATT_FRAGS(S_, va_, vb_); ATT_TILE(S_, va_, vb_, kbx); } while (0)
    ATT_GLOAD(krx, vrx, Pq0);
    { const int kb1 = (Pq0 - 32 > -32) ? Pq0 - 32 : Pq0; ATT_GLOAD(kry, vry, kb1); }
    for (int kb = Pq0; ; kb -= 64) {
        ATT_STEP(krx, vrx, kb);
        if (__all(carry < 9.3132257e-10f)) break;
        if (!((kb - 32) > -32)) break;
        ATT_STEP(kry, vry, kb - 32);
        if (__all(carry < 9.3132257e-10f)) break;
        if (!((kb - 64) > -32)) break;
    }
#undef ATT_STEP
#undef ATT_TILE
#undef ATT_GLOAD
#undef ATT_STAGE
#undef ATT_FRAGS
    bf16* op = Ob + (size_t)row * 512 + head * 64 + 4 * h;
#pragma unroll
    for (int g = 0; g < 4; ++g) {
        v2u a; a.x = cvt_pk_bf16(o0[4 * g], o0[4 * g + 1]); a.y = cvt_pk_bf16(o0[4 * g + 2], o0[4 * g + 3]); *(v2u*)(op + 8 * g) = a;
        v2u d; d.x = cvt_pk_bf16(o1[4 * g], o1[4 * g + 1]); d.y = cvt_pk_bf16(o1[4 * g + 2], o1[4 * g + 3]); *(v2u*)(op + 32 + 8 * g) = d;
    }
}


struct Tr64 { const float* W; int N, k0, n0, ldk; bf16* dst; const float* ksc; int f8; float osc; };
__device__ __forceinline__ void tr64_load(const Tr64& t, f32x4 (&v)[16], int lane) {
    const float* p = t.W + (size_t)(t.k0 + (lane >> 4)) * t.N + t.n0 + 4 * (lane & 15);
#pragma unroll
    for (int i = 0; i < 16; ++i) v[i] = __builtin_nontemporal_load((const f32x4*)(p + (size_t)(4 * i) * t.N));
}
__device__ __forceinline__ void tr64_store(const Tr64& t, const f32x4 (&v)[16], LAS float* scr, int lane) {
    const int cch = lane & 7;
    f32x4 g0 = (f32x4){1.f, 1.f, 1.f, 1.f}, g1 = g0;
    if (t.ksc) { g0 = *(const f32x4*)(t.ksc + t.k0 + 8 * cch); g1 = *(const f32x4*)(t.ksc + t.k0 + 8 * cch + 4); }
    { LAS float* w = scr + (lane >> 4) * 65 + 4 * (lane & 15);
#pragma unroll
        for (int i = 0; i < 16; ++i) { w[(4 * i) * 65 + 0] = v[i][0]; w[(4 * i) * 65 + 1] = v[i][1]; w[(4 * i) * 65 + 2] = v[i][2]; w[(4 * i) * 65 + 3] = v[i][3]; } }
    LDS_WAIT(); asm volatile("" ::: "memory");
    if (t.f8) { g0 = g0 * t.osc; g1 = g1 * t.osc;
#pragma unroll
        for (int jj = 0; jj < 8; ++jj) { const int n = (lane >> 3) + 8 * jj; const LAS float* sp = scr + (8 * cch) * 65 + n; int p0 = 0, p1 = 0;
            p0 = __builtin_amdgcn_cvt_pk_fp8_f32(sp[0 * 65] * g0[0], sp[1 * 65] * g0[1], p0, false); p0 = __builtin_amdgcn_cvt_pk_fp8_f32(sp[2 * 65] * g0[2], sp[3 * 65] * g0[3], p0, true);
            p1 = __builtin_amdgcn_cvt_pk_fp8_f32(sp[4 * 65] * g1[0], sp[5 * 65] * g1[1], p1, false); p1 = __builtin_amdgcn_cvt_pk_fp8_f32(sp[6 * 65] * g1[2], sp[7 * 65] * g1[3], p1, true);
            *(v2u*)((unsigned char*)t.dst + (size_t)n * t.ldk + t.k0 + 8 * cch) = (v2u){(unsigned)p0, (unsigned)p1}; }
    } else {
#pragma unroll
    for (int jj = 0; jj < 8; ++jj) { const int n = (lane >> 3) + 8 * jj; const LAS float* sp = scr + (8 * cch) * 65 + n;
        v4u o; o.x = cvt_pk_bf16(sp[0 * 65] * g0[0], sp[1 * 65] * g0[1]); o.y = cvt_pk_bf16(sp[2 * 65] * g0[2], sp[3 * 65] * g0[3]);
        o.z = cvt_pk_bf16(sp[4 * 65] * g1[0], sp[5 * 65] * g1[1]); o.w = cvt_pk_bf16(sp[6 * 65] * g1[2], sp[7 * 65] * g1[3]);
        *(v4u*)(t.dst + (size_t)n * t.ldk + t.k0 + 8 * cch) = o; }
    }
    LDS_WAIT(); asm volatile("" ::: "memory");
}
constexpr int I_E1 = 32 * 16 * 8, I_E3 = I_E1, I_E2 = 32 * 8 * 16, NEX = I_E1 + I_E3 + I_E2;
__device__ __forceinline__ Tr64 expert_item(int r, const float* ew1, const float* ew3, const float* ew2, const float* g_ffn, bf16* WupT, bf16* W2T) {
    Tr64 t; t.f8 = 1;
    if (r < I_E1 + I_E3) { const int w3 = r >= I_E1; if (w3) r -= I_E1; const int e = r >> 7; t.k0 = 64 * ((r >> 3) & 15); t.n0 = 64 * (r & 7);
        const int drow = (t.n0 >> 7) * 256 + (t.n0 & 127) + (w3 ? 128 : 0);
        t.W = (w3 ? ew3 : ew1) + (size_t)e * D * FF; t.N = FF; t.dst = (bf16*)((unsigned char*)WupT + ((size_t)e * 1024 + drow) * 1024); t.ldk = 1024; t.ksc = g_ffn; t.osc = 32.0f; }
    else { r -= I_E1 + I_E3; const int e = r >> 7; t.k0 = 64 * ((r >> 4) & 7); t.n0 = 64 * (r & 15);
        t.W = ew2 + (size_t)e * FF * D; t.N = D; t.dst = (bf16*)((unsigned char*)W2T + ((size_t)e * 1024 + t.n0) * 512); t.ldk = 512; t.ksc = nullptr; t.osc = 16.0f; }
    return t;
}

__global__ void __launch_bounds__(NWAVES * 64, 2) fwd_kernel(Args args) {
    extern __shared__ __attribute__((aligned(16))) unsigned char lds_raw[];
    Frame F;
    F.lds = (LAS unsigned char*)lds_raw;
    F.MISC = (volatile LAS unsigned*)(F.lds + MISC_OFF);
    F.tid = threadIdx.x; F.lane = F.tid & 63; F.wave = __builtin_amdgcn_readfirstlane(F.tid >> 6);
    F.G = gridDim.x; { const int bx = blockIdx.x; F.vcu = (F.G % 8 == 0) ? (bx % 8) * (F.G / 8) + bx / 8 : bx; }
    unsigned char* ws = args.ws;
    gu32* ctl = (gu32*)(ws + WS_CTL);
    for (int u = F.tid; u < (LDS_BYTES - LDSCTL_OFF) / 4; u += NWAVES * 64) ((LAS unsigned*)(F.lds + LDSCTL_OFF))[u] = 0u;
    __syncthreads();
    XcdBarrier bar = xcd_barrier_post((unsigned*)(ctl + CW_BAR), F.MISC + 8);
    const int wave = F.wave, c = F.vcu;
    const int gw = c * NWAVES + wave, NGW = F.G * NWAVES;

    const float* x = args.in[0]; const float* meta_tok = args.in[1]; const float* g_mix = args.in[2]; const float* w_in = args.in[3];
    const float* lam_re = args.in[4]; const float* lam_im = args.in[5]; const float* log_dt = args.in[6];
    const float* b_re = args.in[7]; const float* b_im = args.in[8]; const float* c_re = args.in[9]; const float* c_im = args.in[10];
    const float* ssm_d = args.in[11]; const float* glu_w = args.in[12]; const float* glu_b = args.in[13];
    const float* w_pa = args.in[14]; const float* w_pb = args.in[15]; const float* w_out = args.in[16]; const float* g_ffn = args.in[17];
    const float* rg_w = args.in[18]; const float* rg_b = args.in[19]; const float* re_w = args.in[20]; const float* re_b = args.in[21];
    const float* ew1 = args.in[22]; const float* ew3 = args.in[23]; const float* ew2 = args.in[24]; const float* g_fin = args.in[25];
    float* out = args.out;
    float* rstd1 = (float*)(ws + SM_RSTD1); float* rstd2 = (float*)(ws + SM_RSTD2);
    int* eid = (int*)(ws + SM_EID); float* gatev = (float*)(ws + SM_GATE); int* cntg = (int*)(ws + SM_CNT);
    float* umeta = (float*)(ws + SM_UMETA); float* bbar_g = (float*)(ws + SM_BBAR); float* lbar_g = (float*)(ws + SM_LBAR); float* l64_g = (float*)(ws + SM_L64);
    int* sdst = (int*)(ws + SM_SDST); float* sgate = (float*)(ws + SM_SGATE); float* srs = (float*)(ws + SM_SRS);
    float* metapart = (float*)(ws + SM_METAP);
    bf16* wr_t = (bf16*)(ws + SM_WR); float* rbias = (float*)(ws + SM_RB); int* moemeta = (int*)(ws + SM_MOEMETA); float* ssqp = (float*)(ws + SM_SSQP);
    bf16* WinT = (bf16*)(ws + WS_WIN); bf16* WpabT = (bf16*)(ws + WS_WPAB); bf16* WoT = (bf16*)(ws + WS_WO); bf16* GluT = (bf16*)(ws + WS_GLU);
    bf16* KT = (bf16*)(ws + WS_KT); bf16* T2 = (bf16*)(ws + WS_T2); bf16* T3 = (bf16*)(ws + WS_T3);
    bf16* WupT = (bf16*)(ws + WS_WUP); bf16* W2T = (bf16*)(ws + WS_W2);
    unsigned char* XB = ws + WS_XB; bf16* MRG = (bf16*)(ws + WS_XB);
    bf16* Qb = (bf16*)(ws + WS_Q); bf16* SSMb = (bf16*)(ws + WS_SSM); bf16* Kb = (bf16*)(ws + WS_K); bf16* VT = (bf16*)(ws + WS_VT);
    bf16* UG = (bf16*)(ws + WS_UG); bf16* Yb = (bf16*)(ws + WS_Y); float* Sst = (float*)(ws + WS_S); bf16* Xs = (bf16*)(ws + WS_XS);
    bf16* H1B = (bf16*)(ws + WS_H1B); unsigned char* H1B8 = ws + WS_H1B8; unsigned char* HID = ws + WS_HID; unsigned char* YB = (unsigned char*)(ws + WS_YB);
    unsigned char* SG = ws + WS_SG;
    int* inv_tok = (int*)(ws + WS_INV); float* inv_gate = (float*)(ws + WS_INV + (size_t)NE * CAPE * 4); float* inv_rs = (float*)(ws + WS_INV + (size_t)2 * NE * CAPE * 4);
    int* mymeta = (int*)(ws + WS_MWG) + (size_t)blockIdx.x * 512; unsigned* etot = (unsigned*)(ctl + CW_TOT);

    for (int rep = 0; rep < REP_P0; ++rep) {
        int tid = threadIdx.x; asm volatile("" : "+v"(tid)); const int lane = tid & 63; (void)lane;
        if (rep) { __syncthreads(); if (tid == 0) F.MISC[0] = 0u; __syncthreads(); }
        if (c & 1) {
            LAS float* scr = (LAS float*)(F.lds + wave * P0_SCR);
            constexpr int I_IN = 16 * 64, I_PA = 8 * 16, I_PB = 8 * 16, I_O = 16 * 16, I_G = 8 * 8;
            constexpr int NTR = I_IN + I_PA + I_PB + I_O + I_G, NXR = M / 4, NITEMS = NTR + NXR;
            const int per_wg = (REP_P0S * NITEMS + F.G - 1) / F.G;
            for (;;) {
                int kq = 0; if (lane == 0) kq = (int)__hip_atomic_fetch_add((unsigned*)(F.MISC + 0), 1u, __ATOMIC_RELAXED, __HIP_MEMORY_SCOPE_WORKGROUP);
                kq = __builtin_amdgcn_readfirstlane(kq);
                if (kq >= per_wg) break;
                int it = kq * F.G + c; if (it >= REP_P0S * NITEMS) break;
                if (REP_P0S > 1) it %= NITEMS;
                if (it >= NTR) {
                    const int m0 = (it - NTR) * 4; f32x4 v[4][4];
#pragma unroll
                    for (int q = 0; q < 4; ++q) { const f32x4* xr = (const f32x4*)(x + (size_t)(m0 + q) * D) + lane;
#pragma unroll
                        for (int jj = 0; jj < 4; ++jj) v[q][jj] = __builtin_nontemporal_load(&xr[64 * jj]); }
#pragma unroll
                    for (int q = 0; q < 4; ++q) { float ss = 0.f;
#pragma unroll
                        for (int jj = 0; jj < 4; ++jj) ss += (v[q][jj][0] * v[q][jj][0] + v[q][jj][1] * v[q][jj][1]) + (v[q][jj][2] * v[q][jj][2] + v[q][jj][3] * v[q][jj][3]);
                        ss = wave_sum(ss, lane);
                        if (lane == 0) rstd1[m0 + q] = 1.0f / sqrtf(ss * (1.0f / D) + RMS_EPS);
                        unsigned* o4 = (unsigned*)(XB + (size_t)(m0 + q) * D) + lane;
#pragma unroll
                        for (int jj = 0; jj < 4; ++jj) { int p = 0; p = __builtin_amdgcn_cvt_pk_fp8_f32(v[q][jj][0], v[q][jj][1], p, false); p = __builtin_amdgcn_cvt_pk_fp8_f32(v[q][jj][2], v[q][jj][3], p, true); o4[64 * jj] = (unsigned)p; } }
                    continue;
                }
                int r = it; const float* W; int N, k0, n0, ldk; bf16* dst; const float* ksc = nullptr; int f8 = 0; float osc = 1.0f;
                if (r < I_IN) { W = w_in; N = INC; k0 = 64 * (r >> 6); n0 = 64 * (r & 63); dst = (bf16*)((unsigned char*)WinT + (size_t)n0 * 1024); ldk = 1024; ksc = g_mix; f8 = 1; osc = 32.0f; }
                else if ((r -= I_IN) < I_PA) { W = w_pa; N = D; k0 = 64 * (r >> 4); n0 = 64 * (r & 15); dst = WpabT + (size_t)n0 * 512; ldk = 512; }
                else if ((r -= I_PA) < I_PB) { W = w_pb; N = D; k0 = 64 * (r >> 4); n0 = 64 * (r & 15); dst = WpabT + (size_t)(1024 + n0) * 512; ldk = 512; }
                else if ((r -= I_PB) < I_O) { W = w_out; N = D; k0 = 64 * (r >> 4); n0 = 64 * (r & 15); dst = WoT + (size_t)n0 * 1024; ldk = 1024; }
                else { r -= I_O; W = glu_w; N = SW; k0 = 64 * (r >> 3); n0 = 64 * (r & 7); dst = GluT + (size_t)n0 * 512; ldk = 512; }
                { Tr64 t; t.W = W; t.N = N; t.k0 = k0; t.n0 = n0; t.ldk = ldk; t.dst = dst; t.ksc = ksc; t.f8 = f8; t.osc = osc; f32x4 tv[16]; tr64_load(t, tv, lane); tr64_store(t, tv, scr, lane); }
            }
            __syncthreads();
        }
        {
            const int g = c >> 3, j = c & 7;
            LAS f32x2* LP = (LAS f32x2*)(F.lds);
            LAS f32x2* BB = (LAS f32x2*)(F.lds + 33792);
            LAS f32x2* CC = (LAS f32x2*)(F.lds + 33792 + 8192);
            LAS f32x2* CL = (LAS f32x2*)(F.lds + 33792 + 16384);
            LAS float* mrs = (LAS float*)(F.lds + 33792 + 16384 + 65536);
            const float dt = expf(log_dt[g]);
#pragma unroll 1
            for (int idx = tid; idx < 65 * 64; idx += 512) {
                const int n = idx >> 6, p = idx & 63; const float lr = lam_re[g * 64 + p], li = lam_im[g * 64 + p];
                const float mag = expf((float)n * (lr * dt));
                const float rev1 = (li * dt) * 0.15915494309189535f; const float hi = (float)n * rev1; const float lo = fmaf((float)n, rev1, -hi);
                const float fr_ = (hi - rintf(hi)) + lo; const float sn = __builtin_amdgcn_sinf(fr_), cs = __builtin_amdgcn_cosf(fr_);
                LP[idx] = (f32x2){mag * cs, mag * sn};
            }
            for (int idx = tid; idx < 1024; idx += 512) { const int cc = idx >> 6, p = idx & 63; CC[idx] = (f32x2){c_re[(g * 16 + cc) * 64 + p], c_im[(g * 16 + cc) * 64 + p]}; }
            for (int r = 2 * wave; r < 2 * wave + 2; ++r) {
                float ss = 0.f;
#pragma unroll
                for (int i = 0; i < 16; ++i) { const float v = meta_tok[r * 1024 + lane + 64 * i]; ss += v * v; }
                ss = wave_sum(ss, lane);
                if (lane == 0) mrs[r] = 1.0f / sqrtf(ss * (1.0f / 1024.0f) + RMS_EPS);
            }
            __syncthreads();
            for (int idx = tid; idx < 1024; idx += 512) {
                const int p = idx >> 4, cp = idx & 15; const float lr = lam_re[g * 64 + p], li = lam_im[g * 64 + p];
                const f32x2 L1 = LP[64 + p]; const float nr = L1.x - 1.0f, ni = L1.y, den = lr * lr + li * li;
                const float fre = (nr * lr + ni * li) / den, fim = (ni * lr - nr * li) / den;
                const float br = b_re[(g * 64 + p) * 16 + cp], bi = b_im[(g * 64 + p) * 16 + cp];
                const f32x2 v = (f32x2){fre * br - fim * bi, fre * bi + fim * br};
                BB[idx] = v;
                if (j == 0) { bbar_g[((g * 64 + p) * 16 + cp) * 2] = v.x; bbar_g[((g * 64 + p) * 16 + cp) * 2 + 1] = v.y; }
            }
#pragma unroll 2
            for (int idx = tid; idx < 8192; idx += 512) { const int nl = idx >> 10, cc = (idx >> 6) & 15, p = idx & 63; const f32x2 C = CC[cc * 64 + p], L = LP[(8 * j + nl) * 64 + p];
                CL[idx] = (f32x2){C.x * L.x - C.y * L.y, C.x * L.y + C.y * L.x}; }
            if (j == 0 && tid < 64) { const f32x2 L1 = LP[64 + tid], L64 = LP[64 * 64 + tid];
                lbar_g[(g * 64 + tid) * 2] = L1.x; lbar_g[(g * 64 + tid) * 2 + 1] = L1.y; l64_g[(g * 64 + tid) * 2] = L64.x; l64_g[(g * 64 + tid) * 2 + 1] = L64.y; }
            __syncthreads();
#pragma unroll 1
            for (int idx = tid; idx < 2048; idx += 512) {
                const int nl = idx >> 8, cc = (idx >> 4) & 15, cp = idx & 15; float a = 0.f;
                const LAS f32x2* clp = CL + (nl * 16 + cc) * 64;
#pragma unroll 8
                for (int p = 0; p < 64; ++p) { const f32x2 X = clp[p], B = BB[p * 16 + cp]; a += X.x * B.x - X.y * B.y; }
                const int n = 8 * j + nl;
                if (n == 0 && cc == cp) a += ssm_d[g * 16 + cc];
                KT[((size_t)(g * KT_ROWS + n + 1)) * 256 + cc * 16 + cp] = (bf16)(cvt_pk_bf16(a, 0.f) & 0xffffu);
            }
            if (j == 0 && tid < 256) KT[((size_t)(g * KT_ROWS)) * 256 + tid] = 0;
#pragma unroll 2
            for (int idx = tid; idx < 16384; idx += 512) {
                const int kk = idx & 127, nn = idx >> 7; const int s2 = 8 * j + (kk >> 4), cp = kk & 15, ri = nn >> 6, p = nn & 63;
                const f32x2 L = LP[(63 - s2) * 64 + p], B = BB[p * 16 + cp];
                const float v = ri ? (L.x * B.y + L.y * B.x) : (L.x * B.x - L.y * B.y);
                T2[((((size_t)(g * 4 + (nn >> 5)) * 64 + s2) * 2 + (cp >> 3)) * 32 + (nn & 31)) * 8 + (cp & 7)] = (bf16)(cvt_pk_bf16(v, 0.f) & 0xffffu);
            }
#pragma unroll 2
            for (int idx = tid; idx < 16384; idx += 512) {
                const int kk = idx & 127, nl = idx >> 7; const int t = 8 * j + (nl >> 4), cc = nl & 15, ri = kk >> 6, p = kk & 63;
                const f32x2 L = LP[(t + 1) * 64 + p], C = CC[cc * 64 + p];
                const float v = ri ? -(C.x * L.y + C.y * L.x) : (C.x * L.x - C.y * L.y);
                T3[((((size_t)(g * 32 + (t >> 1)) * 8 + (kk >> 4)) * 2 + ((kk >> 3) & 1)) * 32 + (t & 1) * 16 + cc) * 8 + (kk & 7)] = (bf16)(cvt_pk_bf16(v, 0.f) & 0xffffu);
            }
            float my_rs[16];
            if (wave == 0 && c < 192) {
#pragma unroll
                for (int r = 0; r < 16; ++r) my_rs[r] = mrs[r];
            }
            __syncthreads();
            LAS float* scr = (LAS float*)(F.lds + wave * P0_SCR);
            if (wave == 0 && c < 192) {
                const int cb = c >> 3, kp = c & 7, k0 = 128 * kp, n = 512 + 64 * cb + lane;
#pragma unroll
                for (int r = 0; r < 16; ++r) { const float g0 = g_mix[k0 + lane], g1 = g_mix[k0 + 64 + lane];
                    scr[r * 128 + lane] = meta_tok[r * 1024 + k0 + lane] * my_rs[r] * g0; scr[r * 128 + 64 + lane] = meta_tok[r * 1024 + k0 + 64 + lane] * my_rs[r] * g1; }
                LDS_WAIT(); asm volatile("" ::: "memory");
                float a[16];
#pragma unroll
                for (int r = 0; r < 16; ++r) a[r] = 0.f;
#pragma unroll 4
                for (int k = 0; k < 128; k += 4) {
                    const float w0 = w_in[(size_t)(k0 + k) * INC + n], w1 = w_in[(size_t)(k0 + k + 1) * INC + n], w2 = w_in[(size_t)(k0 + k + 2) * INC + n], w3 = w_in[(size_t)(k0 + k + 3) * INC + n];
#pragma unroll
                    for (int r = 0; r < 16; ++r) { const f32x4 xv = *(const LAS f32x4*)(scr + r * 128 + k); a[r] += xv[0] * w0 + xv[1] * w1 + xv[2] * w2 + xv[3] * w3; }
                }
#pragma unroll
                for (int r = 0; r < 16; ++r) metapart[((size_t)kp * 16 + r) * 1536 + 64 * cb + lane] = a[r];
                LDS_WAIT(); asm volatile("" ::: "memory");
            } else if (wave == 1 && c < 64) {
                const int n = c;
#pragma unroll 4
                for (int i = 0; i < 16; ++i) { const int k = lane + 64 * i; float v = 0.f;
                    if (n < 4) v = rg_w[k * 4 + n] * g_ffn[k]; else if (n < 36) v = re_w[k * 32 + (n - 4)] * g_ffn[k];
                    const unsigned hi = cvt_pk_bf16(v, 0.f) & 0xffffu; const float lo = v - bf2f((unsigned short)hi);
                    const int fo = ((((n >> 5) * 64 + (k >> 4)) * 2 + ((k >> 3) & 1)) * 32 + (n & 31)) * 8 + (k & 7);
                    wr_t[fo] = (bf16)hi; wr_t[65536 + fo] = (bf16)(cvt_pk_bf16(lo, 0.f) & 0xffffu); }
                if (lane == 0) rbias[n] = n < 4 ? rg_b[n] : (n < 36 ? re_b[n - 4] : 0.f);
            } else if (wave == 1 && c < 72) {
                const int it = c - 64, b = it >> 1;
                if (it & 1) { for (int idx = lane; idx < 512 * 16; idx += 64) { const int cc = idx >> 4, r = idx & 15; VT[((size_t)(b * 512 + cc)) * LPB + r] = 0; } }
                else { for (int idx = lane; idx < 16 * 512; idx += 64) Kb[((size_t)(b * LPB)) * 512 + idx] = 0; }
            }
            if (!(c & 1)) {
            constexpr int I_IN = 16 * 64, I_PA = 8 * 16, I_PB = 8 * 16, I_O = 16 * 16, I_G = 8 * 8;
            constexpr int NTR = I_IN + I_PA + I_PB + I_O + I_G, NXR = M / 4, NITEMS = NTR + NXR;
            const int per_wg = (REP_P0S * NITEMS + F.G - 1) / F.G;
            for (;;) {
                int kq = 0; if (lane == 0) kq = (int)__hip_atomic_fetch_add((unsigned*)(F.MISC + 0), 1u, __ATOMIC_RELAXED, __HIP_MEMORY_SCOPE_WORKGROUP);
                kq = __builtin_amdgcn_readfirstlane(kq);
                if (kq >= per_wg) break;
                int it = kq * F.G + c; if (it >= REP_P0S * NITEMS) break;
                if (REP_P0S > 1) it %= NITEMS;
                if (it >= NTR) {
                    const int m0 = (it - NTR) * 4; f32x4 v[4][4];
#pragma unroll
                    for (int q = 0; q < 4; ++q) { const f32x4* xr = (const f32x4*)(x + (size_t)(m0 + q) * D) + lane;
#pragma unroll
                        for (int jj = 0; jj < 4; ++jj) v[q][jj] = __builtin_nontemporal_load(&xr[64 * jj]); }
#pragma unroll
                    for (int q = 0; q < 4; ++q) { float ss = 0.f;
#pragma unroll
                        for (int jj = 0; jj < 4; ++jj) ss += (v[q][jj][0] * v[q][jj][0] + v[q][jj][1] * v[q][jj][1]) + (v[q][jj][2] * v[q][jj][2] + v[q][jj][3] * v[q][jj][3]);
                        ss = wave_sum(ss, lane);
                        if (lane == 0) rstd1[m0 + q] = 1.0f / sqrtf(ss * (1.0f / D) + RMS_EPS);
                        unsigned* o4 = (unsigned*)(XB + (size_t)(m0 + q) * D) + lane;
#pragma unroll
                        for (int jj = 0; jj < 4; ++jj) { int p = 0; p = __builtin_amdgcn_cvt_pk_fp8_f32(v[q][jj][0], v[q][jj][1], p, false); p = __builtin_amdgcn_cvt_pk_fp8_f32(v[q][jj][2], v[q][jj][3], p, true); o4[64 * jj] = (unsigned)p; } }
                    continue;
                }
                int r = it; const float* W; int N, k0, n0, ldk; bf16* dst; const float* ksc = nullptr; int f8 = 0; float osc = 1.0f;
                if (r < I_IN) { W = w_in; N = INC; k0 = 64 * (r >> 6); n0 = 64 * (r & 63); dst = (bf16*)((unsigned char*)WinT + (size_t)n0 * 1024); ldk = 1024; ksc = g_mix; f8 = 1; osc = 32.0f; }
                else if ((r -= I_IN) < I_PA) { W = w_pa; N = D; k0 = 64 * (r >> 4); n0 = 64 * (r & 15); dst = WpabT + (size_t)n0 * 512; ldk = 512; }
                else if ((r -= I_PA) < I_PB) { W = w_pb; N = D; k0 = 64 * (r >> 4); n0 = 64 * (r & 15); dst = WpabT + (size_t)(1024 + n0) * 512; ldk = 512; }
                else if ((r -= I_PB) < I_O) { W = w_out; N = D; k0 = 64 * (r >> 4); n0 = 64 * (r & 15); dst = WoT + (size_t)n0 * 1024; ldk = 1024; }
                else { r -= I_O; W = glu_w; N = SW; k0 = 64 * (r >> 3); n0 = 64 * (r & 7); dst = GluT + (size_t)n0 * 512; ldk = 512; }
                { Tr64 t; t.W = W; t.N = N; t.k0 = k0; t.n0 = n0; t.ldk = ldk; t.dst = dst; t.ksc = ksc; t.f8 = f8; t.osc = osc; f32x4 tv[16]; tr64_load(t, tv, lane); tr64_store(t, tv, scr, lane); }
            }
            }
        }
    }
    xcd_barrier(bar);

#if PH_MAX >= 1
    for (int rep = 0; rep < REP_P1; ++rep) {
        P1Order S; S.so.init(M / 256, INC / 256, F.G, (int)blockIdx.x, WGM_P1); S.X = (const char*)XB; S.W = (const char*)WinT; S.t = (size_t)256 * 1024;
        EpiIn E{Qb, Kb, VT, UG, SG, rstd1};
        pg8::gemm_phase<EpiIn, P1Order, true, false, false, true>(F.lds + RING_OFF, 512, S, E, 0x7f7a);
        if (rep == REP_P1 - 1) {
            int tid = threadIdx.x; asm volatile("" : "+v"(tid));
            const int t = c * 512 + tid;
            if (t < 16 * 1536) {
                const int r = t / 1536, n = t % 1536; float sacc = 0.f;
#pragma unroll
                for (int kp = 0; kp < 8; ++kp) sacc += metapart[((size_t)kp * 16 + r) * 1536 + n];
                const bf16 hv = (bf16)(cvt_pk_bf16(sacc, 0.f) & 0xffffu);
                if (n < 512) { for (int b = 0; b < NB; ++b) Kb[((size_t)(b * LPB + 16 + r)) * 512 + n] = hv; }
                else if (n < 1024) { for (int b = 0; b < NB; ++b) VT[((size_t)(b * 512 + (n - 512))) * LPB + 16 + r] = hv; }
                else umeta[r * 512 + (n - 1024)] = sacc;
            }
        }
    }
    xcd_barrier(bar);
#endif


#if PH_MAX >= 2
    for (int rep = 0; rep < REP_SSM; ++rep) {
    if (c < 128) {
        int tid = threadIdx.x; asm volatile("" : "+v"(tid)); const int lane = tid & 63;
        const int b = c >> 5, g = c & 31;
        LAS float* SL = (LAS float*)(F.lds);
        LAS f32x2* ends = (LAS f32x2*)(F.lds + 128 * 129 * 4);
        {
            const int mbl = wave >> 1, nh = wave & 1, mb = 4 * b + mbl;
            const int l31 = lane & 31, h = lane >> 5;
            f32x16 a2[2];
#pragma unroll
            for (int r = 0; r < 16; ++r) { a2[0][r] = 0.f; a2[1][r] = 0.f; }
            const bf16* ua = UG + (size_t)(g * 16 + mb) * 64 * 512 + lane * 8;
            const bf16* t2 = T2 + (size_t)(g * 4 + 2 * nh) * 64 * 512 + lane * 8;
#pragma unroll 8
            for (int s2 = 0; s2 < 64; ++s2) {
                const bf16x8 a = *(const bf16x8*)(ua + s2 * 512);
                const bf16x8 b0 = *(const bf16x8*)(t2 + s2 * 512), b1 = *(const bf16x8*)(t2 + 64 * 512 + s2 * 512);
                a2[0] = __builtin_amdgcn_mfma_f32_32x32x16_bf16(a, b0, a2[0], 0, 0, 0);
                a2[1] = __builtin_amdgcn_mfma_f32_32x32x16_bf16(a, b1, a2[1], 0, 0, 0);
            }
#pragma unroll
            for (int t = 0; t < 2; ++t)
#pragma unroll
                for (int r = 0; r < 16; ++r) SL[(32 * mbl + (r & 3) + 8 * (r >> 2) + 4 * h) * 129 + (2 * nh + t) * 32 + l31] = a2[t][r];
        }
        __syncthreads();
        {
            const int seg = wave & 3, p = lane;
            const float lr = lbar_g[(g * 64 + p) * 2], li = lbar_g[(g * 64 + p) * 2 + 1], qr = l64_g[(g * 64 + p) * 2], qi = l64_g[(g * 64 + p) * 2 + 1];
            float vr[32], vi[32];
            float cr = 0.f, ci = 0.f, q32r = qr, q32i = qi;
            if (wave < 4) {
#pragma unroll
                for (int m = 0; m < 32; ++m) { vr[m] = SL[(32 * seg + m) * 129 + p]; vi[m] = SL[(32 * seg + m) * 129 + 64 + p]; }
                float xr = 0.f, xi = 0.f;
#pragma unroll
                for (int m = 0; m < 32; ++m) { const float sr = vr[m], si = vi[m]; vr[m] = xr; vi[m] = xi; const float nr = qr * xr - qi * xi + sr, ni = qr * xi + qi * xr + si; xr = nr; xi = ni; }
                ends[seg * 64 + p] = (f32x2){xr, xi};
                for (int r = 0; r < NMETA; ++r) {
                    float bur = 0.f, bui = 0.f;
#pragma unroll
                    for (int cp = 0; cp < 16; ++cp) { const float uv = umeta[r * 512 + 16 * g + cp]; bur += bbar_g[((g * 64 + p) * 16 + cp) * 2] * uv; bui += bbar_g[((g * 64 + p) * 16 + cp) * 2 + 1] * uv; }
                    const float nr = lr * cr - li * ci + bur, ni = lr * ci + li * cr + bui; cr = nr; ci = ni;
                }
#pragma unroll
                for (int k = 0; k < 5; ++k) { const float nr = q32r * q32r - q32i * q32i, ni = 2.0f * q32r * q32i; q32r = nr; q32i = ni; }
            }
            __syncthreads();
            if (wave < 4) {
                for (int k = 0; k < seg; ++k) { const f32x2 e = ends[k * 64 + p]; const float nr = q32r * cr - q32i * ci + e.x, ni = q32r * ci + q32i * cr + e.y; cr = nr; ci = ni; }
                float pr_ = 1.f, pi_ = 0.f;
#pragma unroll
                for (int m = 0; m < 32; ++m) {
                    const float Xr = vr[m] + (pr_ * cr - pi_ * ci), Xi = vi[m] + (pr_ * ci + pi_ * cr);
                    { const int mrow = b * 128 + 32 * seg + m;
                      const size_t xo = ((((size_t)(g * 16 + (mrow >> 5)) * 8 + (p >> 4)) * 2 + ((p >> 3) & 1)) * 32 + (mrow & 31)) * 8 + (p & 7);
                      Xs[xo] = (bf16)(cvt_pk_bf16(Xr, 0.f) & 0xffffu); Xs[xo + 4 * 512] = (bf16)(cvt_pk_bf16(Xi, 0.f) & 0xffffu); }
                    const float nr = pr_ * qr - pi_ * qi, ni = pr_ * qi + pi_ * qr; pr_ = nr; pi_ = ni;
                }
            }
        }
        __syncthreads();
    }
    if (rep == 0) {
        int tid = threadIdx.x; asm volatile("" : "+v"(tid)); const int lane = tid & 63; (void)lane;
        LAS float* scr = (LAS float*)(F.lds + wave * P0_SCR);
#pragma unroll 1
        for (int pass = 0; pass < 2; ++pass) {
            const bool do_att = (pass == 0) != (wave >= 4);
            if (do_att) {
                const int nu = (c < 128) ? 3 : 5;
#pragma unroll 1
                for (int rp = 0; rp < REP_ATT; ++rp)
#pragma unroll 1
                for (int i = 0; i < nu; ++i) { const int cc = (i < 4) ? c : c - 128; const int qi = (i < 4) ? i : 3;
                    attn_unit(Qb, Kb, VT, (rp == REP_ATT - 1) ? Qb : SSMb, cc >> 6, wave, (cc & 63) * 4 + qi, lane, (LAS unsigned char*)scr); }
            } else {
#pragma unroll 1
                for (int k = 0; k < 4; k += 2) {
                    const Tr64 ta = expert_item(c + 256 * (wave + 8 * k), ew1, ew3, ew2, g_ffn, WupT, W2T);
                    const Tr64 tb = expert_item(c + 256 * (wave + 8 * (k + 1)), ew1, ew3, ew2, g_ffn, WupT, W2T);
                    f32x4 va[16], vb[16];
                    tr64_load(ta, va, lane); tr64_load(tb, vb, lane);
                    tr64_store(ta, va, scr, lane); tr64_store(tb, vb, scr, lane);
                }
            }
        }
    }
    xcd_barrier(bar);
    for (int ui = 0; ui < 2; ++ui) {
        int tid = threadIdx.x; asm volatile("" : "+v"(tid)); const int lane = tid & 63; (void)lane;
        const int U = c * 2 + ui; const int g = U >> 4, mb = U & 15;
        const int l31 = lane & 31, h = lane >> 5;
        LAS unsigned char* UT = F.lds;
        LAS unsigned char* KTl = F.lds + 65536;
        __syncthreads();
        {
            const unsigned char* usrc = (const unsigned char*)(UG + (size_t)(g * 16 + mb) * 64 * 512);
#pragma unroll
            for (int i = 0; i < 8; ++i) { const int idx = tid + 512 * i; *(LAS v4u*)(UT + idx * 16) = *(const v4u*)(usrc + (size_t)idx * 16); }
            const unsigned char* ksrc = (const unsigned char*)(KT + (size_t)g * KT_ROWS * 256);
            for (int idx = tid; idx < 2080; idx += 512) *(LAS v4u*)(KTl + idx * 16) = *(const v4u*)(ksrc + (size_t)idx * 16);
        }
        f32x16 ac[4];
#pragma unroll
        for (int j = 0; j < 4; ++j)
#pragma unroll
            for (int r = 0; r < 16; ++r) ac[j][r] = 0.f;
        {
            const bf16* xa = Xs + (size_t)(g * 16 + mb) * 8 * 512 + lane * 8;
            const bf16* t3 = T3 + (size_t)(g * 32) * 8 * 512 + lane * 8;
#pragma unroll
            for (int kh = 0; kh < 2; ++kh) {
                bf16x8 xa4[4], tb[4][4];
#pragma unroll
                for (int k2 = 0; k2 < 4; ++k2) { xa4[k2] = *(const bf16x8*)(xa + (kh * 4 + k2) * 512);
#pragma unroll
                    for (int j = 0; j < 4; ++j) { const int tp = (j == 0) ? 2 * wave : (j == 1) ? 2 * wave + 1 : (j == 2) ? 30 - 2 * wave : 31 - 2 * wave; tb[k2][j] = *(const bf16x8*)(t3 + ((size_t)tp * 8 + (kh * 4 + k2)) * 512); } }
#pragma unroll
                for (int k2 = 0; k2 < 4; ++k2)
#pragma unroll
                    for (int j = 0; j < 4; ++j) ac[j] = __builtin_amdgcn_mfma_f32_32x32x16_bf16(xa4[k2], tb[k2][j], ac[j], 0, 0, 0);
            }
        }
        __syncthreads();
        {
            const LAS unsigned char* ap = UT + lane * 16;
            const LAS unsigned char* kp = KTl + (l31 >> 4) * 512 + (l31 & 15) * 32 + 16 * h;
            const int tA0 = 2 * wave, tA1 = 30 - 2 * wave;
            bf16x8 pv0[2], pv1[2];
            pv0[0] = *(const LAS bf16x8*)(kp + (2 * tA0 + 3) * 512); pv0[1] = *(const LAS bf16x8*)(kp + (2 * tA0 + 2) * 512);
            pv1[0] = *(const LAS bf16x8*)(kp + (2 * tA1 + 3) * 512); pv1[1] = *(const LAS bf16x8*)(kp + (2 * tA1 + 2) * 512);
#pragma unroll 1
            for (int s0 = 0; s0 < 64; s0 += 2) {
#pragma unroll
                for (int par = 0; par < 2; ++par) {
                    const int s2 = s0 + par;
                    const bf16x8 a = *(const LAS bf16x8*)(ap + s2 * 1024);
                    if (s2 <= 2 * tA0 + 3) { ac[1] = __builtin_amdgcn_mfma_f32_32x32x16_bf16(a, pv0[par], ac[1], 0, 0, 0);
                        if (s2 <= 2 * tA0 + 1) { const bf16x8 f = *(const LAS bf16x8*)(kp + (2 * tA0 - s2 + 1) * 512); ac[0] = __builtin_amdgcn_mfma_f32_32x32x16_bf16(a, f, ac[0], 0, 0, 0); pv0[par] = f; } }
                    if (s2 <= 2 * tA1 + 3) { ac[3] = __builtin_amdgcn_mfma_f32_32x32x16_bf16(a, pv1[par], ac[3], 0, 0, 0);
                        if (s2 <= 2 * tA1 + 1) { const bf16x8 f = *(const LAS bf16x8*)(kp + (2 * tA1 - s2 + 1) * 512); ac[2] = __builtin_amdgcn_mfma_f32_32x32x16_bf16(a, f, ac[2], 0, 0, 0); pv1[par] = f; } }
                }
            }
        }
#pragma unroll
        for (int j = 0; j < 4; ++j) { const int tp = (j == 0) ? 2 * wave : (j == 1) ? 2 * wave + 1 : (j == 2) ? 30 - 2 * wave : 31 - 2 * wave; const int t = 2 * tp + (l31 >> 4);
#pragma unroll
            for (int r = 0; r < 16; ++r) { const int m = 32 * mb + (r & 3) + 8 * (r >> 2) + 4 * h;
                Yb[((size_t)m * 64 + t) * 512 + 16 * g + (l31 & 15)] = (bf16)(cvt_pk_bf16(gelu_tanh(ac[j][r]), 0.f) & 0xffffu); } }
    }

    xcd_barrier(bar);
    }
    for (int rep = 0; rep < REP_MIX; ++rep) {
    {
        GOrder S; S.so.init(M / 256, SW / 256, F.G, (int)blockIdx.x, WGM_GLU); S.A = (const char*)Yb; S.B = (const char*)GluT; S.ta = (size_t)256 * 512 * 2; S.tb = (size_t)256 * 512 * 2;
        EpiGlu E{Yb, SSMb, glu_b};
        pg8::gemm_phase<EpiGlu, GOrder, true>(F.lds + RING_OFF, 512, S, E);
    }
    xcd_barrier(bar);
    {
        MergeOrder S; S.so.init(M / 256, D / 256, F.G, (int)blockIdx.x, WGM_MRG); S.A = (const char*)Qb; S.B = (const char*)WpabT; S.ta = (size_t)256 * 512 * 2; S.tb = (size_t)256 * 512 * 2;
        EpiMerge E{SG, MRG};
        pg8::gemm_phase<EpiMerge, MergeOrder, true, false, true>(F.lds + RING_OFF, 512, S, E);
    }
    xcd_barrier(bar);
    {
        GOrder S; S.so.init(M / 256, D / 256, F.G, (int)blockIdx.x, WGM_WO); S.A = (const char*)MRG; S.B = (const char*)WoT; S.ta = (size_t)256 * 1024 * 2; S.tb = (size_t)256 * 1024 * 2;
        EpiOut E{x, H1B, H1B8, ssqp};
        pg8::gemm_phase<EpiOut, GOrder, true>(F.lds + RING_OFF, 1024, S, E);
    }
    xcd_barrier(bar);
    }
#endif

#if PH_MAX >= 3
    for (int rep = 0; rep < REP_RT; ++rep) {
    {
        int tid = threadIdx.x; asm volatile("" : "+v"(tid)); const int lane = tid & 63; (void)lane;
        LAS float* lg = (LAS float*)(F.lds);
        LAS int* cntl = (LAS int*)(F.lds + 2 * 128 * 65 * 4);
        LAS int* basel = cntl + 32; LAS int* eloc = basel + 32; LAS float* gloc = (LAS float*)(eloc + 256); LAS float* rloc = gloc + 256;
        if (tid < 32) cntl[tid] = 0;
        const int mt = wave & 3, kh = wave >> 2, l31 = lane & 31, h = lane >> 5;
        {
            const int row = 128 * c + 32 * mt + l31;
            f32x16 a0, a1;
#pragma unroll
            for (int r = 0; r < 16; ++r) { a0[r] = 0.f; a1[r] = 0.f; }
            const bf16* hp = H1B + (size_t)row * D + 512 * kh + 8 * h;
            const bf16* w0 = wr_t + (size_t)(32 * kh) * 512 + lane * 8;
#pragma unroll 8
            for (int ks = 0; ks < 32; ++ks) {
                const bf16x8 av = *(const bf16x8*)(hp + 16 * ks);
                const bf16x8 bh0 = *(const bf16x8*)(w0 + 512 * ks), bl0 = *(const bf16x8*)(w0 + 65536 + 512 * ks);
                const bf16x8 bh1 = *(const bf16x8*)(w0 + 32768 + 512 * ks), bl1 = *(const bf16x8*)(w0 + 32768 + 65536 + 512 * ks);
                a0 = __builtin_amdgcn_mfma_f32_32x32x16_bf16(av, bh0, a0, 0, 0, 0);
                a0 = __builtin_amdgcn_mfma_f32_32x32x16_bf16(av, bl0, a0, 0, 0, 0);
                a1 = __builtin_amdgcn_mfma_f32_32x32x16_bf16(av, bh1, a1, 0, 0, 0);
                a1 = __builtin_amdgcn_mfma_f32_32x32x16_bf16(av, bl1, a1, 0, 0, 0);
            }
#pragma unroll
            for (int r = 0; r < 16; ++r) { const int rr = 32 * mt + (r & 3) + 8 * (r >> 2) + 4 * h; lg[(kh * 128 + rr) * 65 + l31] = a0[r]; lg[(kh * 128 + rr) * 65 + 32 + l31] = a1[r]; }
        }
        __syncthreads();
        if (tid < 128) {
            const int row = 128 * c + tid; float ss = 0.f;
#pragma unroll
            for (int j = 0; j < 16; ++j) ss += ssqp[(size_t)row * 16 + j];
            const float rs = 1.0f / sqrtf(ss * (1.0f / D) + RMS_EPS); rstd2[row] = rs;
            const LAS float* l = lg + tid * 65; const LAS float* l2 = lg + (128 + tid) * 65;
            float gl[4]; int gi = 0; float gm;
#pragma unroll
            for (int j = 0; j < 4; ++j) gl[j] = rs * (l[j] + l2[j]) + rbias[j];
            gm = gl[0];
#pragma unroll
            for (int j = 1; j < 4; ++j) if (gl[j] > gm) { gm = gl[j]; gi = j; }
            float den = 0.f;
#pragma unroll
            for (int j = 0; j < 4; ++j) den += expf(gl[j] - gm);
            const float ptop = 1.0f / den;
            float v0 = -3.0e38f, v1 = -3.0e38f; int i0 = 0, i1 = 0;
            for (int j = 0; j < 8; ++j) { const float v = rs * (l[4 + gi * 8 + j] + l2[4 + gi * 8 + j]) + rbias[4 + gi * 8 + j];
                if (v > v0) { v1 = v0; i1 = i0; v0 = v; i0 = j; } else if (v > v1) { v1 = v; i1 = j; } }
            const float e1 = expf(v1 - v0); const float g0 = ptop / (1.0f + e1), g1 = ptop * e1 / (1.0f + e1);
            const int ea = gi * 8 + i0, eb = gi * 8 + i1;
            eloc[2 * tid] = ea; eloc[2 * tid + 1] = eb; gloc[2 * tid] = g0; gloc[2 * tid + 1] = g1; rloc[tid] = rs;
            atomicAdd((int*)(cntl + ea), 1); atomicAdd((int*)(cntl + eb), 1);
        }
        __syncthreads();
        if (tid < 32) basel[tid] = (int)__hip_atomic_fetch_add(etot + tid, (unsigned)cntl[tid], __ATOMIC_RELAXED, __HIP_MEMORY_SCOPE_AGENT);
        __syncthreads();
        if (tid < 256) {
            const int e = eloc[tid]; int rank = 0;
            for (int a = 0; a < tid; ++a) rank += (eloc[a] == e) ? 1 : 0;
            const int idx = e * CAPE + basel[e] + rank;
            inv_tok[idx] = 128 * c * 2 + tid; inv_gate[idx] = gloc[tid]; inv_rs[idx] = rloc[tid >> 1];
        }
    }
    xcd_barrier(bar);
    }
    for (int rep = 0; rep < REP_MOE; ++rep) {
    {
        LAS int* rowtok = (LAS int*)(F.lds + ROWTOK_OFF);
        { int tid = threadIdx.x; asm volatile("" : "+v"(tid));
          LAS int* tot = (LAS int*)(F.lds); LAS int* pst = tot + 32; LAS int* blke = pst + 40;
          if (tid < 32) tot[tid] = (int)etot[tid];
          __syncthreads();
          if (tid == 0) { int p = 0; for (int e = 0; e < 32; ++e) { pst[e] = p; p += ((tot[e] + 255) >> 8) << 8; } pst[32] = p; mymeta[0] = p >> 8; }
          __syncthreads();
          if (tid < 32) { for (int rb = pst[tid] >> 8; rb < (pst[tid + 1] >> 8); ++rb) { blke[rb] = tid; mymeta[16 + rb] = tid; } }
          __syncthreads();
          const int nrb = pst[32] >> 8; const int cb = (int)blockIdx.x;
          for (int idx = tid; idx < 5 * 256; idx += 512) { const int rb = (idx >> 8) * 64 + (cb & 7) * 8 + (cb >> 5); int tk = 0;
              if (rb < nrb) { const int e = blke[rb]; const int slot = rb * 256 + (idx & 255); const int rel = slot - pst[e]; const bool ok = rel < tot[e];
                  const int t2 = ok ? inv_tok[e * CAPE + rel] : -1; tk = ok ? (t2 >> 1) : 0;
                  sdst[slot] = t2; sgate[slot] = ok ? inv_gate[e * CAPE + rel] : 0.f; srs[slot] = ok ? inv_rs[e * CAPE + rel] : 0.f; }
              rowtok[idx] = tk; }
          asm volatile("s_waitcnt vmcnt(0)" ::: "memory");
          __syncthreads(); }
        MoeOrderG S; S.meta = mymeta; S.rowtok = rowtok; S.G = F.G; S.c = (int)blockIdx.x; S.A = (const char*)H1B8; S.B = (const char*)WupT; S.tb = (size_t)256 * 1024;
        EpiUp E{srs, HID};
        pg8::gemm_phase<EpiUp, MoeOrderG, true, true, false, true>(F.lds + RING_OFF, 512, S, E, 0x7f7a);
        if (rep == 0) {
            int tid = threadIdx.x; asm volatile("" : "+v"(tid)); const int lane = tid & 63;
            const int nrb = __builtin_amdgcn_readfirstlane(mymeta[0]); const int cb = (int)blockIdx.x;
            int T = nrb - 256; T = T < 0 ? 0 : (T > 32 ? 32 : T);
            const int r5 = (cb & 7) * 8 + (cb >> 5);
            if (r5 >= T) {
                const int nidle = (64 - T) * 4, me = (r5 - T) * 4 + ((cb >> 3) & 3);
                LAS float* scr = (LAS float*)(F.lds + wave * P0_SCR);
#pragma unroll 1
                for (int it = me + nidle * wave; it < I_E2; it += nidle * 8) {
                    const Tr64 t = expert_item(I_E1 + I_E3 + it, ew1, ew3, ew2, g_ffn, WupT, W2T);
                    f32x4 tv[16]; tr64_load(t, tv, lane); tr64_store(t, tv, scr, lane);
                }
            }
        }
    }
    xcd_barrier(bar);
    {
        MoeOrder S; S.meta = mymeta; S.G = F.G; S.c = (int)blockIdx.x; S.A = (const char*)HID; S.B = (const char*)W2T; S.ta = (size_t)256 * 512; S.tb = (size_t)256 * 512;
        EpiDown E{sdst, sgate, YB};
        pg8::gemm_phase<EpiDown, MoeOrder, true, false, false, true>(F.lds + RING_OFF, 256, S, E, 0x7d7b);
    }
    xcd_barrier(bar);
    }
#endif

#ifdef DBG_COPYSG
    for (int m = gw; m < M; m += NGW) { for (int j = 0; j < 16; ++j) HID[(size_t)m * 512 + ((lane + 64 * j) & 511)] = SG[(size_t)m * 2048 + DBG_COL0 + ((lane + 64 * j) & 511)]; }
    xcd_barrier(bar);
#endif
#ifdef DBG_BUF
    {
        for (int m = gw; m < M; m += NGW) {
            const bf16* src = DBG_BUF; const size_t ld = DBG_LD;
            float v[16];
#pragma unroll
            for (int j = 0; j < 16; ++j) v[j] = DBG_SCALE * bf2f(src[(size_t)(m % DBG_ROWS) * ld + ((lane + 64 * j) % ld)]);
            asm volatile("" ::: "memory");
#pragma unroll
            for (int j = 0; j < 16; ++j) out[(size_t)m * D + lane + 64 * j] = v[j];
        }
    }
#else
    for (int rep = 0; rep < REP_FIN; ++rep) {
        int tid = threadIdx.x; asm volatile("" : "+v"(tid)); const int lane = tid & 63; (void)lane;
        for (int m = gw; m < M; m += NGW) {
            f32x4 v[4]; float s = 0.f;
            { const v2u* hr = (const v2u*)(H1B + (size_t)m * D) + lane;
#pragma unroll
              for (int j = 0; j < 4; ++j) { const v2u a = hr[64 * j]; v[j][0] = bflo(a.x); v[j][1] = bfhi(a.x); v[j][2] = bflo(a.y); v[j][3] = bfhi(a.y); } }
#if PH_MAX >= 3
            const unsigned* y0 = (const unsigned*)(YB + (size_t)(2 * m) * D) + lane; const unsigned* y1 = (const unsigned*)(YB + (size_t)(2 * m + 1) * D) + lane;
#pragma unroll
            for (int j = 0; j < 4; ++j) { const int a = (int)y0[64 * j], b = (int)y1[64 * j];
                v[j][0] += (__builtin_amdgcn_cvt_f32_fp8(a, 0) + __builtin_amdgcn_cvt_f32_fp8(b, 0)) * 0.0625f; v[j][1] += (__builtin_amdgcn_cvt_f32_fp8(a, 1) + __builtin_amdgcn_cvt_f32_fp8(b, 1)) * 0.0625f;
                v[j][2] += (__builtin_amdgcn_cvt_f32_fp8(a, 2) + __builtin_amdgcn_cvt_f32_fp8(b, 2)) * 0.0625f; v[j][3] += (__builtin_amdgcn_cvt_f32_fp8(a, 3) + __builtin_amdgcn_cvt_f32_fp8(b, 3)) * 0.0625f; }
#endif
#pragma unroll
            for (int j = 0; j < 4; ++j) s += (v[j][0] * v[j][0] + v[j][1] * v[j][1]) + (v[j][2] * v[j][2] + v[j][3] * v[j][3]);
            const float rs = 1.0f / sqrtf(wave_sum(s, lane) * (1.0f / D) + RMS_EPS);
            f32x4* o = (f32x4*)(out + (size_t)m * D) + lane;
#pragma unroll
            for (int j = 0; j < 4; ++j) { const f32x4 g = *((const f32x4*)g_fin + lane + 64 * j); __builtin_nontemporal_store(v[j] * rs * g, &o[64 * j]); }
        }
    }
#endif
}

extern "C" void kernel_launch(void* const* d_in, const int* in_sizes, int n_in, void* d_out, int out_size, void* d_ws, size_t ws_size, hipStream_t stream) {
    static int grid = 0;
    if (grid == 0) {
        if (n_in != 26 || out_size != M * D || ws_size < WS_END) { fprintf(stderr, "kernel_launch: unexpected sizes n_in %d out %d ws %zu\n", n_in, out_size, ws_size); grid = -1; return; }
        int dev = 0, cus = 0, per_cu = 0;
        if (hipGetDevice(&dev) != hipSuccess || hipDeviceGetAttribute(&cus, hipDeviceAttributeMultiprocessorCount, dev) != hipSuccess) { grid = -1; return; }
        if (hipFuncSetAttribute((const void*)fwd_kernel, hipFuncAttributeMaxDynamicSharedMemorySize, LDS_BYTES) != hipSuccess) { fprintf(stderr, "kernel_launch: hipFuncSetAttribute failed\n"); grid = -1; return; }
        if (hipOccupancyMaxActiveBlocksPerMultiprocessor(&per_cu, (const void*)fwd_kernel, NWAVES * 64, LDS_BYTES) != hipSuccess || per_cu < 1)
            fprintf(stderr, "kernel_launch: occupancy query reports %d\n", per_cu);
        (void)hipGetLastError();
        grid = cus;
        if (grid != 256) fprintf(stderr, "kernel_launch: %d CUs (built for 256)\n", grid);
    }
    if (grid < 0) return;
    if (hipMemsetAsync((char*)d_ws + WS_CTL, 0, CTL_ZERO_BYTES, stream) != hipSuccess) return;
    Args a{};
    for (int i = 0; i < 26; ++i) a.in[i] = (const float*)d_in[i];
    a.out = (float*)d_out; a.ws = (unsigned char*)d_ws;
    hipLaunchKernelGGL(fwd_kernel, dim3(grid), dim3(NWAVES * 64), LDS_BYTES, stream, a);
}
```

```cpp
#include <hip/hip_runtime.h>
#include <cstdio>
#include <cstdint>

#ifndef REP_P0
#define REP_P0 1
#endif
#ifndef WGM_P1
#define WGM_P1 4
#endif
#ifndef WGM_GLU
#define WGM_GLU 4
#endif
#ifndef WGM_MRG
#define WGM_MRG 4
#endif
#ifndef WGM_WO
#define WGM_WO 4
#endif
#ifndef REP_P0S
#define REP_P0S 1
#endif
#ifndef REP_P1
#define REP_P1 1
#endif
#ifndef REP_SSM
#define REP_SSM 1
#endif
#ifndef REP_ATT
#define REP_ATT 1
#endif
#ifndef REP_MIX
#define REP_MIX 1
#endif
#ifndef REP_RT
#define REP_RT 1
#endif
#ifndef REP_MOE
#define REP_MOE 1
#endif
#ifndef REP_FIN
#define REP_FIN 1
#endif
#ifndef PH_MAX
#define PH_MAX 3
#endif

#define GAS __attribute__((address_space(1)))
#define LAS __attribute__((address_space(3)))
typedef unsigned short bf16;
typedef unsigned v4u __attribute__((ext_vector_type(4)));
typedef unsigned v2u __attribute__((ext_vector_type(2)));
typedef float f32x2 __attribute__((ext_vector_type(2)));
typedef float f32x4 __attribute__((ext_vector_type(4)));
typedef float f32x16 __attribute__((ext_vector_type(16)));
typedef short bf16x8 __attribute__((ext_vector_type(8)));
typedef GAS unsigned gu32;

constexpr int D = 1024, NB = 4, SEQ = 8192, M = NB * SEQ, NMETA = 16;
constexpr int ATW = 512, NH = 8, HD = 64, SW = 512, NG = 32, GC = 16, NP = 64, INC = 4096;
constexpr int NE = 32, FF = 512;
constexpr int LPB = 8224;
constexpr int KT_ROWS = 66;
constexpr int MAXRB = 288;
constexpr float RMS_EPS = 1e-6f;
constexpr float QSCALE = 0.125f * 1.4426950408889634f;

constexpr size_t MiB = 1u << 20;
constexpr size_t WS_CTL = 0, CTL_ZERO_BYTES = 1 * MiB;
constexpr size_t WS_SMALL = 1 * MiB;
constexpr size_t SM_RSTD1 = WS_SMALL;
constexpr size_t SM_RSTD2 = SM_RSTD1 + 128 * 1024;
constexpr size_t SM_EID = SM_RSTD2 + 128 * 1024;
constexpr size_t SM_GATE = SM_EID + 256 * 1024;
constexpr size_t SM_CNT = SM_GATE + 256 * 1024;
constexpr size_t SM_UMETA = SM_CNT + 32 * 1024;
constexpr size_t SM_BBAR = SM_UMETA + 32 * 1024;
constexpr size_t SM_LBAR = SM_BBAR + 256 * 1024;
constexpr size_t SM_L64 = SM_LBAR + 16 * 1024;
constexpr size_t SM_SDST = SM_L64 + 16 * 1024;
constexpr size_t SM_SGATE = SM_SDST + 288 * 1024;
constexpr size_t SM_SRS = SM_SGATE + 288 * 1024;
constexpr size_t SM_WR = SM_SRS + 288 * 1024;
constexpr size_t SM_RB = SM_WR + 256 * 1024;
constexpr size_t SM_MOEMETA = SM_RB + 1024;
constexpr size_t SM_METAP = SM_MOEMETA + 4096;
constexpr size_t SM_SSQP = 4 * MiB;
static_assert(SM_METAP + 8 * 16 * 1536 * 4 <= SM_SSQP, "small map");
constexpr size_t WS_WIN = 6 * MiB;
constexpr size_t WS_WPAB = 14 * MiB;
constexpr size_t WS_WO = 16 * MiB;
constexpr size_t WS_GLU = 18 * MiB;
constexpr size_t WS_KT = 19 * MiB;
constexpr size_t WS_T2 = 21 * MiB;
constexpr size_t WS_T3 = 29 * MiB;
constexpr size_t WS_WUP = 37 * MiB;
constexpr size_t WS_W2 = 101 * MiB;
constexpr size_t WS_XB = 133 * MiB;
constexpr size_t WS_Y = 133 * MiB;
constexpr size_t WS_S = 165 * MiB;
constexpr size_t WS_XS = 173 * MiB;
constexpr size_t WS_Q = 197 * MiB;
constexpr size_t WS_SSM = 229 * MiB;
constexpr size_t WS_K = 261 * MiB;
constexpr size_t WS_VT = 295 * MiB;
constexpr size_t WS_UG = 329 * MiB;
constexpr size_t WS_SG = 361 * MiB;
constexpr size_t WS_H1B = 361 * MiB;
constexpr size_t WS_H1B8 = 425 * MiB;
constexpr size_t WS_HID = 277 * MiB;
constexpr size_t WS_YB = 133 * MiB;
constexpr size_t WS_INV = 489 * MiB;
constexpr size_t WS_MWG = 502 * MiB;
constexpr size_t WS_END = 503 * MiB;
constexpr int CAPE = 32768;
constexpr int CW_TOT = 8192;

constexpr int CW_BAR = 4096;

constexpr int RING_OFF = 0, RING_BYTES = 131072;
constexpr int P0_SCR = 16896;
constexpr int LDSCTL_OFF = 8 * P0_SCR, MISC_OFF = LDSCTL_OFF + 320;
static_assert(LDSCTL_OFF >= RING_BYTES, "lds map");
constexpr int LDS_BYTES = 147456;
constexpr int ROWTOK_OFF = 8 * 16896 + 512;
static_assert(ROWTOK_OFF + 5 * 256 * 4 <= LDS_BYTES, "lds map");
constexpr int NWAVES = 8;

#define LDS_WAIT() asm volatile("s_waitcnt lgkmcnt(0)" ::: "memory")
#define VM_WAIT() asm volatile("s_waitcnt vmcnt(0)" ::: "memory")

typedef __bf16 bf16x2_t __attribute__((ext_vector_type(2)));
__device__ __forceinline__ unsigned cvt_pk_bf16(float lo, float hi) { bf16x2_t v; v[0] = (__bf16)lo; v[1] = (__bf16)hi; return __builtin_bit_cast(unsigned, v); }
__device__ __forceinline__ float bf2f(unsigned short b) { return __builtin_bit_cast(float, (unsigned)b << 16); }
__device__ __forceinline__ float bflo(unsigned w) { return __builtin_bit_cast(float, w << 16); }
__device__ __forceinline__ float bfhi(unsigned w) { return __builtin_bit_cast(float, w & 0xffff0000u); }
__device__ __forceinline__ float fast_sigmoid(float x) { return __builtin_amdgcn_rcpf(1.0f + __expf(-x)); }
__device__ __forceinline__ float shx(float v, int k, int lane) { return __builtin_bit_cast(float, __builtin_amdgcn_ds_bpermute((lane ^ k) << 2, __builtin_bit_cast(int, v))); }
__device__ __forceinline__ float wave_sum(float v, int lane) {
#pragma unroll
    for (int o = 1; o < 64; o <<= 1) v += shx(v, o, lane);
    return v;
}

#define XB_TMO      128
#define XB_XCNT(j)  (256  + 64 * (j))
#define XB_XSUB(j)  (1280 + 64 * (j))
#define XB_XGEN(j)  (2304 + 64 * (j))
#define XB_TOP      3328
#define XB_TOPGEN   3392
#define XCD_BAR_WORDS 3456
#define XB_SPIN_CAP (1u << 18)
__device__ __forceinline__ unsigned xb_ld(unsigned* p)              { return __hip_atomic_load(p, __ATOMIC_RELAXED, __HIP_MEMORY_SCOPE_AGENT); }
__device__ __forceinline__ unsigned xb_add(unsigned* p, unsigned v) { return __hip_atomic_fetch_add(p, v, __ATOMIC_RELAXED, __HIP_MEMORY_SCOPE_AGENT); }
__device__ __forceinline__ unsigned xb_xcc_id() { return (unsigned)__builtin_amdgcn_s_getreg((3 << 11) | 20) & 0xFu; }
#define XB_SPIN(cond, bar) do { unsigned _sp = 0; while (cond) { __builtin_amdgcn_s_sleep(1); \
    if ((++_sp & 255u) == 0u) { if (xb_ld(&(bar)[XB_TMO])) break; if (_sp > XB_SPIN_CAP) { atomicAdd(&(bar)[XB_TMO], 1u); break; } } } } while (0)
struct XcdBarrier { unsigned* bar; unsigned x; volatile LAS unsigned* st; };
__device__ __forceinline__ XcdBarrier xcd_barrier_post(unsigned* bar, volatile LAS unsigned* st) {
    XcdBarrier b; b.bar = bar; b.x = (unsigned)__builtin_amdgcn_readfirstlane((int)xb_xcc_id()); b.st = st;
    if (threadIdx.x == 0) (void)xb_add(&bar[XB_XCNT(b.x)], 1u);
    return b;
}
__device__ __forceinline__ void xcd_barrier_complete(unsigned* bar, unsigned x, unsigned& nloc, unsigned& nx) {
    const unsigned G = gridDim.x * gridDim.y * gridDim.z;
    unsigned sum, cnt, mine, sp = 0u;
    for (;;) {
        sum = 0u; cnt = 0u; mine = 0u;
#pragma unroll
        for (unsigned j = 0; j < 16; ++j) { const unsigned c = xb_ld(&bar[XB_XCNT(j)]); sum += c; cnt += (c > 0u) ? 1u : 0u; mine = (j == x) ? c : mine; }
        if (sum == G) break;
        __builtin_amdgcn_s_sleep(1);
        if ((++sp & 255u) == 0u) { if (xb_ld(&bar[XB_TMO])) break; if (sp > XB_SPIN_CAP) { atomicAdd(&bar[XB_TMO], 1u); break; } }
    }
    nloc = mine > 0u ? mine : 1u; nx = cnt > 0u ? cnt : 1u;
}
__device__ __forceinline__ void xcd_barrier(const XcdBarrier& b) {
    asm volatile("s_waitcnt vmcnt(0)" ::: "memory");
    __syncthreads();
    if (threadIdx.x == 0) {
        unsigned* bar = b.bar; asm volatile("" : "+s"(bar));
        __builtin_amdgcn_s_waitcnt(0);
        unsigned bx = b.x; asm volatile("" : "+s"(bx));
        const unsigned osub = (unsigned)__builtin_amdgcn_readfirstlane((int)XB_XSUB(bx)), ogen = (unsigned)__builtin_amdgcn_readfirstlane((int)XB_XGEN(bx));
        unsigned nloc = b.st[0], nx = b.st[1];
        if (nloc == 0u) { xcd_barrier_complete(bar, bx, nloc, nx); b.st[0] = nloc; b.st[1] = nx; }
        const unsigned old = xb_add(&bar[osub], 1u);
        const unsigned gen = old / nloc;
        if (old + 1u == (gen + 1u) * nloc) {
            __builtin_amdgcn_fence(__ATOMIC_RELEASE, "agent");
            asm volatile("s_waitcnt vmcnt(0)" ::: "memory");
            const unsigned og = xb_add(&bar[XB_TOP], 1u);
            const unsigned tg = og / nx;
            if (og + 1u == (tg + 1u) * nx) xb_add(&bar[XB_TOPGEN], 1u);
            else XB_SPIN(xb_ld(&bar[XB_TOPGEN]) == tg, bar);
            __builtin_amdgcn_fence(__ATOMIC_ACQUIRE, "agent");
            xb_add(&bar[ogen], 1u);
            asm volatile("s_waitcnt vmcnt(0)" ::: "memory");
        } else {
            XB_SPIN(xb_ld(&bar[ogen]) == gen, bar);
            __builtin_amdgcn_fence(__ATOMIC_ACQUIRE, "agent");
            asm volatile("s_waitcnt vmcnt(0)" ::: "memory");
        }
    }
    __syncthreads();
}

namespace pg8 {
typedef int pg8_v4i __attribute__((ext_vector_type(4)));
typedef int pg8_v8i __attribute__((ext_vector_type(8)));
constexpr int BM = 256, BK = 64, HALF = 128, HTB = HALF * BK * 2, STAGE_BYTES = 8 * HTB, NXCD = 8, WGM = 4;
__host__ __device__ __forceinline__ int lds_byte(int r, int c) { const int st = (r >> 4) * 2 + (c >> 5), rr = r & 15, cc = c & 31, ob = rr * 64 + cc * 2; return st * 1024 + (ob ^ (((ob >> 9) & 1) << 5)); }
__host__ __device__ __forceinline__ void stage_rc(int b, int& R, int& C) { const int st = b / 1024, sb = b % 1024, swz = sb ^ (((sb >> 9) & 1) << 5); R = (st >> 1) * 16 + swz / 64; C = (st & 1) * 32 + (swz % 64) / 2; }
__host__ __device__ __forceinline__ int perm32(int rho) { const int n = rho >> 4, i = rho & 15; return 8 * (i >> 2) + 4 * n + (i & 3); }
struct Unit { int pm, pn; };
struct StaticOrder {
    int nM, nN, nwg, G, c, wgm;
    __host__ __device__ void init(int nM_, int nN_, int G_, int c_, int wgm_ = WGM) { nM = nM_; nN = nN_; nwg = nM * nN; G = G_; c = c_; wgm = wgm_; }
    __host__ __device__ bool next(int i, Unit& u) const {
        const long L = (long)i * G + c; if (L >= nwg) return false;
        int wgid = (int)L; { const int q = nwg / NXCD, r = nwg % NXCD, xcd = wgid % NXCD, off = wgid / NXCD; wgid = (xcd < r ? xcd * (q + 1) : r * (q + 1) + (xcd - r) * q) + off; }
        const int nig = wgm * nN, gid = wgid / nig, fm = gid * wgm, gsz = (nM - fm) < wgm ? (nM - fm) : wgm;
        u.pm = fm + ((wgid % nig) % gsz); u.pn = (wgid % nig) / gsz; return true;
    }
};
template <class Epi, class Sched, bool ALIGN_EPI, bool GATHER = false, bool KS = false, bool F8 = false>
__device__ __forceinline__ void gemm_phase(LAS unsigned char* lds, const int K, const Sched& S, const Epi& E, const int sc_wa = 0x7f7f) {
    int tid = threadIdx.x; asm volatile("" : "+v"(tid));
    const int wid = __builtin_amdgcn_readfirstlane(tid >> 6), lane = tid & 63, wr = wid >> 2, wc = wid & 3, fr = lane & 15, fq = lane >> 4;
    const int nt = KS ? 16 : K / BK;
    unsigned voffA[2], voffB[2]; int Rr[2], Cc[2];
#pragma unroll
    for (int i = 0; i < 2; ++i) { int R, C; stage_rc(tid * 16 + i * 8192, R, C); const int Rb = Epi::PERM ? ((R & ~31) + perm32(R & 31)) : R; Rr[i] = R; Cc[i] = C;
        voffA[i] = (unsigned)(R * K + C) * 2u; voffB[i] = (unsigned)(Rb * K + C) * 2u; }
    unsigned gA[2][2], gAn[2][2];
#pragma unroll
    for (int h2 = 0; h2 < 2; ++h2) { gA[h2][0] = gA[h2][1] = gAn[h2][0] = gAn[h2][1] = 0u; }
    const size_t kstep = (size_t)(BK * 2);
    const size_t hstep = (size_t)HALF * K * 2;
    const unsigned ldsw = (unsigned)wid * 1024u;
    const int aoff = lds_byte(wr * 64 + fr, fq * 8), boff = lds_byte(wc * 32 + fr, fq * 8);
#define PG8_SA(b, h) (((b) * 2 + (h)) * HTB)
#define PG8_SB(b, h) ((4 + (b) * 2 + (h)) * HTB)
#define PG8_STAGE(bufoff, gbase, voff) do { _Pragma("unroll") for (int _i = 0; _i < 2; ++_i) \
        __builtin_amdgcn_global_load_lds((const unsigned*)((const char*)(gbase) + (voff)[_i]), (LAS unsigned*)(lds + (bufoff) + ldsw + _i * 8192), 16, 0, 0); } while (0)
#define PG8_LD8(dst8, addr) do { const pg8_v4i lo_ = *(const LAS pg8_v4i*)(addr), hi_ = *(const LAS pg8_v4i*)((addr) + 1024); dst8 = __builtin_shufflevector(lo_, hi_, 0, 1, 2, 3, 4, 5, 6, 7); } while (0)
#define PG8_LDA(dst, b, h) do { if constexpr (F8) { _Pragma("unroll") for (int m = 0; m < 4; ++m) PG8_LD8(dst##8[m], lds + PG8_SA(b, h) + aoff + m * 2048); } \
        else { _Pragma("unroll") for (int m = 0; m < 4; ++m) _Pragma("unroll") for (int k = 0; k < 2; ++k) dst[m][k] = *(const LAS bf16x8*)(lds + PG8_SA(b, h) + aoff + m * 2048 + k * 1024); } } while (0)
#define PG8_LDB(dst, b, h) do { if constexpr (F8) { _Pragma("unroll") for (int n = 0; n < 2; ++n) PG8_LD8(dst##8[n], lds + PG8_SB(b, h) + boff + n * 2048); } \
        else { _Pragma("unroll") for (int n = 0; n < 2; ++n) _Pragma("unroll") for (int k = 0; k < 2; ++k) dst[n][k] = *(const LAS bf16x8*)(lds + PG8_SB(b, h) + boff + n * 2048 + k * 1024); } } while (0)
#define PG8_MMA(ai, bj, At, Bt) do { __builtin_amdgcn_s_setprio(1); _Pragma("unroll") for (int m = 0; m < 4; ++m) _Pragma("unroll") for (int n = 0; n < 2; ++n) { \
        if constexpr (F8) { acc[ai][bj][m][n] = __builtin_amdgcn_mfma_scale_f32_16x16x128_f8f6f4(Bt##8[n], At##8[m], acc[ai][bj][m][n], 0, 0, 0, sc_wa, 1, sc_wa); } \
        else { _Pragma("unroll") for (int k = 0; k < 2; ++k) acc[ai][bj][m][n] = __builtin_amdgcn_mfma_f32_16x16x32_bf16(Bt[n][k], At[m][k], acc[ai][bj][m][n], 0, 0, 0); } } \
        if constexpr (F8) asm volatile("" : "+v"(acc[ai][bj][0][0]), "+v"(acc[ai][bj][0][1]), "+v"(acc[ai][bj][1][0]), "+v"(acc[ai][bj][1][1]), "+v"(acc[ai][bj][2][0]), "+v"(acc[ai][bj][2][1]), "+v"(acc[ai][bj][3][0]), "+v"(acc[ai][bj][3][1]));   \
        __builtin_amdgcn_s_setprio(0); } while (0)
#define PG8_WAIT_V(n) asm volatile("s_waitcnt vmcnt(" #n ")" ::: "memory")
#define PG8_WAIT_L(n) asm volatile("s_waitcnt lgkmcnt(" #n ")" ::: "memory")
#define PG8_BAR __builtin_amdgcn_s_barrier()
#define PG8_SCHED __builtin_amdgcn_sched_barrier(0)
    Unit cur, nxt; int ui = 0;
    if (!S.next(0, cur)) return;
    f32x4 acc[2][2][4][2];
#pragma unroll
    for (int a = 0; a < 2; ++a)
#pragma unroll
        for (int b = 0; b < 2; ++b)
#pragma unroll
            for (int m = 0; m < 4; ++m)
#pragma unroll
                for (int n = 0; n < 2; ++n) acc[a][b][m][n] = (f32x4){0.f, 0.f, 0.f, 0.f};
    if constexpr (F8) {
#pragma unroll
        for (int a = 0; a < 2; ++a)
#pragma unroll
            for (int b = 0; b < 2; ++b)
#pragma unroll
                for (int m = 0; m < 4; ++m)
#pragma unroll
                    for (int n = 0; n < 2; ++n) asm volatile("" : "+v"(acc[a][b][m][n]));
    }
    bf16x8 At[4][2], B0[2][2], B1[2][2];
    pg8_v8i At8[4], B08[2], B18[2];
    const char* cA = S.aptr(cur); const char* cB = S.bptr(cur);
    if constexpr (GATHER) { S.gather(cur, Rr, Cc, K, gA); }
#define PG8_STAGE_A(bufoff, h, ko, usenext) PG8_STAGE_A2(bufoff, h, cA, ko, usenext)
#define PG8_STAGE_A2(bufoff, h, cur_base, ko, usenext) do { if constexpr (GATHER) { unsigned _v[2] = { (usenext) ? gAn[h][0] : gA[h][0], (usenext) ? gAn[h][1] : gA[h][1] }; PG8_STAGE(bufoff, cA + (ko), _v); } \
        else { PG8_STAGE(bufoff, ((usenext) ? nA : (cur_base)) + (size_t)(h) * hstep + (ko), voffA); } } while (0)
    { const char* nA = cA; (void)nA;
    PG8_STAGE(PG8_SB(0, 0), cB, voffB); PG8_STAGE(PG8_SB(0, 1), cB + hstep, voffB); PG8_STAGE_A(PG8_SA(0, 0), 0, 0, false); PG8_STAGE_A(PG8_SA(0, 1), 1, 0, false);
    if (wr == 1) PG8_BAR;
    PG8_WAIT_V(2); PG8_BAR;
    PG8_STAGE(PG8_SB(1, 0), cB + kstep, voffB); PG8_STAGE_A(PG8_SA(1, 0), 0, kstep, false); PG8_STAGE(PG8_SB(1, 1), cB + hstep + kstep, voffB);
    PG8_WAIT_V(6); PG8_BAR; }
    for (;;) {
        { int tid2 = threadIdx.x; asm volatile("" : "+v"(tid2));
#pragma unroll
          for (int i = 0; i < 2; ++i) { int R, C; stage_rc(tid2 * 16 + i * 8192, R, C); const int Rb = Epi::PERM ? ((R & ~31) + perm32(R & 31)) : R;
              voffA[i] = (unsigned)(R * K + C) * 2u; voffB[i] = (unsigned)(Rb * K + C) * 2u; } }
        const bool has_next = S.next(ui + 1, nxt);
        const char* nA = has_next ? S.aptr(nxt) : cA; const char* nB = has_next ? S.bptr(nxt) : cB;
        const char* dA = cA; const char* dB = cB; if constexpr (KS) { dA = S.aptr2(cur); dB = S.bptr2(cur); }
        if constexpr (GATHER) { if (has_next) S.gather(nxt, Rr, Cc, K, gAn); else {
#pragma unroll
            for (int h2 = 0; h2 < 2; ++h2) { gAn[h2][0] = gA[h2][0]; gAn[h2][1] = gA[h2][1]; } } }
#pragma unroll 1
        for (int t = 0; t < nt; t += 2) {
            const bool last = (t == nt - 2);
            const char* pa1 = (KS && t >= 8) ? dA : cA; const char* pa2 = (KS && t >= 6) ? dA : cA; const char* pb2 = (KS && t >= 6) ? dB : cB;
            const size_t ko1 = KS ? (size_t)((t + 1) & 7) * kstep : (size_t)(t + 1) * kstep;
            const size_t ko2 = last ? (size_t)0 : (KS ? (size_t)((t + 2) & 7) * kstep : (size_t)(t + 2) * kstep), ko3 = ko2 + kstep;
            const char* b2 = last ? nB : pb2 + ko2; const char* b3 = b2 + kstep;
            PG8_LDB(B0, 0, 0); PG8_LDB(B1, 0, 1); PG8_SCHED; PG8_LDA(At, 0, 0); PG8_STAGE_A2(PG8_SA(1, 1), 1, pa1, ko1, false);
            PG8_WAIT_V(8); PG8_WAIT_L(0); PG8_BAR; PG8_MMA(0, 0, At, B0); PG8_MMA(0, 1, At, B1); PG8_BAR; PG8_SCHED;
            PG8_LDA(At, 0, 1); PG8_STAGE(PG8_SB(0, 0), b2, voffB); PG8_STAGE(PG8_SB(0, 1), b2 + hstep, voffB); PG8_STAGE_A2(PG8_SA(0, 0), 0, pa2, ko2, last);
            PG8_WAIT_V(8); PG8_WAIT_L(0); PG8_BAR; PG8_MMA(1, 0, At, B0); PG8_MMA(1, 1, At, B1); PG8_BAR; PG8_SCHED;
            PG8_LDB(B0, 1, 0); PG8_LDB(B1, 1, 1); PG8_SCHED; PG8_LDA(At, 1, 0); PG8_STAGE_A2(PG8_SA(0, 1), 1, pa2, ko2, last);
            PG8_WAIT_V(8); PG8_WAIT_L(0); PG8_BAR; PG8_MMA(0, 0, At, B0); PG8_MMA(0, 1, At, B1); PG8_BAR; PG8_SCHED;
            PG8_LDA(At, 1, 1); PG8_STAGE(PG8_SB(1, 0), b3, voffB); PG8_STAGE(PG8_SB(1, 1), b3 + hstep, voffB); PG8_STAGE_A2(PG8_SA(1, 0), 0, pa2, ko3, last);
            PG8_WAIT_V(8); PG8_WAIT_L(0); PG8_BAR; PG8_MMA(1, 0, At, B0); PG8_MMA(1, 1, At, B1); PG8_BAR; PG8_SCHED;
            if constexpr (KS) { if (t == 6) { int efr = fr, efq = fq; asm volatile("" : "+v"(efr), "+v"(efq)); E.mid(acc, cur, wr, wc, efr, efq); } }
        }
        if constexpr (ALIGN_EPI) { if (wr == 0) PG8_BAR; }
        { int efr = fr, efq = fq; asm volatile("" : "+v"(efr), "+v"(efq));
          E(acc, cur, wr, wc, efr, efq); }
        if (!has_next) break;
#pragma unroll
        for (int a = 0; a < 2; ++a)
#pragma unroll
            for (int b = 0; b < 2; ++b)
#pragma unroll
                for (int m = 0; m < 4; ++m)
#pragma unroll
                    for (int n = 0; n < 2; ++n) { acc[a][b][m][n] = (f32x4){0.f, 0.f, 0.f, 0.f}; if constexpr (F8) asm volatile("" : "+v"(acc[a][b][m][n])); }
        cur = nxt; cA = nA; cB = nB; ++ui;
        if constexpr (GATHER) {
#pragma unroll
            for (int h2 = 0; h2 < 2; ++h2) { gA[h2][0] = gAn[h2][0]; gA[h2][1] = gAn[h2][1]; } }
        if constexpr (ALIGN_EPI) { if (wr == 1) PG8_BAR; }
    }
    PG8_WAIT_V(0);
    if constexpr (!ALIGN_EPI) { if (wr == 0) PG8_BAR; }
    PG8_BAR;
#undef PG8_SA
#undef PG8_SB
#undef PG8_STAGE
#undef PG8_STAGE_A
#undef PG8_STAGE_A2
#undef PG8_LDA
#undef PG8_LD8
#undef PG8_LDB
#undef PG8_MMA
#undef PG8_WAIT_V
#undef PG8_WAIT_L
#undef PG8_BAR
#undef PG8_SCHED
}
}
using pg8::Unit;

struct Args { const float* in[26]; float* out; unsigned char* ws; };
struct Frame {
    LAS unsigned char* lds;
    volatile LAS unsigned* MISC;
    int tid, lane, wave, vcu, G;
};

struct GOrder {
    pg8::StaticOrder so; const char* A; const char* B; size_t ta, tb;
    __device__ __forceinline__ bool next(int i, Unit& u) const { return so.next(i, u); }
    __device__ __forceinline__ const char* aptr(const Unit& u) const { return A + (size_t)u.pm * ta; }
    __device__ __forceinline__ const char* bptr(const Unit& u) const { return B + (size_t)u.pn * tb; }
};
struct P1Order {
    pg8::StaticOrder so; const char* X; const char* W; size_t t;
    __device__ __forceinline__ bool next(int i, Unit& u) const { return so.next(i, u); }
    __device__ __forceinline__ const char* aptr(const Unit& u) const { return (u.pn == 4 || u.pn == 5) ? W + (size_t)u.pn * t : X + (size_t)u.pm * t; }
    __device__ __forceinline__ const char* bptr(const Unit& u) const { return (u.pn == 4 || u.pn == 5) ? X + (size_t)u.pm * t : W + (size_t)u.pn * t; }
};
struct MergeOrder {
    pg8::StaticOrder so; const char* A; const char* B; size_t ta, tb;
    __device__ __forceinline__ bool next(int i, Unit& u) const { return so.next(i, u); }
    __device__ __forceinline__ const char* aptr(const Unit& u) const { return A + (size_t)u.pm * ta; }
    __device__ __forceinline__ const char* aptr2(const Unit& u) const { return A + (size_t)(u.pm + 128) * ta; }
    __device__ __forceinline__ const char* bptr(const Unit& u) const { return B + (size_t)u.pn * tb; }
    __device__ __forceinline__ const char* bptr2(const Unit& u) const { return B + (size_t)(u.pn + 4) * tb; }
};
struct MoeOrder {
    const int* meta; int G, c; const char* A; const char* B; size_t ta, tb;
    __device__ __forceinline__ bool next(int i, Unit& u) const {
        const int nrb = __builtin_amdgcn_readfirstlane(meta[0]);
        const int rb = i * 64 + (c & 7) * 8 + (c >> 5);
        if (rb >= nrb) return false;
        const int e = __builtin_amdgcn_readfirstlane(meta[16 + rb]);
        u.pm = rb; u.pn = e * 4 + ((c >> 3) & 3); return true;
    }
    __device__ __forceinline__ const char* aptr(const Unit& u) const { return A + (size_t)u.pm * ta; }
    __device__ __forceinline__ const char* bptr(const Unit& u) const { return B + (size_t)u.pn * tb; }
};

struct MoeOrderG {
    const int* meta; const LAS int* rowtok; int G, c; const char* A; const char* B; size_t tb;
    __device__ __forceinline__ bool next(int i, Unit& u) const {
        const int nrb = __builtin_amdgcn_readfirstlane(meta[0]);
        const int rb = i * 64 + (c & 7) * 8 + (c >> 5);
        if (rb >= nrb) return false;
        const int e = __builtin_amdgcn_readfirstlane(meta[16 + rb]);
        u.pm = rb; u.pn = e * 4 + ((c >> 3) & 3); return true;
    }
    __device__ __forceinline__ const char* aptr(const Unit&) const { return A; }
    __device__ __forceinline__ const char* bptr(const Unit& u) const { return B + (size_t)u.pn * tb; }
    __device__ __forceinline__ void gather(const Unit& u, const int (&Rr)[2], const int (&Cc)[2], int K, unsigned (&v)[2][2]) const {
        const LAS int* t = rowtok + (u.pm >> 6) * 256;
#pragma unroll
        for (int h = 0; h < 2; ++h)
#pragma unroll
            for (int i = 0; i < 2; ++i) v[h][i] = ((unsigned)t[h * 128 + Rr[i]] * (unsigned)K + (unsigned)Cc[i]) * 2u;
    }
};

#define EPI_ARGS const f32x4 (&acc)[2][2][4][2], const Unit& u, int wr, int wc, int fr, int fq
__device__ __forceinline__ v4u pack8(f32x4 a, f32x4 b) { v4u w; w.x = cvt_pk_bf16(a[0], a[1]); w.y = cvt_pk_bf16(a[2], a[3]); w.z = cvt_pk_bf16(b[0], b[1]); w.w = cvt_pk_bf16(b[2], b[3]); return w; }

struct EpiIn {
    static constexpr bool PERM = true;
    bf16 *Q, *Kb, *VT, *UG; unsigned char* SG; const float* rstd;
    __device__ __forceinline__ void operator()(EPI_ARGS) const {
        const int pn = u.pn;
        if (pn == 4 || pn == 5) {
            f32x4 rsa[2][2];
#pragma unroll
            for (int bj = 0; bj < 2; ++bj) { const int t0 = u.pm * 256 + bj * 128 + wc * 32 + 8 * fq; rsa[bj][0] = *(const f32x4*)(rstd + t0); rsa[bj][1] = *(const f32x4*)(rstd + t0 + 4); }
            asm volatile("" : "+v"(rsa[0][0]), "+v"(rsa[0][1]), "+v"(rsa[1][0]), "+v"(rsa[1][1]));
#pragma unroll
            for (int bj = 0; bj < 2; ++bj) {
                const int t0 = u.pm * 256 + bj * 128 + wc * 32 + 8 * fq; const int b = t0 >> 13, i0 = t0 & 8191;
                const f32x4 rs0 = rsa[bj][0], rs1 = rsa[bj][1];
#pragma unroll
                for (int ai = 0; ai < 2; ++ai)
#pragma unroll
                    for (int m = 0; m < 4; ++m) {
                        const int vr = (pn - 4) * 256 + ai * 128 + wr * 64 + m * 16 + fr;
                        bf16* dst = VT + ((size_t)(b * 512 + vr)) * LPB + 32 + i0;
                        *(v4u*)dst = pack8(acc[ai][bj][m][0] * rs0, acc[ai][bj][m][1] * rs1);
                    }
            }
        } else {
            float rsv[2][4];
#pragma unroll
            for (int ai = 0; ai < 2; ++ai)
#pragma unroll
                for (int m = 0; m < 4; ++m) rsv[ai][m] = rstd[u.pm * 256 + ai * 128 + wr * 64 + m * 16 + fr];
            asm volatile("" : "+v"(rsv[0][0]), "+v"(rsv[0][1]), "+v"(rsv[0][2]), "+v"(rsv[0][3]), "+v"(rsv[1][0]), "+v"(rsv[1][1]), "+v"(rsv[1][2]), "+v"(rsv[1][3]));
#pragma unroll
            for (int ai = 0; ai < 2; ++ai)
#pragma unroll
                for (int m = 0; m < 4; ++m) {
                    const int row = u.pm * 256 + ai * 128 + wr * 64 + m * 16 + fr; const float rs = rsv[ai][m];
#pragma unroll
                    for (int bj = 0; bj < 2; ++bj) {
                        const int col0 = pn * 256 + bj * 128 + wc * 32 + 8 * fq;
                        f32x4 v0 = acc[ai][bj][m][0] * rs, v1 = acc[ai][bj][m][1] * rs;
                        if (pn < 2) { *(v4u*)(Q + (size_t)row * 512 + col0) = pack8(v0 * QSCALE, v1 * QSCALE); }
                        else if (pn < 4) { const int b = row >> 13, i = row & 8191; *(v4u*)(Kb + ((size_t)(b * LPB + 32 + i)) * 512 + (col0 - 512)) = pack8(v0, v1); }
                        else if (pn < 8) { const int c = col0 - 1536; const int mrow = row >> 6;
                            *(v4u*)(UG + ((((size_t)((c >> 4) * 16 + (mrow >> 5)) * 64 + (row & 63)) * 2 + ((c & 15) >> 3)) * 32 + (mrow & 31)) * 8) = pack8(v0, v1); }
                        else {
                            unsigned g0 = 0u, g1 = 0u;
#pragma unroll
                            for (int e = 0; e < 4; ++e) { g0 = __builtin_amdgcn_cvt_pk_u8_f32(floorf(fast_sigmoid(v0[e]) * 256.0f), e, g0); g1 = __builtin_amdgcn_cvt_pk_u8_f32(floorf(fast_sigmoid(v1[e]) * 256.0f), e, g1); }
                            *(v2u*)(SG + (size_t)row * 2048 + (col0 - 2048)) = (v2u){g0, g1};
                        }
                    }
                }
        }
    }
};

struct EpiGlu {
    static constexpr bool PERM = true;
    const bf16* Y; bf16* O; const float* bias;
    __device__ __forceinline__ void operator()(EPI_ARGS) const {
#pragma unroll
        for (int bj = 0; bj < 2; ++bj) {
            const int col0 = u.pn * 256 + bj * 128 + wc * 32 + 8 * fq;
            const f32x4 b0 = *(const f32x4*)(bias + col0), b1 = *(const f32x4*)(bias + col0 + 4);
#pragma unroll
            for (int ai = 0; ai < 2; ++ai)
#pragma unroll
                for (int m = 0; m < 4; ++m) {
                    const int row = u.pm * 256 + ai * 128 + wr * 64 + m * 16 + fr;
                    const v4u yv = *(const v4u*)(Y + (size_t)row * 512 + col0);
                    f32x4 v0 = acc[ai][bj][m][0] + b0, v1 = acc[ai][bj][m][1] + b1;
                    v0[0] = bflo(yv.x) * fast_sigmoid(v0[0]); v0[1] = bfhi(yv.x) * fast_sigmoid(v0[1]); v0[2] = bflo(yv.y) * fast_sigmoid(v0[2]); v0[3] = bfhi(yv.y) * fast_sigmoid(v0[3]);
                    v1[0] = bflo(yv.z) * fast_sigmoid(v1[0]); v1[1] = bfhi(yv.z) * fast_sigmoid(v1[1]); v1[2] = bflo(yv.w) * fast_sigmoid(v1[2]); v1[3] = bfhi(yv.w) * fast_sigmoid(v1[3]);
                    *(v4u*)(O + (size_t)row * 512 + col0) = pack8(v0, v1);
                }
        }
    }
};

struct EpiMerge {
    static constexpr bool PERM = true;
    const unsigned char* SG; bf16* O;
    static __device__ __forceinline__ float gq(unsigned w, int i) { return (float)((w >> (8 * i)) & 0xffu) + 0.5f; }
    __device__ __forceinline__ void mid(f32x4 (&acc)[2][2][4][2], const Unit& u, int wr, int wc, int fr, int fq) const {
#pragma unroll
        for (int ai = 0; ai < 2; ++ai)
#pragma unroll
            for (int m = 0; m < 4; ++m) {
                const int row = u.pm * 256 + ai * 128 + wr * 64 + m * 16 + fr;
#pragma unroll
                for (int bj = 0; bj < 2; ++bj) {
                    const int col0 = u.pn * 256 + bj * 128 + wc * 32 + 8 * fq;
                    const v2u ga = *(const v2u*)(SG + (size_t)row * 2048 + col0), gb = *(const v2u*)(SG + (size_t)row * 2048 + 1024 + col0);
                    f32x4& v0 = acc[ai][bj][m][0]; f32x4& v1 = acc[ai][bj][m][1];
#pragma unroll
                    for (int e = 0; e < 4; ++e) { v0[e] *= gq(ga.x, e) * __builtin_amdgcn_rcpf(gq(gb.x, e)); v1[e] *= gq(ga.y, e) * __builtin_amdgcn_rcpf(gq(gb.y, e)); }
                }
            }
    }
    __device__ __forceinline__ void operator()(EPI_ARGS) const {
#pragma unroll
        for (int ai = 0; ai < 2; ++ai)
#pragma unroll
            for (int m = 0; m < 4; ++m) {
                const int row = u.pm * 256 + ai * 128 + wr * 64 + m * 16 + fr;
#pragma unroll
                for (int bj = 0; bj < 2; ++bj) {
                    const int col0 = u.pn * 256 + bj * 128 + wc * 32 + 8 * fq;
                    const v2u g = *(const v2u*)(SG + (size_t)row * 2048 + 1024 + col0);
                    f32x4 v0 = acc[ai][bj][m][0], v1 = acc[ai][bj][m][1];
#pragma unroll
                    for (int e = 0; e < 4; ++e) { v0[e] *= gq(g.x, e) * 0.00390625f; v1[e] *= gq(g.y, e) * 0.00390625f; }
                    *(v4u*)(O + (size_t)row * 1024 + col0) = pack8(v0, v1);
                }
            }
    }
};

struct EpiOut {
    static constexpr bool PERM = true;
    const float* X; bf16* HB; unsigned char* HB8; float* ssqp;
    __device__ __forceinline__ void operator()(EPI_ARGS) const {
#pragma unroll
        for (int ai = 0; ai < 2; ++ai)
#pragma unroll
            for (int m = 0; m < 4; ++m) {
                const int row = u.pm * 256 + ai * 128 + wr * 64 + m * 16 + fr; float ss = 0.f;
#pragma unroll
                for (int bj = 0; bj < 2; ++bj) {
                    const int col0 = u.pn * 256 + bj * 128 + wc * 32 + 8 * fq;
                    const f32x4 x0 = *(const f32x4*)(X + (size_t)row * D + col0), x1 = *(const f32x4*)(X + (size_t)row * D + col0 + 4);
                    const f32x4 v0 = acc[ai][bj][m][0] + x0, v1 = acc[ai][bj][m][1] + x1;
                    *(v4u*)(HB + (size_t)row * D + col0) = pack8(v0, v1);
                    { int p0 = 0, p1 = 0;
                      p0 = __builtin_amdgcn_cvt_pk_fp8_f32(v0[0], v0[1], p0, false); p0 = __builtin_amdgcn_cvt_pk_fp8_f32(v0[2], v0[3], p0, true);
                      p1 = __builtin_amdgcn_cvt_pk_fp8_f32(v1[0], v1[1], p1, false); p1 = __builtin_amdgcn_cvt_pk_fp8_f32(v1[2], v1[3], p1, true);
                      *(v2u*)(HB8 + (size_t)row * D + col0) = (v2u){(unsigned)p0, (unsigned)p1}; }
                    ss += (v0[0] * v0[0] + v0[1] * v0[1]) + (v0[2] * v0[2] + v0[3] * v0[3]) + (v1[0] * v1[0] + v1[1] * v1[1]) + (v1[2] * v1[2] + v1[3] * v1[3]);
                }
                { const int ln = fq * 16 + fr; ss += shx(ss, 16, ln); ss += shx(ss, 32, ln); }
                if (fq == 0) ssqp[(size_t)row * 16 + u.pn * 4 + wc] = ss;
            }
    }
};

struct EpiUp {
    static constexpr bool PERM = true;
    const float* srs; unsigned char* HID;
    __device__ __forceinline__ void operator()(EPI_ARGS) const {
        const int pnl = u.pn & 3;
        float rsv[2][4];
#pragma unroll
        for (int ai = 0; ai < 2; ++ai)
#pragma unroll
            for (int m = 0; m < 4; ++m) rsv[ai][m] = srs[u.pm * 256 + ai * 128 + wr * 64 + m * 16 + fr];
        asm volatile("" : "+v"(rsv[0][0]), "+v"(rsv[0][1]), "+v"(rsv[0][2]), "+v"(rsv[0][3]), "+v"(rsv[1][0]), "+v"(rsv[1][1]), "+v"(rsv[1][2]), "+v"(rsv[1][3]));
#pragma unroll
        for (int ai = 0; ai < 2; ++ai)
#pragma unroll
            for (int m = 0; m < 4; ++m) {
                const int slot = u.pm * 256 + ai * 128 + wr * 64 + m * 16 + fr; const float rs = rsv[ai][m];
                f32x4 h0, h1;
#pragma unroll
                for (int e = 0; e < 4; ++e) {
                    const float a0 = acc[ai][0][m][0][e] * rs, c0 = acc[ai][1][m][0][e] * rs; h0[e] = a0 * fast_sigmoid(a0) * c0 * 4.0f;
                    const float a1 = acc[ai][0][m][1][e] * rs, c1 = acc[ai][1][m][1][e] * rs; h1[e] = a1 * fast_sigmoid(a1) * c1 * 4.0f;
                }
                int p0 = 0, p1 = 0;
                p0 = __builtin_amdgcn_cvt_pk_fp8_f32(h0[0], h0[1], p0, false); p0 = __builtin_amdgcn_cvt_pk_fp8_f32(h0[2], h0[3], p0, true);
                p1 = __builtin_amdgcn_cvt_pk_fp8_f32(h1[0], h1[1], p1, false); p1 = __builtin_amdgcn_cvt_pk_fp8_f32(h1[2], h1[3], p1, true);
                *(v2u*)(HID + (size_t)slot * FF + pnl * 128 + wc * 32 + 8 * fq) = (v2u){(unsigned)p0, (unsigned)p1};
            }
    }
};

struct EpiDown {
    static constexpr bool PERM = true;
    const int* sdst; const float* sgate; unsigned char* YB;
    __device__ __forceinline__ void operator()(EPI_ARGS) const {
        const int pnl = u.pn & 3;
#pragma unroll
        for (int ai = 0; ai < 2; ++ai)
#pragma unroll
            for (int m = 0; m < 4; ++m) {
                const int slot = u.pm * 256 + ai * 128 + wr * 64 + m * 16 + fr; const int dst = sdst[slot]; const float gt = sgate[slot] * 16.0f;
                if (dst >= 0) {
#pragma unroll
                    for (int bj = 0; bj < 2; ++bj) {
                        const f32x4 a = acc[ai][bj][m][0] * gt, c2 = acc[ai][bj][m][1] * gt; int p0 = 0, p1 = 0;
                        p0 = __builtin_amdgcn_cvt_pk_fp8_f32(a[0], a[1], p0, false); p0 = __builtin_amdgcn_cvt_pk_fp8_f32(a[2], a[3], p0, true);
                        p1 = __builtin_amdgcn_cvt_pk_fp8_f32(c2[0], c2[1], p1, false); p1 = __builtin_amdgcn_cvt_pk_fp8_f32(c2[2], c2[3], p1, true);
                        *(v2u*)(YB + ((unsigned)dst * (unsigned)D + (unsigned)(pnl * 256 + bj * 128 + wc * 32 + 8 * fq))) = (v2u){(unsigned)p0, (unsigned)p1};
                    }
                }
            }
    }
};

__device__ __forceinline__ void p0_transpose_block(const float* W, int N, int k0, int n0, bf16* dst, int ldk, const float* ksc, LAS float* scr, int lane) {
#pragma unroll 8
    for (int i = 0; i < 32; ++i) { const int kk = 2 * i + (lane >> 5); float v = W[(size_t)(k0 + kk) * N + n0 + (lane & 31)]; if (ksc) v *= ksc[k0 + kk]; scr[kk * 33 + (lane & 31)] = v; }
    LDS_WAIT(); asm volatile("" ::: "memory");
    const int c = lane & 7;
#pragma unroll
    for (int j = 0; j < 4; ++j) { const int n = (lane >> 3) + 8 * j; const LAS float* s = scr + (8 * c) * 33 + n;
        v4u o; o.x = cvt_pk_bf16(s[0 * 33], s[1 * 33]); o.y = cvt_pk_bf16(s[2 * 33], s[3 * 33]); o.z = cvt_pk_bf16(s[4 * 33], s[5 * 33]); o.w = cvt_pk_bf16(s[6 * 33], s[7 * 33]);
        *(v4u*)(dst + (size_t)n * ldk + k0 + 8 * c) = o; }
    LDS_WAIT(); asm volatile("" ::: "memory");
}


__device__ __forceinline__ float gelu_tanh(float x) { const float u = 0.7978845608028654f * (x + 0.044715f * x * x * x); return x * fast_sigmoid(2.0f * u); }
typedef unsigned short us4 __attribute__((ext_vector_type(4)));

__device__ __forceinline__ void attn_unit(const bf16* Qb, const bf16* Kb, const bf16* VT, bf16* Ob, int b, int head, int qb, int lane, LAS unsigned char* wl) {
    const int l31 = lane & 31, h = lane >> 5;
    const int row = b * SEQ + qb * 32 + l31;
    bf16x8 qf[4];
#pragma unroll
    for (int st = 0; st < 4; ++st) qf[st] = *(const bf16x8*)(Qb + (size_t)row * 512 + head * 64 + 16 * st + 8 * h);
    const int Pq0 = 16 + qb * 32, qpos = Pq0 + l31;
    f32x16 o0, o1;
#pragma unroll
    for (int r = 0; r < 16; ++r) { o0[r] = 0.f; o1[r] = 0.f; }
    float carry = 1.f;
    LAS unsigned char* kl = wl; LAS unsigned char* vl = wl + 32 * 144;
    const bf16* kg = Kb + ((size_t)b * LPB + 16 + (lane >> 3)) * 512 + head * 64 + (lane & 7) * 8;
    const bf16* vg = VT + ((size_t)(b * 512 + head * 64 + (lane >> 2))) * LPB + 16 + (lane & 3) * 8;
    const int kwo = (lane >> 3) * 144 + (lane & 7) * 16, vwo = (lane >> 2) * 72 + (lane & 3) * 16;
    v4u krx[4], vrx[4], kry[4], vry[4];
#define ATT_GLOAD(kr, vr, kbx) do { _Pragma("unroll") for (int i = 0; i < 4; ++i) { kr[i] = *(const v4u*)(kg + (long)((kbx) + 8 * i) * 512); vr[i] = *(const v4u*)(vg + (size_t)(16 * i) * LPB + (long)(kbx)); } } while (0)
#define ATT_STAGE(kr, vr) do { _Pragma("unroll") for (int i = 0; i < 4; ++i) { *(LAS v4u*)(kl + kwo + i * 8 * 144) = kr[i]; \
        *(LAS v2u*)(vl + vwo + i * 16 * 72) = (v2u){vr[i].x, vr[i].y}; *(LAS v2u*)(vl + vwo + i * 16 * 72 + 8) = (v2u){vr[i].z, vr[i].w}; } } while (0)
#define ATT_FRAGS(Sx, vax, vbx) do { bf16x8 kf_[4]; _Pragma("unroll") for (int st = 0; st < 4; ++st) kf_[st] = *(const LAS bf16x8*)(kl + l31 * 144 + st * 32 + 16 * h); \
        _Pragma("unroll") for (int db = 0; db < 2; ++db) _Pragma("unroll") for (int s2 = 0; s2 < 2; ++s2) { const LAS unsigned char* vp = vl + (db * 32 + l31) * 72 + (16 * s2 + 4 * h) * 2; vax[db][s2] = *(const LAS v2u*)vp; vbx[db][s2] = *(const LAS v2u*)(vp + 16); } \
        _Pragma("unroll") for (int r = 0; r < 16; ++r) Sx[r] = 0.f; \
        _Pragma("unroll") for (int st = 0; st < 4; ++st) Sx = __builtin_amdgcn_mfma_f32_32x32x16_bf16(kf_[st], qf[st], Sx, 0, 0, 0); } while (0)
#define ATT_TILE(Sx, vax, vbx, kbx) do { \
        float be[16], kp[16]; \
        const bool boundary = ((kbx) + 31 >= Pq0) || ((kbx) < 0);        \
        _Pragma("unroll") for (int r = 0; r < 16; ++r) { const float e = __builtin_amdgcn_exp2f(-Sx[r]); be[r] = __builtin_amdgcn_rcpf(1.0f + e); kp[r] = 1.0f - be[r]; } \
        if (boundary) { _Pragma("unroll") for (int r = 0; r < 16; ++r) { const int key = (kbx) + (r & 3) + 8 * (r >> 2) + 4 * h; const bool valid = (key < qpos) && (key >= 0); \
                be[r] = valid ? be[r] : 0.f; kp[r] = valid ? kp[r] : 1.f; } } \
        float gs[4], pg[4]; \
        _Pragma("unroll") for (int g = 0; g < 4; ++g) { gs[g] = (kp[4 * g] * kp[4 * g + 1]) * (kp[4 * g + 2] * kp[4 * g + 3]); pg[g] = shx(gs[g], 32, lane); } \
        float w[16]; float later = carry; \
        _Pragma("unroll") for (int g = 3; g >= 0; --g) { \
            const float p3 = later * (h == 0 ? pg[g] : 1.f); \
            const float p2 = p3 * kp[4 * g + 3], p1 = p2 * kp[4 * g + 2], p0 = p1 * kp[4 * g + 1]; \
            w[4 * g + 3] = be[4 * g + 3] * p3; w[4 * g + 2] = be[4 * g + 2] * p2; w[4 * g + 1] = be[4 * g + 1] * p1; w[4 * g] = be[4 * g] * p0; \
            later *= gs[g] * pg[g]; } \
        carry = later; \
        _Pragma("unroll") for (int s2 = 0; s2 < 2; ++s2) { \
            v4u wp; wp.x = cvt_pk_bf16(w[8 * s2], w[8 * s2 + 1]); wp.y = cvt_pk_bf16(w[8 * s2 + 2], w[8 * s2 + 3]); wp.z = cvt_pk_bf16(w[8 * s2 + 4], w[8 * s2 + 5]); wp.w = cvt_pk_bf16(w[8 * s2 + 6], w[8 * s2 + 7]); \
            const bf16x8 wf = __builtin_bit_cast(bf16x8, wp); \
            v4u v0; v0.x = vax[0][s2].x; v0.y = vax[0][s2].y; v0.z = vbx[0][s2].x; v0.w = vbx[0][s2].y; \
            v4u v1; v1.x = vax[1][s2].x; v1.y = vax[1][s2].y; v1.z = vbx[1][s2].x; v1.w = vbx[1][s2].y; \
            o0 = __builtin_amdgcn_mfma_f32_32x32x16_bf16(__builtin_bit_cast(bf16x8, v0), wf, o0, 0, 0, 0); \
            o1 = __builtin_amdgcn_mfma_f32_32x32x16_bf16(__builtin_bit_cast(bf16x8, v1), wf, o1, 0, 0, 0); } } while (0)
#define ATT_STEP(kr, vr, kbx) do { ATT_STAGE(kr, vr); const int kb2_ = ((kbx) - 64 > -32) ? (kbx) - 64 : (kbx); ATT_GLOAD(kr, vr, kb2_); \
        f32x16 S_; v2u va_[2][2], vb_[2][2]; ATT_FRAGS(S_, va_, vb_); ATT_TILE(S_, va_, vb_, kbx); } while (0)
    ATT_GLOAD(krx, vrx, Pq0);
    { const int kb1 = (Pq0 - 32 > -32) ? Pq0 - 32 : Pq0; ATT_GLOAD(kry, vry, kb1); }
    for (int kb = Pq0; ; kb -= 64) {
        ATT_STEP(krx, vrx, kb);
        if (__all(carry < 9.3132257e-10f)) break;
        if (!((kb - 32) > -32)) break;
        ATT_STEP(kry, vry, kb - 32);
        if (__all(carry < 9.3132257e-10f)) break;
        if (!((kb - 64) > -32)) break;
    }
#undef ATT_STEP
#undef ATT_TILE
#undef ATT_GLOAD
#undef ATT_STAGE
#undef ATT_FRAGS
    bf16* op = Ob + (size_t)row * 512 + head * 64 + 4 * h;
#pragma unroll
    for (int g = 0; g < 4; ++g) {
        v2u a; a.x = cvt_pk_bf16(o0[4 * g], o0[4 * g + 1]); a.y = cvt_pk_bf16(o0[4 * g + 2], o0[4 * g + 3]); *(v2u*)(op + 8 * g) = a;
        v2u d; d.x = cvt_pk_bf16(o1[4 * g], o1[4 * g + 1]); d.y = cvt_pk_bf16(o1[4 * g + 2], o1[4 * g + 3]); *(v2u*)(op + 32 + 8 * g) = d;
    }
}


struct Tr64 { const float* W; int N, k0, n0, ldk; bf16* dst; const float* ksc; int f8; float osc; };
__device__ __forceinline__ void tr64_load(const Tr64& t, f32x4 (&v)[16], int lane) {
    const float* p = t.W + (size_t)(t.k0 + (lane >> 4)) * t.N + t.n0 + 4 * (lane & 15);
#pragma unroll
    for (int i = 0; i < 16; ++i) v[i] = __builtin_nontemporal_load((const f32x4*)(p + (size_t)(4 * i) * t.N));
}
__device__ __forceinline__ void tr64_store(const Tr64& t, const f32x4 (&v)[16], LAS float* scr, int lane) {
    const int cch = lane & 7;
    f32x4 g0 = (f32x4){1.f, 1.f, 1.f, 1.f}, g1 = g0;
    if (t.ksc) { g0 = *(const f32x4*)(t.ksc + t.k0 + 8 * cch); g1 = *(const f32x4*)(t.ksc + t.k0 + 8 * cch + 4); }
    { LAS float* w = scr + (lane >> 4) * 65 + 4 * (lane & 15);
#pragma unroll
        for (int i = 0; i < 16; ++i) { w[(4 * i) * 65 + 0] = v[i][0]; w[(4 * i) * 65 + 1] = v[i][1]; w[(4 * i) * 65 + 2] = v[i][2]; w[(4 * i) * 65 + 3] = v[i][3]; } }
    LDS_WAIT(); asm volatile("" ::: "memory");
    if (t.f8) { g0 = g0 * t.osc; g1 = g1 * t.osc;
#pragma unroll
        for (int jj = 0; jj < 8; ++jj) { const int n = (lane >> 3) + 8 * jj; const LAS float* sp = scr + (8 * cch) * 65 + n; int p0 = 0, p1 = 0;
            p0 = __builtin_amdgcn_cvt_pk_fp8_f32(sp[0 * 65] * g0[0], sp[1 * 65] * g0[1], p0, false); p0 = __builtin_amdgcn_cvt_pk_fp8_f32(sp[2 * 65] * g0[2], sp[3 * 65] * g0[3], p0, true);
            p1 = __builtin_amdgcn_cvt_pk_fp8_f32(sp[4 * 65] * g1[0], sp[5 * 65] * g1[1], p1, false); p1 = __builtin_amdgcn_cvt_pk_fp8_f32(sp[6 * 65] * g1[2], sp[7 * 65] * g1[3], p1, true);
            *(v2u*)((unsigned char*)t.dst + (size_t)n * t.ldk + t.k0 + 8 * cch) = (v2u){(unsigned)p0, (unsigned)p1}; }
    } else {
#pragma unroll
    for (int jj = 0; jj < 8; ++jj) { const int n = (lane >> 3) + 8 * jj; const LAS float* sp = scr + (8 * cch) * 65 + n;
        v4u o; o.x = cvt_pk_bf16(sp[0 * 65] * g0[0], sp[1 * 65] * g0[1]); o.y = cvt_pk_bf16(sp[2 * 65] * g0[2], sp[3 * 65] * g0[3]);
        o.z = cvt_pk_bf16(sp[4 * 65] * g1[0], sp[5 * 65] * g1[1]); o.w = cvt_pk_bf16(sp[6 * 65] * g1[2], sp[7 * 65] * g1[3]);
        *(v4u*)(t.dst + (size_t)n * t.ldk + t.k0 + 8 * cch) = o; }
    }
    LDS_WAIT(); asm volatile("" ::: "memory");
}
constexpr int I_E1 = 32 * 16 * 8, I_E3 = I_E1, I_E2 = 32 * 8 * 16, NEX = I_E1 + I_E3 + I_E2;
__device__ __forceinline__ Tr64 expert_item(int r, const float* ew1, const float* ew3, const float* ew2, const float* g_ffn, bf16* WupT, bf16* W2T) {
    Tr64 t; t.f8 = 1;
    if (r < I_E1 + I_E3) { const int w3 = r >= I_E1; if (w3) r -= I_E1; const int e = r >> 7; t.k0 = 64 * ((r >> 3) & 15); t.n0 = 64 * (r & 7);
        const int drow = (t.n0 >> 7) * 256 + (t.n0 & 127) + (w3 ? 128 : 0);
        t.W = (w3 ? ew3 : ew1) + (size_t)e * D * FF; t.N = FF; t.dst = (bf16*)((unsigned char*)WupT + ((size_t)e * 1024 + drow) * 1024); t.ldk = 1024; t.ksc = g_ffn; t.osc = 32.0f; }
    else { r -= I_E1 + I_E3; const int e = r >> 7; t.k0 = 64 * ((r >> 4) & 7); t.n0 = 64 * (r & 15);
        t.W = ew2 + (size_t)e * FF * D; t.N = D; t.dst = (bf16*)((unsigned char*)W2T + ((size_t)e * 1024 + t.n0) * 512); t.ldk = 512; t.ksc = nullptr; t.osc = 16.0f; }
    return t;
}

__global__ void __launch_bounds__(NWAVES * 64, 2) fwd_kernel(Args args) {
    extern __shared__ __attribute__((aligned(16))) unsigned char lds_raw[];
    Frame F;
    F.lds = (LAS unsigned char*)lds_raw;
    F.MISC = (volatile LAS unsigned*)(F.lds + MISC_OFF);
    F.tid = threadIdx.x; F.lane = F.tid & 63; F.wave = __builtin_amdgcn_readfirstlane(F.tid >> 6);
    F.G = gridDim.x; { const int bx = blockIdx.x; F.vcu = (F.G % 8 == 0) ? (bx % 8) * (F.G / 8) + bx / 8 : bx; }
    unsigned char* ws = args.ws;
    gu32* ctl = (gu32*)(ws + WS_CTL);
    for (int u = F.tid; u < (LDS_BYTES - LDSCTL_OFF) / 4; u += NWAVES * 64) ((LAS unsigned*)(F.lds + LDSCTL_OFF))[u] = 0u;
    __syncthreads();
    XcdBarrier bar = xcd_barrier_post((unsigned*)(ctl + CW_BAR), F.MISC + 8);
    const int wave = F.wave, c = F.vcu;
    const int gw = c * NWAVES + wave, NGW = F.G * NWAVES;

    const float* x = args.in[0]; const float* meta_tok = args.in[1]; const float* g_mix = args.in[2]; const float* w_in = args.in[3];
    const float* lam_re = args.in[4]; const float* lam_im = args.in[5]; const float* log_dt = args.in[6];
    const float* b_re = args.in[7]; const float* b_im = args.in[8]; const float* c_re = args.in[9]; const float* c_im = args.in[10];
    const float* ssm_d = args.in[11]; const float* glu_w = args.in[12]; const float* glu_b = args.in[13];
    const float* w_pa = args.in[14]; const float* w_pb = args.in[15]; const float* w_out = args.in[16]; const float* g_ffn = args.in[17];
    const float* rg_w = args.in[18]; const float* rg_b = args.in[19]; const float* re_w = args.in[20]; const float* re_b = args.in[21];
    const float* ew1 = args.in[22]; const float* ew3 = args.in[23]; const float* ew2 = args.in[24]; const float* g_fin = args.in[25];
    float* out = args.out;
    float* rstd1 = (float*)(ws + SM_RSTD1); float* rstd2 = (float*)(ws + SM_RSTD2);
    int* eid = (int*)(ws + SM_EID); float* gatev = (float*)(ws + SM_GATE); int* cntg = (int*)(ws + SM_CNT);
    float* umeta = (float*)(ws + SM_UMETA); float* bbar_g = (float*)(ws + SM_BBAR); float* lbar_g = (float*)(ws + SM_LBAR); float* l64_g = (float*)(ws + SM_L64);
    int* sdst = (int*)(ws + SM_SDST); float* sgate = (float*)(ws + SM_SGATE); float* srs = (float*)(ws + SM_SRS);
    float* metapart = (float*)(ws + SM_METAP);
    bf16* wr_t = (bf16*)(ws + SM_WR); float* rbias = (float*)(ws + SM_RB); int* moemeta = (int*)(ws + SM_MOEMETA); float* ssqp = (float*)(ws + SM_SSQP);
    bf16* WinT = (bf16*)(ws + WS_WIN); bf16* WpabT = (bf16*)(ws + WS_WPAB); bf16* WoT = (bf16*)(ws + WS_WO); bf16* GluT = (bf16*)(ws + WS_GLU);
    bf16* KT = (bf16*)(ws + WS_KT); bf16* T2 = (bf16*)(ws + WS_T2); bf16* T3 = (bf16*)(ws + WS_T3);
    bf16* WupT = (bf16*)(ws + WS_WUP); bf16* W2T = (bf16*)(ws + WS_W2);
    unsigned char* XB = ws + WS_XB; bf16* MRG = (bf16*)(ws + WS_XB);
    bf16* Qb = (bf16*)(ws + WS_Q); bf16* SSMb = (bf16*)(ws + WS_SSM); bf16* Kb = (bf16*)(ws + WS_K); bf16* VT = (bf16*)(ws + WS_VT);
    bf16* UG = (bf16*)(ws + WS_UG); bf16* Yb = (bf16*)(ws + WS_Y); float* Sst = (float*)(ws + WS_S); bf16* Xs = (bf16*)(ws + WS_XS);
    bf16* H1B = (bf16*)(ws + WS_H1B); unsigned char* H1B8 = ws + WS_H1B8; unsigned char* HID = ws + WS_HID; unsigned char* YB = (unsigned char*)(ws + WS_YB);
    unsigned char* SG = ws + WS_SG;
    int* inv_tok = (int*)(ws + WS_INV); float* inv_gate = (float*)(ws + WS_INV + (size_t)NE * CAPE * 4); float* inv_rs = (float*)(ws + WS_INV + (size_t)2 * NE * CAPE * 4);
    int* mymeta = (int*)(ws + WS_MWG) + (size_t)blockIdx.x * 512; unsigned* etot = (unsigned*)(ctl + CW_TOT);

    for (int rep = 0; rep < REP_P0; ++rep) {
        int tid = threadIdx.x; asm volatile("" : "+v"(tid)); const int lane = tid & 63; (void)lane;
        if (rep) { __syncthreads(); if (tid == 0) F.MISC[0] = 0u; __syncthreads(); }
        if (c & 1) {
            LAS float* scr = (LAS float*)(F.lds + wave * P0_SCR);
            constexpr int I_IN = 16 * 64, I_PA = 8 * 16, I_PB = 8 * 16, I_O = 16 * 16, I_G = 8 * 8;
            constexpr int NTR = I_IN + I_PA + I_PB + I_O + I_G, NXR = M / 4, NITEMS = NTR + NXR;
            const int per_wg = (REP_P0S * NITEMS + F.G - 1) / F.G;
            for (;;) {
                int kq = 0; if (lane == 0) kq = (int)__hip_atomic_fetch_add((unsigned*)(F.MISC + 0), 1u, __ATOMIC_RELAXED, __HIP_MEMORY_SCOPE_WORKGROUP);
                kq = __builtin_amdgcn_readfirstlane(kq);
                if (kq >= per_wg) break;
                int it = kq * F.G + c; if (it >= REP_P0S * NITEMS) break;
                if (REP_P0S > 1) it %= NITEMS;
                if (it >= NTR) {
                    const int m0 = (it - NTR) * 4; f32x4 v[4][4];
#pragma unroll
                    for (int q = 0; q < 4; ++q) { const f32x4* xr = (const f32x4*)(x + (size_t)(m0 + q) * D) + lane;
#pragma unroll
                        for (int jj = 0; jj < 4; ++jj) v[q][jj] = __builtin_nontemporal_load(&xr[64 * jj]); }
#pragma unroll
                    for (int q = 0; q < 4; ++q) { float ss = 0.f;
#pragma unroll
                        for (int jj = 0; jj < 4; ++jj) ss += (v[q][jj][0] * v[q][jj][0] + v[q][jj][1] * v[q][jj][1]) + (v[q][jj][2] * v[q][jj][2] + v[q][jj][3] * v[q][jj][3]);
                        ss = wave_sum(ss, lane);
                        if (lane == 0) rstd1[m0 + q] = 1.0f / sqrtf(ss * (1.0f / D) + RMS_EPS);
                        unsigned* o4 = (unsigned*)(XB + (size_t)(m0 + q) * D) + lane;
#pragma unroll
                        for (int jj = 0; jj < 4; ++jj) { int p = 0; p = __builtin_amdgcn_cvt_pk_fp8_f32(v[q][jj][0], v[q][jj][1], p, false); p = __builtin_amdgcn_cvt_pk_fp8_f32(v[q][jj][2], v[q][jj][3], p, true); o4[64 * jj] = (unsigned)p; } }
                    continue;
                }
                int r = it; const float* W; int N, k0, n0, ldk; bf16* dst; const float* ksc = nullptr; int f8 = 0; float osc = 1.0f;
                if (r < I_IN) { W = w_in; N = INC; k0 = 64 * (r >> 6); n0 = 64 * (r & 63); dst = (bf16*)((unsigned char*)WinT + (size_t)n0 * 1024); ldk = 1024; ksc = g_mix; f8 = 1; osc = 32.0f; }
                else if ((r -= I_IN) < I_PA) { W = w_pa; N = D; k0 = 64 * (r >> 4); n0 = 64 * (r & 15); dst = WpabT + (size_t)n0 * 512; ldk = 512; }
                else if ((r -= I_PA) < I_PB) { W = w_pb; N = D; k0 = 64 * (r >> 4); n0 = 64 * (r & 15); dst = WpabT + (size_t)(1024 + n0) * 512; ldk = 512; }
                else if ((r -= I_PB) < I_O) { W = w_out; N = D; k0 = 64 * (r >> 4); n0 = 64 * (r & 15); dst = WoT + (size_t)n0 * 1024; ldk = 1024; }
                else { r -= I_O; W = glu_w; N = SW; k0 = 64 * (r >> 3); n0 = 64 * (r & 7); dst = GluT + (size_t)n0 * 512; ldk = 512; }
                { Tr64 t; t.W = W; t.N = N; t.k0 = k0; t.n0 = n0; t.ldk = ldk; t.dst = dst; t.ksc = ksc; t.f8 = f8; t.osc = osc; f32x4 tv[16]; tr64_load(t, tv, lane); tr64_store(t, tv, scr, lane); }
            }
            __syncthreads();
        }
        {
            const int g = c >> 3, j = c & 7;
            LAS f32x2* LP = (LAS f32x2*)(F.lds);
            LAS f32x2* BB = (LAS f32x2*)(F.lds + 33792);
            LAS f32x2* CC = (LAS f32x2*)(F.lds + 33792 + 8192);
            LAS f32x2* CL = (LAS f32x2*)(F.lds + 33792 + 16384);
            LAS float* mrs = (LAS float*)(F.lds + 33792 + 16384 + 65536);
            const float dt = expf(log_dt[g]);
#pragma unroll 1
            for (int idx = tid; idx < 65 * 64; idx += 512) {
                const int n = idx >> 6, p = idx & 63; const float lr = lam_re[g * 64 + p], li = lam_im[g * 64 + p];
                const float mag = expf((float)n * (lr * dt));
                const float rev1 = (li * dt) * 0.15915494309189535f; const float hi = (float)n * rev1; const float lo = fmaf((float)n, rev1, -hi);
                const float fr_ = (hi - rintf(hi)) + lo; const float sn = __builtin_amdgcn_sinf(fr_), cs = __builtin_amdgcn_cosf(fr_);
                LP[idx] = (f32x2){mag * cs, mag * sn};
            }
            for (int idx = tid; idx < 1024; idx += 512) { const int cc = idx >> 6, p = idx & 63; CC[idx] = (f32x2){c_re[(g * 16 + cc) * 64 + p], c_im[(g * 16 + cc) * 64 + p]}; }
            for (int r = 2 * wave; r < 2 * wave + 2; ++r) {
                float ss = 0.f;
#pragma unroll
                for (int i = 0; i < 16; ++i) { const float v = meta_tok[r * 1024 + lane + 64 * i]; ss += v * v; }
                ss = wave_sum(ss, lane);
                if (lane == 0) mrs[r] = 1.0f / sqrtf(ss * (1.0f / 1024.0f) + RMS_EPS);
            }
            __syncthreads();
            for (int idx = tid; idx < 1024; idx += 512) {
                const int p = idx >> 4, cp = idx & 15; const float lr = lam_re[g * 64 + p], li = lam_im[g * 64 + p];
                const f32x2 L1 = LP[64 + p]; const float nr = L1.x - 1.0f, ni = L1.y, den = lr * lr + li * li;
                const float fre = (nr * lr + ni * li) / den, fim = (ni * lr - nr * li) / den;
                const float br = b_re[(g * 64 + p) * 16 + cp], bi = b_im[(g * 64 + p) * 16 + cp];
                const f32x2 v = (f32x2){fre * br - fim * bi, fre * bi + fim * br};
                BB[idx] = v;
                if (j == 0) { bbar_g[((g * 64 + p) * 16 + cp) * 2] = v.x; bbar_g[((g * 64 + p) * 16 + cp) * 2 + 1] = v.y; }
            }
#pragma unroll 2
            for (int idx = tid; idx < 8192; idx += 512) { const int nl = idx >> 10, cc = (idx >> 6) & 15, p = idx & 63; const f32x2 C = CC[cc * 64 + p], L = LP[(8 * j + nl) * 64 + p];
                CL[idx] = (f32x2){C.x * L.x - C.y * L.y, C.x * L.y + C.y * L.x}; }
            if (j == 0 && tid < 64) { const f32x2 L1 = LP[64 + tid], L64 = LP[64 * 64 + tid];
                lbar_g[(g * 64 + tid) * 2] = L1.x; lbar_g[(g * 64 + tid) * 2 + 1] = L1.y; l64_g[(g * 64 + tid) * 2] = L64.x; l64_g[(g * 64 + tid) * 2 + 1] = L64.y; }
            __syncthreads();
#pragma unroll 1
            for (int idx = tid; idx < 2048; idx += 512) {
                const int nl = idx >> 8, cc = (idx >> 4) & 15, cp = idx & 15; float a = 0.f;
                const LAS f32x2* clp = CL + (nl * 16 + cc) * 64;
#pragma unroll 8
                for (int p = 0; p < 64; ++p) { const f32x2 X = clp[p], B = BB[p * 16 + cp]; a += X.x * B.x - X.y * B.y; }
                const int n = 8 * j + nl;
                if (n == 0 && cc == cp) a += ssm_d[g * 16 + cc];
                KT[((size_t)(g * KT_ROWS + n + 1)) * 256 + cc * 16 + cp] = (bf16)(cvt_pk_bf16(a, 0.f) & 0xffffu);
            }
            if (j == 0 && tid < 256) KT[((size_t)(g * KT_ROWS)) * 256 + tid] = 0;
#pragma unroll 2
            for (int idx = tid; idx < 16384; idx += 512) {
                const int kk = idx & 127, nn = idx >> 7; const int s2 = 8 * j + (kk >> 4), cp = kk & 15, ri = nn >> 6, p = nn & 63;
                const f32x2 L = LP[(63 - s2) * 64 + p], B = BB[p * 16 + cp];
                const float v = ri ? (L.x * B.y + L.y * B.x) : (L.x * B.x - L.y * B.y);
                T2[((((size_t)(g * 4 + (nn >> 5)) * 64 + s2) * 2 + (cp >> 3)) * 32 + (nn & 31)) * 8 + (cp & 7)] = (bf16)(cvt_pk_bf16(v, 0.f) & 0xffffu);
            }
#pragma unroll 2
            for (int idx = tid; idx < 16384; idx += 512) {
                const int kk = idx & 127, nl = idx >> 7; const int t = 8 * j + (nl >> 4), cc = nl & 15, ri = kk >> 6, p = kk & 63;
                const f32x2 L = LP[(t + 1) * 64 + p], C = CC[cc * 64 + p];
                const float v = ri ? -(C.x * L.y + C.y * L.x) : (C.x * L.x - C.y * L.y);
                T3[((((size_t)(g * 32 + (t >> 1)) * 8 + (kk >> 4)) * 2 + ((kk >> 3) & 1)) * 32 + (t & 1) * 16 + cc) * 8 + (kk & 7)] = (bf16)(cvt_pk_bf16(v, 0.f) & 0xffffu);
            }
            float my_rs[16];
            if (wave == 0 && c < 192) {
#pragma unroll
                for (int r = 0; r < 16; ++r) my_rs[r] = mrs[r];
            }
            __syncthreads();
            LAS float* scr = (LAS float*)(F.lds + wave * P0_SCR);
            if (wave == 0 && c < 192) {
                const int cb = c >> 3, kp = c & 7, k0 = 128 * kp, n = 512 + 64 * cb + lane;
#pragma unroll
                for (int r = 0; r < 16; ++r) { const float g0 = g_mix[k0 + lane], g1 = g_mix[k0 + 64 + lane];
                    scr[r * 128 + lane] = meta_tok[r * 1024 + k0 + lane] * my_rs[r] * g0; scr[r * 128 + 64 + lane] = meta_tok[r * 1024 + k0 + 64 + lane] * my_rs[r] * g1; }
                LDS_WAIT(); asm volatile("" ::: "memory");
                float a[16];
#pragma unroll
                for (int r = 0; r < 16; ++r) a[r] = 0.f;
#pragma unroll 4
                for (int k = 0; k < 128; k += 4) {
                    const float w0 = w_in[(size_t)(k0 + k) * INC + n], w1 = w_in[(size_t)(k0 + k + 1) * INC + n], w2 = w_in[(size_t)(k0 + k + 2) * INC + n], w3 = w_in[(size_t)(k0 + k + 3) * INC + n];
#pragma unroll
                    for (int r = 0; r < 16; ++r) { const f32x4 xv = *(const LAS f32x4*)(scr + r * 128 + k); a[r] += xv[0] * w0 + xv[1] * w1 + xv[2] * w2 + xv[3] * w3; }
                }
#pragma unroll
                for (int r = 0; r < 16; ++r) metapart[((size_t)kp * 16 + r) * 1536 + 64 * cb + lane] = a[r];
                LDS_WAIT(); asm volatile("" ::: "memory");
            } else if (wave == 1 && c < 64) {
                const int n = c;
#pragma unroll 4
                for (int i = 0; i < 16; ++i) { const int k = lane + 64 * i; float v = 0.f;
                    if (n < 4) v = rg_w[k * 4 + n] * g_ffn[k]; else if (n < 36) v = re_w[k * 32 + (n - 4)] * g_ffn[k];
                    const unsigned hi = cvt_pk_bf16(v, 0.f) & 0xffffu; const float lo = v - bf2f((unsigned short)hi);
                    const int fo = ((((n >> 5) * 64 + (k >> 4)) * 2 + ((k >> 3) & 1)) * 32 + (n & 31)) * 8 + (k & 7);
                    wr_t[fo] = (bf16)hi; wr_t[65536 + fo] = (bf16)(cvt_pk_bf16(lo, 0.f) & 0xffffu); }
                if (lane == 0) rbias[n] = n < 4 ? rg_b[n] : (n < 36 ? re_b[n - 4] : 0.f);
            } else if (wave == 1 && c < 72) {
                const int it = c - 64, b = it >> 1;
                if (it & 1) { for (int idx = lane; idx < 512 * 16; idx += 64) { const int cc = idx >> 4, r = idx & 15; VT[((size_t)(b * 512 + cc)) * LPB + r] = 0; } }
                else { for (int idx = lane; idx < 16 * 512; idx += 64) Kb[((size_t)(b * LPB)) * 512 + idx] = 0; }
            }
            if (!(c & 1)) {
            constexpr int I_IN = 16 * 64, I_PA = 8 * 16, I_PB = 8 * 16, I_O = 16 * 16, I_G = 8 * 8;
            constexpr int NTR = I_IN + I_PA + I_PB + I_O + I_G, NXR = M / 4, NITEMS = NTR + NXR;
            const int per_wg = (REP_P0S * NITEMS + F.G - 1) / F.G;
            for (;;) {
                int kq = 0; if (lane == 0) kq = (int)__hip_atomic_fetch_add((unsigned*)(F.MISC + 0), 1u, __ATOMIC_RELAXED, __HIP_MEMORY_SCOPE_WORKGROUP);
                kq = __builtin_amdgcn_readfirstlane(kq);
                if (kq >= per_wg) break;
                int it = kq * F.G + c; if (it >= REP_P0S * NITEMS) break;
                if (REP_P0S > 1) it %= NITEMS;
                if (it >= NTR) {
                    const int m0 = (it - NTR) * 4; f32x4 v[4][4];
#pragma unroll
                    for (int q = 0; q < 4; ++q) { const f32x4* xr = (const f32x4*)(x + (size_t)(m0 + q) * D) + lane;
#pragma unroll
                        for (int jj = 0; jj < 4; ++jj) v[q][jj] = __builtin_nontemporal_load(&xr[64 * jj]); }
#pragma unroll
                    for (int q = 0; q < 4; ++q) { float ss = 0.f;
#pragma unroll
                        for (int jj = 0; jj < 4; ++jj) ss += (v[q][jj][0] * v[q][jj][0] + v[q][jj][1] * v[q][jj][1]) + (v[q][jj][2] * v[q][jj][2] + v[q][jj][3] * v[q][jj][3]);
                        ss = wave_sum(ss, lane);
                        if (lane == 0) rstd1[m0 + q] = 1.0f / sqrtf(ss * (1.0f / D) + RMS_EPS);
                        unsigned* o4 = (unsigned*)(XB + (size_t)(m0 + q) * D) + lane;
#pragma unroll
                        for (int jj = 0; jj < 4; ++jj) { int p = 0; p = __builtin_amdgcn_cvt_pk_fp8_f32(v[q][jj][0], v[q][jj][1], p, false); p = __builtin_amdgcn_cvt_pk_fp8_f32(v[q][jj][2], v[q][jj][3], p, true); o4[64 * jj] = (unsigned)p; } }
                    continue;
                }
                int r = it; const float* W; int N, k0, n0, ldk; bf16* dst; const float* ksc = nullptr; int f8 = 0; float osc = 1.0f;
                if (r < I_IN) { W = w_in; N = INC; k0 = 64 * (r >> 6); n0 = 64 * (r & 63); dst = (bf16*)((unsigned char*)WinT + (size_t)n0 * 1024); ldk = 1024; ksc = g_mix; f8 = 1; osc = 32.0f; }
                else if ((r -= I_IN) < I_PA) { W = w_pa; N = D; k0 = 64 * (r >> 4); n0 = 64 * (r & 15); dst = WpabT + (size_t)n0 * 512; ldk = 512; }
                else if ((r -= I_PA) < I_PB) { W = w_pb; N = D; k0 = 64 * (r >> 4); n0 = 64 * (r & 15); dst = WpabT + (size_t)(1024 + n0) * 512; ldk = 512; }
                else if ((r -= I_PB) < I_O) { W = w_out; N = D; k0 = 64 * (r >> 4); n0 = 64 * (r & 15); dst = WoT + (size_t)n0 * 1024; ldk = 1024; }
                else { r -= I_O; W = glu_w; N = SW; k0 = 64 * (r >> 3); n0 = 64 * (r & 7); dst = GluT + (size_t)n0 * 512; ldk = 512; }
                { Tr64 t; t.W = W; t.N = N; t.k0 = k0; t.n0 = n0; t.ldk = ldk; t.dst = dst; t.ksc = ksc; t.f8 = f8; t.osc = osc; f32x4 tv[16]; tr64_load(t, tv, lane); tr64_store(t, tv, scr, lane); }
            }
            }
        }
    }
    xcd_barrier(bar);

#if PH_MAX >= 1
    for (int rep = 0; rep < REP_P1; ++rep) {
        P1Order S; S.so.init(M / 256, INC / 256, F.G, (int)blockIdx.x, WGM_P1); S.X = (const char*)XB; S.W = (const char*)WinT; S.t = (size_t)256 * 1024;
        EpiIn E{Qb, Kb, VT, UG, SG, rstd1};
        pg8::gemm_phase<EpiIn, P1Order, true, false, false, true>(F.lds + RING_OFF, 512, S, E, 0x7f7a);
        if (rep == REP_P1 - 1) {
            int tid = threadIdx.x; asm volatile("" : "+v"(tid));
            const int t = c * 512 + tid;
            if (t < 16 * 1536) {
                const int r = t / 1536, n = t % 1536; float sacc = 0.f;
#pragma unroll
                for (int kp = 0; kp < 8; ++kp) sacc += metapart[((size_t)kp * 16 + r) * 1536 + n];
                const bf16 hv = (bf16)(cvt_pk_bf16(sacc, 0.f) & 0xffffu);
                if (n < 512) { for (int b = 0; b < NB; ++b) Kb[((size_t)(b * LPB + 16 + r)) * 512 + n] = hv; }
                else if (n < 1024) { for (int b = 0; b < NB; ++b) VT[((size_t)(b * 512 + (n - 512))) * LPB + 16 + r] = hv; }
                else umeta[r * 512 + (n - 1024)] = sacc;
            }
        }
    }
    xcd_barrier(bar);
#endif


#if PH_MAX >= 2
    for (int rep = 0; rep < REP_SSM; ++rep) {
    if (c < 128) {
        int tid = threadIdx.x; asm volatile("" : "+v"(tid)); const int lane = tid & 63;
        const int b = c >> 5, g = c & 31;
        LAS float* SL = (LAS float*)(F.lds);
        LAS f32x2* ends = (LAS f32x2*)(F.lds + 128 * 129 * 4);
        {
            const int mbl = wave >> 1, nh = wave & 1, mb = 4 * b + mbl;
            const int l31 = lane & 31, h = lane >> 5;
            f32x16 a2[2];
#pragma unroll
            for (int r = 0; r < 16; ++r) { a2[0][r] = 0.f; a2[1][r] = 0.f; }
            const bf16* ua = UG + (size_t)(g * 16 + mb) * 64 * 512 + lane * 8;
            const bf16* t2 = T2 + (size_t)(g * 4 + 2 * nh) * 64 * 512 + lane * 8;
#pragma unroll 8
            for (int s2 = 0; s2 < 64; ++s2) {
                const bf16x8 a = *(const bf16x8*)(ua + s2 * 512);
                const bf16x8 b0 = *(const bf16x8*)(t2 + s2 * 512), b1 = *(const bf16x8*)(t2 + 64 * 512 + s2 * 512);
                a2[0] = __builtin_amdgcn_mfma_f32_32x32x16_bf16(a, b0, a2[0], 0, 0, 0);
                a2[1] = __builtin_amdgcn_mfma_f32_32x32x16_bf16(a, b1, a2[1], 0, 0, 0);
            }
#pragma unroll
            for (int t = 0; t < 2; ++t)
#pragma unroll
                for (int r = 0; r < 16; ++r) SL[(32 * mbl + (r & 3) + 8 * (r >> 2) + 4 * h) * 129 + (2 * nh + t) * 32 + l31] = a2[t][r];
        }
        __syncthreads();
        {
            const int seg = wave & 3, p = lane;
            const float lr = lbar_g[(g * 64 + p) * 2], li = lbar_g[(g * 64 + p) * 2 + 1], qr = l64_g[(g * 64 + p) * 2], qi = l64_g[(g * 64 + p) * 2 + 1];
            float vr[32], vi[32];
            float cr = 0.f, ci = 0.f, q32r = qr, q32i = qi;
            if (wave < 4) {
#pragma unroll
                for (int m = 0; m < 32; ++m) { vr[m] = SL[(32 * seg + m) * 129 + p]; vi[m] = SL[(32 * seg + m) * 129 + 64 + p]; }
                float xr = 0.f, xi = 0.f;
#pragma unroll
                for (int m = 0; m < 32; ++m) { const float sr = vr[m], si = vi[m]; vr[m] = xr; vi[m] = xi; const float nr = qr * xr - qi * xi + sr, ni = qr * xi + qi * xr + si; xr = nr; xi = ni; }
                ends[seg * 64 + p] = (f32x2){xr, xi};
                for (int r = 0; r < NMETA; ++r) {
                    float bur = 0.f, bui = 0.f;
#pragma unroll
                    for (int cp = 0; cp < 16; ++cp) { const float uv = umeta[r * 512 + 16 * g + cp]; bur += bbar_g[((g * 64 + p) * 16 + cp) * 2] * uv; bui += bbar_g[((g * 64 + p) * 16 + cp) * 2 + 1] * uv; }
                    const float nr = lr * cr - li * ci + bur, ni = lr * ci + li * cr + bui; cr = nr; ci = ni;
                }
#pragma unroll
                for (int k = 0; k < 5; ++k) { const float nr = q32r * q32r - q32i * q32i, ni = 2.0f * q32r * q32i; q32r = nr; q32i = ni; }
            }
            __syncthreads();
            if (wave < 4) {
                for (int k = 0; k < seg; ++k) { const f32x2 e = ends[k * 64 + p]; const float nr = q32r * cr - q32i * ci + e.x, ni = q32r * ci + q32i * cr + e.y; cr = nr; ci = ni; }
                float pr_ = 1.f, pi_ = 0.f;
#pragma unroll
                for (int m = 0; m < 32; ++m) {
                    const float Xr = vr[m] + (pr_ * cr - pi_ * ci), Xi = vi[m] + (pr_ * ci + pi_ * cr);
                    { const int mrow = b * 128 + 32 * seg + m;
                      const size_t xo = ((((size_t)(g * 16 + (mrow >> 5)) * 8 + (p >> 4)) * 2 + ((p >> 3) & 1)) * 32 + (mrow & 31)) * 8 + (p & 7);
                      Xs[xo] = (bf16)(cvt_pk_bf16(Xr, 0.f) & 0xffffu); Xs[xo + 4 * 512] = (bf16)(cvt_pk_bf16(Xi, 0.f) & 0xffffu); }
                    const float nr = pr_ * qr - pi_ * qi, ni = pr_ * qi + pi_ * qr; pr_ = nr; pi_ = ni;
                }
            }
        }
        __syncthreads();
    }
    if (rep == 0) {
        int tid = threadIdx.x; asm volatile("" : "+v"(tid)); const int lane = tid & 63; (void)lane;
        LAS float* scr = (LAS float*)(F.lds + wave * P0_SCR);
#pragma unroll 1
        for (int pass = 0; pass < 2; ++pass) {
            const bool do_att = (pass == 0) != (wave >= 4);
            if (do_att) {
                const int nu = (c < 128) ? 3 : 5;
#pragma unroll 1
                for (int rp = 0; rp < REP_ATT; ++rp)
#pragma unroll 1
                for (int i = 0; i < nu; ++i) { const int cc = (i < 4) ? c : c - 128; const int qi = (i < 4) ? i : 3;
                    attn_unit(Qb, Kb, VT, (rp == REP_ATT - 1) ? Qb : SSMb, cc >> 6, wave, (cc & 63) * 4 + qi, lane, (LAS unsigned char*)scr); }
            } else {
#pragma unroll 1
                for (int k = 0; k < 4; k += 2) {
                    const Tr64 ta = expert_item(c + 256 * (wave + 8 * k), ew1, ew3, ew2, g_ffn, WupT, W2T);
                    const Tr64 tb = expert_item(c + 256 * (wave + 8 * (k + 1)), ew1, ew3, ew2, g_ffn, WupT, W2T);
                    f32x4 va[16], vb[16];
                    tr64_load(ta, va, lane); tr64_load(tb, vb, lane);
                    tr64_store(ta, va, scr, lane); tr64_store(tb, vb, scr, lane);
                }
            }
        }
    }
    xcd_barrier(bar);
    for (int ui = 0; ui < 2; ++ui) {
        int tid = threadIdx.x; asm volatile("" : "+v"(tid)); const int lane = tid & 63; (void)lane;
        const int U = c * 2 + ui; const int g = U >> 4, mb = U & 15;
        const int l31 = lane & 31, h = lane >> 5;
        LAS unsigned char* UT = F.lds;
        LAS unsigned char* KTl = F.lds + 65536;
        __syncthreads();
        {
            const unsigned char* usrc = (const unsigned char*)(UG + (size_t)(g * 16 + mb) * 64 * 512);
#pragma unroll
            for (int i = 0; i < 8; ++i) { const int idx = tid + 512 * i; *(LAS v4u*)(UT + idx * 16) = *(const v4u*)(usrc + (size_t)idx * 16); }
            const unsigned char* ksrc = (const unsigned char*)(KT + (size_t)g * KT_ROWS * 256);
            for (int idx = tid; idx < 2080; idx += 512) *(LAS v4u*)(KTl + idx * 16) = *(const v4u*)(ksrc + (size_t)idx * 16);
        }
        f32x16 ac[4];
#pragma unroll
        for (int j = 0; j < 4; ++j)
#pragma unroll
            for (int r = 0; r < 16; ++r) ac[j][r] = 0.f;
        {
            const bf16* xa = Xs + (size_t)(g * 16 + mb) * 8 * 512 + lane * 8;
            const bf16* t3 = T3 + (size_t)(g * 32) * 8 * 512 + lane * 8;
#pragma unroll
            for (int kh = 0; kh < 2; ++kh) {
                bf16x8 xa4[4], tb[4][4];
#pragma unroll
                for (int k2 = 0; k2 < 4; ++k2) { xa4[k2] = *(const bf16x8*)(xa + (kh * 4 + k2) * 512);
#pragma unroll
                    for (int j = 0; j < 4; ++j) { const int tp = (j == 0) ? 2 * wave : (j == 1) ? 2 * wave + 1 : (j == 2) ? 30 - 2 * wave : 31 - 2 * wave; tb[k2][j] = *(const bf16x8*)(t3 + ((size_t)tp * 8 + (kh * 4 + k2)) * 512); } }
#pragma unroll
                for (int k2 = 0; k2 < 4; ++k2)
#pragma unroll
                    for (int j = 0; j < 4; ++j) ac[j] = __builtin_amdgcn_mfma_f32_32x32x16_bf16(xa4[k2], tb[k2][j], ac[j], 0, 0, 0);
            }
        }
        __syncthreads();
        {
            const LAS unsigned char* ap = UT + lane * 16;
            const LAS unsigned char* kp = KTl + (l31 >> 4) * 512 + (l31 & 15) * 32 + 16 * h;
            const int tA0 = 2 * wave, tA1 = 30 - 2 * wave;
            bf16x8 pv0[2], pv1[2];
            pv0[0] = *(const LAS bf16x8*)(kp + (2 * tA0 + 3) * 512); pv0[1] = *(const LAS bf16x8*)(kp + (2 * tA0 + 2) * 512);
            pv1[0] = *(const LAS bf16x8*)(kp + (2 * tA1 + 3) * 512); pv1[1] = *(const LAS bf16x8*)(kp + (2 * tA1 + 2) * 512);
#pragma unroll 1
            for (int s0 = 0; s0 < 64; s0 += 2) {
#pragma unroll
                for (int par = 0; par < 2; ++par) {
                    const int s2 = s0 + par;
                    const bf16x8 a = *(const LAS bf16x8*)(ap + s2 * 1024);
                    if (s2 <= 2 * tA0 + 3) { ac[1] = __builtin_amdgcn_mfma_f32_32x32x16_bf16(a, pv0[par], ac[1], 0, 0, 0);
                        if (s2 <= 2 * tA0 + 1) { const bf16x8 f = *(const LAS bf16x8*)(kp + (2 * tA0 - s2 + 1) * 512); ac[0] = __builtin_amdgcn_mfma_f32_32x32x16_bf16(a, f, ac[0], 0, 0, 0); pv0[par] = f; } }
                    if (s2 <= 2 * tA1 + 3) { ac[3] = __builtin_amdgcn_mfma_f32_32x32x16_bf16(a, pv1[par], ac[3], 0, 0, 0);
                        if (s2 <= 2 * tA1 + 1) { const bf16x8 f = *(const LAS bf16x8*)(kp + (2 * tA1 - s2 + 1) * 512); ac[2] = __builtin_amdgcn_mfma_f32_32x32x16_bf16(a, f, ac[2], 0, 0, 0); pv1[par] = f; } }
                }
            }
        }
#pragma unroll
        for (int j = 0; j < 4; ++j) { const int tp = (j == 0) ? 2 * wave : (j == 1) ? 2 * wave + 1 : (j == 2) ? 30 - 2 * wave : 31 - 2 * wave; const int t = 2 * tp + (l31 >> 4);
#pragma unroll
            for (int r = 0; r < 16; ++r) { const int m = 32 * mb + (r & 3) + 8 * (r >> 2) + 4 * h;
                Yb[((size_t)m * 64 + t) * 512 + 16 * g + (l31 & 15)] = (bf16)(cvt_pk_bf16(gelu_tanh(ac[j][r]), 0.f) & 0xffffu); } }
    }

    xcd_barrier(bar);
    }
    for (int rep = 0; rep < REP_MIX; ++rep) {
    {
        GOrder S; S.so.init(M / 256, SW / 256, F.G, (int)blockIdx.x, WGM_GLU); S.A = (const char*)Yb; S.B = (const char*)GluT; S.ta = (size_t)256 * 512 * 2; S.tb = (size_t)256 * 512 * 2;
        EpiGlu E{Yb, SSMb, glu_b};
        pg8::gemm_phase<EpiGlu, GOrder, true>(F.lds + RING_OFF, 512, S, E);
    }
    xcd_barrier(bar);
    {
        MergeOrder S; S.so.init(M / 256, D / 256, F.G, (int)blockIdx.x, WGM_MRG); S.A = (const char*)Qb; S.B = (const char*)WpabT; S.ta = (size_t)256 * 512 * 2; S.tb = (size_t)256 * 512 * 2;
        EpiMerge E{SG, MRG};
        pg8::gemm_phase<EpiMerge, MergeOrder, true, false, true>(F.lds + RING_OFF, 512, S, E);
    }
    xcd_barrier(bar);
    {
        GOrder S; S.so.init(M / 256, D / 256, F.G, (int)blockIdx.x, WGM_WO); S.A = (const char*)MRG; S.B = (const char*)WoT; S.ta = (size_t)256 * 1024 * 2; S.tb = (size_t)256 * 1024 * 2;
        EpiOut E{x, H1B, H1B8, ssqp};
        pg8::gemm_phase<EpiOut, GOrder, true>(F.lds + RING_OFF, 1024, S, E);
    }
    xcd_barrier(bar);
    }
#endif

#if PH_MAX >= 3
    for (int rep = 0; rep < REP_RT; ++rep) {
    {
        int tid = threadIdx.x; asm volatile("" : "+v"(tid)); const int lane = tid & 63; (void)lane;
        LAS float* lg = (LAS float*)(F.lds);
        LAS int* cntl = (LAS int*)(F.lds + 2 * 128 * 65 * 4);
        LAS int* basel = cntl + 32; LAS int* eloc = basel + 32; LAS float* gloc = (LAS float*)(eloc + 256); LAS float* rloc = gloc + 256;
        if (tid < 32) cntl[tid] = 0;
        const int mt = wave & 3, kh = wave >> 2, l31 = lane & 31, h = lane >> 5;
        {
            const int row = 128 * c + 32 * mt + l31;
            f32x16 a0, a1;
#pragma unroll
            for (int r = 0; r < 16; ++r) { a0[r] = 0.f; a1[r] = 0.f; }
            const bf16* hp = H1B + (size_t)row * D + 512 * kh + 8 * h;
            const bf16* w0 = wr_t + (size_t)(32 * kh) * 512 + lane * 8;
#pragma unroll 8
            for (int ks = 0; ks < 32; ++ks) {
                const bf16x8 av = *(const bf16x8*)(hp + 16 * ks);
                const bf16x8 bh0 = *(const bf16x8*)(w0 + 512 * ks), bl0 = *(const bf16x8*)(w0 + 65536 + 512 * ks);
                const bf16x8 bh1 = *(const bf16x8*)(w0 + 32768 + 512 * ks), bl1 = *(const bf16x8*)(w0 + 32768 + 65536 + 512 * ks);
                a0 = __builtin_amdgcn_mfma_f32_32x32x16_bf16(av, bh0, a0, 0, 0, 0);
                a0 = __builtin_amdgcn_mfma_f32_32x32x16_bf16(av, bl0, a0, 0, 0, 0);
                a1 = __builtin_amdgcn_mfma_f32_32x32x16_bf16(av, bh1, a1, 0, 0, 0);
                a1 = __builtin_amdgcn_mfma_f32_32x32x16_bf16(av, bl1, a1, 0, 0, 0);
            }
#pragma unroll
            for (int r = 0; r < 16; ++r) { const int rr = 32 * mt + (r & 3) + 8 * (r >> 2) + 4 * h; lg[(kh * 128 + rr) * 65 + l31] = a0[r]; lg[(kh * 128 + rr) * 65 + 32 + l31] = a1[r]; }
        }
        __syncthreads();
        if (tid < 128) {
            const int row = 128 * c + tid; float ss = 0.f;
#pragma unroll
            for (int j = 0; j < 16; ++j) ss += ssqp[(size_t)row * 16 + j];
            const float rs = 1.0f / sqrtf(ss * (1.0f / D) + RMS_EPS); rstd2[row] = rs;
            const LAS float* l = lg + tid * 65; const LAS float* l2 = lg + (128 + tid) * 65;
            float gl[4]; int gi = 0; float gm;
#pragma unroll
            for (int j = 0; j < 4; ++j) gl[j] = rs * (l[j] + l2[j]) + rbias[j];
            gm = gl[0];
#pragma unroll
            for (int j = 1; j < 4; ++j) if (gl[j] > gm) { gm = gl[j]; gi = j; }
            float den = 0.f;
#pragma unroll
            for (int j = 0; j < 4; ++j) den += expf(gl[j] - gm);
            const float ptop = 1.0f / den;
            float v0 = -3.0e38f, v1 = -3.0e38f; int i0 = 0, i1 = 0;
            for (int j = 0; j < 8; ++j) { const float v = rs * (l[4 + gi * 8 + j] + l2[4 + gi * 8 + j]) + rbias[4 + gi * 8 + j];
                if (v > v0) { v1 = v0; i1 = i0; v0 = v; i0 = j; } else if (v > v1) { v1 = v; i1 = j; } }
            const float e1 = expf(v1 - v0); const float g0 = ptop / (1.0f + e1), g1 = ptop * e1 / (1.0f + e1);
            const int ea = gi * 8 + i0, eb = gi * 8 + i1;
            eloc[2 * tid] = ea; eloc[2 * tid + 1] = eb; gloc[2 * tid] = g0; gloc[2 * tid + 1] = g1; rloc[tid] = rs;
            atomicAdd((int*)(cntl + ea), 1); atomicAdd((int*)(cntl + eb), 1);
        }
        __syncthreads();
        if (tid < 32) basel[tid] = (int)__hip_atomic_fetch_add(etot + tid, (unsigned)cntl[tid], __ATOMIC_RELAXED, __HIP_MEMORY_SCOPE_AGENT);
        __syncthreads();
        if (tid < 256) {
            const int e = eloc[tid]; int rank = 0;
            for (int a = 0; a < tid; ++a) rank += (eloc[a] == e) ? 1 : 0;
            const int idx = e * CAPE + basel[e] + rank;
            inv_tok[idx] = 128 * c * 2 + tid; inv_gate[idx] = gloc[tid]; inv_rs[idx] = rloc[tid >> 1];
        }
    }
    xcd_barrier(bar);
    }
    for (int rep = 0; rep < REP_MOE; ++rep) {
    {
        LAS int* rowtok = (LAS int*)(F.lds + ROWTOK_OFF);
        { int tid = threadIdx.x; asm volatile("" : "+v"(tid));
          LAS int* tot = (LAS int*)(F.lds); LAS int* pst = tot + 32; LAS int* blke = pst + 40;
          if (tid < 32) tot[tid] = (int)etot[tid];
          __syncthreads();
          if (tid == 0) { int p = 0; for (int e = 0; e < 32; ++e) { pst[e] = p; p += ((tot[e] + 255) >> 8) << 8; } pst[32] = p; mymeta[0] = p >> 8; }
          __syncthreads();
          if (tid < 32) { for (int rb = pst[tid] >> 8; rb < (pst[tid + 1] >> 8); ++rb) { blke[rb] = tid; mymeta[16 + rb] = tid; } }
          __syncthreads();
          const int nrb = pst[32] >> 8; const int cb = (int)blockIdx.x;
          for (int idx = tid; idx < 5 * 256; idx += 512) { const int rb = (idx >> 8) * 64 + (cb & 7) * 8 + (cb >> 5); int tk = 0;
              if (rb < nrb) { const int e = blke[rb]; const int slot = rb * 256 + (idx & 255); const int rel = slot - pst[e]; const bool ok = rel < tot[e];
                  const int t2 = ok ? inv_tok[e * CAPE + rel] : -1; tk = ok ? (t2 >> 1) : 0;
                  sdst[slot] = t2; sgate[slot] = ok ? inv_gate[e * CAPE + rel] : 0.f; srs[slot] = ok ? inv_rs[e * CAPE + rel] : 0.f; }
              rowtok[idx] = tk; }
          asm volatile("s_waitcnt vmcnt(0)" ::: "memory");
          __syncthreads(); }
        MoeOrderG S; S.meta = mymeta; S.rowtok = rowtok; S.G = F.G; S.c = (int)blockIdx.x; S.A = (const char*)H1B8; S.B = (const char*)WupT; S.tb = (size_t)256 * 1024;
        EpiUp E{srs, HID};
        pg8::gemm_phase<EpiUp, MoeOrderG, true, true, false, true>(F.lds + RING_OFF, 512, S, E, 0x7f7a);
        if (rep == 0) {
            int tid = threadIdx.x; asm volatile("" : "+v"(tid)); const int lane = tid & 63;
            const int nrb = __builtin_amdgcn_readfirstlane(mymeta[0]); const int cb = (int)blockIdx.x;
            int T = nrb - 256; T = T < 0 ? 0 : (T > 32 ? 32 : T);
            const int r5 = (cb & 7) * 8 + (cb >> 5);
            if (r5 >= T) {
                const int nidle = (64 - T) * 4, me = (r5 - T) * 4 + ((cb >> 3) & 3);
                LAS float* scr = (LAS float*)(F.lds + wave * P0_SCR);
#pragma unroll 1
                for (int it = me + nidle * wave; it < I_E2; it += nidle * 8) {
                    const Tr64 t = expert_item(I_E1 + I_E3 + it, ew1, ew3, ew2, g_ffn, WupT, W2T);
                    f32x4 tv[16]; tr64_load(t, tv, lane); tr64_store(t, tv, scr, lane);
                }
            }
        }
    }
    xcd_barrier(bar);
    {
        MoeOrder S; S.meta = mymeta; S.G = F.G; S.c = (int)blockIdx.x; S.A = (const char*)HID; S.B = (const char*)W2T; S.ta = (size_t)256 * 512; S.tb = (size_t)256 * 512;
        EpiDown E{sdst, sgate, YB};
        pg8::gemm_phase<EpiDown, MoeOrder, true, false, false, true>(F.lds + RING_OFF, 256, S, E, 0x7d7b);
    }
    xcd_barrier(bar);
    }
#endif

#ifdef DBG_COPYSG
    for (int m = gw; m < M; m += NGW) { for (int j = 0; j < 16; ++j) HID[(size_t)m * 512 + ((lane + 64 * j) & 511)] = SG[(size_t)m * 2048 + DBG_COL0 + ((lane + 64 * j) & 511)]; }
    xcd_barrier(bar);
#endif
#ifdef DBG_BUF
    {
        for (int m = gw; m < M; m += NGW) {
            const bf16* src = DBG_BUF; const size_t ld = DBG_LD;
            float v[16];
#pragma unroll
            for (int j = 0; j < 16; ++j) v[j] = DBG_SCALE * bf2f(src[(size_t)(m % DBG_ROWS) * ld + ((lane + 64 * j) % ld)]);
            asm volatile("" ::: "memory");
#pragma unroll
            for (int j = 0; j < 16; ++j) out[(size_t)m * D + lane + 64 * j] = v[j];
        }
    }
#else
    for (int rep = 0; rep < REP_FIN; ++rep) {
        int tid = threadIdx.x; asm volatile("" : "+v"(tid)); const int lane = tid & 63; (void)lane;
        for (int m = gw; m < M; m += NGW) {
            f32x4 v[4]; float s = 0.f;
            { const v2u* hr = (const v2u*)(H1B + (size_t)m * D) + lane;
#pragma unroll
              for (int j = 0; j < 4; ++j) { const v2u a = hr[64 * j]; v[j][0] = bflo(a.x); v[j][1] = bfhi(a.x); v[j][2] = bflo(a.y); v[j][3] = bfhi(a.y); } }
#if PH_MAX >= 3
            const unsigned* y0 = (const unsigned*)(YB + (size_t)(2 * m) * D) + lane; const unsigned* y1 = (const unsigned*)(YB + (size_t)(2 * m + 1) * D) + lane;
#pragma unroll
            for (int j = 0; j < 4; ++j) { const int a = (int)y0[64 * j], b = (int)y1[64 * j];
                v[j][0] += (__builtin_amdgcn_cvt_f32_fp8(a, 0) + __builtin_amdgcn_cvt_f32_fp8(b, 0)) * 0.0625f; v[j][1] += (__builtin_amdgcn_cvt_f32_fp8(a, 1) + __builtin_amdgcn_cvt_f32_fp8(b, 1)) * 0.0625f;
                v[j][2] += (__builtin_amdgcn_cvt_f32_fp8(a, 2) + __builtin_amdgcn_cvt_f32_fp8(b, 2)) * 0.0625f; v[j][3] += (__builtin_amdgcn_cvt_f32_fp8(a, 3) + __builtin_amdgcn_cvt_f32_fp8(b, 3)) * 0.0625f; }
#endif
#pragma unroll
            for (int j = 0; j < 4; ++j) s += (v[j][0] * v[j][0] + v[j][1] * v[j][1]) + (v[j][2] * v[j][2] + v[j][3] * v[j][3]);
            const float rs = 1.0f / sqrtf(wave_sum(s, lane) * (1.0f / D) + RMS_EPS);
            f32x4* o = (f32x4*)(out + (size_t)m * D) + lane;
#pragma unroll
            for (int j = 0; j < 4; ++j) { const f32x4 g = *((const f32x4*)g_fin + lane + 64 * j); __builtin_nontemporal_store(v[j] * rs * g, &o[64 * j]); }
        }
    }
#endif
}

extern "C" void kernel_launch(void* const* d_in, const int* in_sizes, int n_in, void* d_out, int out_size, void* d_ws, size_t ws_size, hipStream_t stream) {
    static int grid = 0;
    if (grid == 0) {
        if (n_in != 26 || out_size != M * D || ws_size < WS_END) { fprintf(stderr, "kernel_launch: unexpected sizes n_in %d out %d ws %zu\n", n_in, out_size, ws_size); grid = -1; return; }
        int dev = 0, cus = 0, per_cu = 0;
        if (hipGetDevice(&dev) != hipSuccess || hipDeviceGetAttribute(&cus, hipDeviceAttributeMultiprocessorCount, dev) != hipSuccess) { grid = -1; return; }
        if (hipFuncSetAttribute((const void*)fwd_kernel, hipFuncAttributeMaxDynamicSharedMemorySize, LDS_BYTES) != hipSuccess) { fprintf(stderr, "kernel_launch: hipFuncSetAttribute failed\n"); grid = -1; return; }
        if (hipOccupancyMaxActiveBlocksPerMultiprocessor(&per_cu, (const void*)fwd_kernel, NWAVES * 64, LDS_BYTES) != hipSuccess || per_cu < 1)
            fprintf(stderr, "kernel_launch: occupancy query reports %d\n", per_cu);
        (void)hipGetLastError();
        grid = cus;
        if (grid != 256) fprintf(stderr, "kernel_launch: %d CUs (built for 256)\n", grid);
    }
    if (grid < 0) return;
    if (hipMemsetAsync((char*)d_ws + WS_CTL, 0, CTL_ZERO_BYTES, stream) != hipSuccess) return;
    Args a{};
    for (int i = 0; i < 26; ++i) a.in[i] = (const float*)d_in[i];
    a.out = (float*)d_out; a.ws = (unsigned char*)d_ws;
    hipLaunchKernelGGL(fwd_kernel, dim3(grid), dim3(NWAVES * 64), LDS_BYTES, stream, a);
}
```

```cpp
#include <hip/hip_runtime.h>
#include <cstdio>
#include <cstdint>

#ifndef REP_P0
#define REP_P0 1
#endif
#ifndef WGM_P1
#define WGM_P1 2
#endif
#ifndef WGM_GLU
#define WGM_GLU 4
#endif
#ifndef WGM_MRG
#define WGM_MRG 4
#endif
#ifndef WGM_WO
#define WGM_WO 4
#endif
#ifndef REP_P0S
#define REP_P0S 1
#endif
#ifndef REP_P1
#define REP_P1 1
#endif
#ifndef REP_SSM
#define REP_SSM 1
#endif
#ifndef REP_ATT
#define REP_ATT 1
#endif
#ifndef REP_MIX
#define REP_MIX 1
#endif
#ifndef REP_RT
#define REP_RT 1
#endif
#ifndef REP_MOE
#define REP_MOE 1
#endif
#ifndef REP_FIN
#define REP_FIN 1
#endif
#ifndef PH_MAX
#define PH_MAX 3
#endif

#define GAS __attribute__((address_space(1)))
#define LAS __attribute__((address_space(3)))
typedef unsigned short bf16;
typedef unsigned v4u __attribute__((ext_vector_type(4)));
typedef unsigned v2u __attribute__((ext_vector_type(2)));
typedef float f32x2 __attribute__((ext_vector_type(2)));
typedef float f32x4 __attribute__((ext_vector_type(4)));
typedef float f32x16 __attribute__((ext_vector_type(16)));
typedef short bf16x8 __attribute__((ext_vector_type(8)));
typedef GAS unsigned gu32;

constexpr int D = 1024, NB = 4, SEQ = 8192, M = NB * SEQ, NMETA = 16;
constexpr int ATW = 512, NH = 8, HD = 64, SW = 512, NG = 32, GC = 16, NP = 64, INC = 4096;
constexpr int NE = 32, FF = 512;
constexpr int LPB = 8224;
constexpr int KT_ROWS = 66;
constexpr int MAXRB = 288;
constexpr float RMS_EPS = 1e-6f;
constexpr float QSCALE = 0.125f * 1.4426950408889634f;

constexpr size_t MiB = 1u << 20;
constexpr size_t WS_CTL = 0, CTL_ZERO_BYTES = 1 * MiB;
constexpr size_t WS_SMALL = 1 * MiB;
constexpr size_t SM_RSTD1 = WS_SMALL;
constexpr size_t SM_RSTD2 = SM_RSTD1 + 128 * 1024;
constexpr size_t SM_EID = SM_RSTD2 + 128 * 1024;
constexpr size_t SM_GATE = SM_EID + 256 * 1024;
constexpr size_t SM_CNT = SM_GATE + 256 * 1024;
constexpr size_t SM_UMETA = SM_CNT + 32 * 1024;
constexpr size_t SM_BBAR = SM_UMETA + 32 * 1024;
constexpr size_t SM_LBAR = SM_BBAR + 256 * 1024;
constexpr size_t SM_L64 = SM_LBAR + 16 * 1024;
constexpr size_t SM_SDST = SM_L64 + 16 * 1024;
constexpr size_t SM_SGATE = SM_SDST + 288 * 1024;
constexpr size_t SM_SRS = SM_SGATE + 288 * 1024;
constexpr size_t SM_WR = SM_SRS + 288 * 1024;
constexpr size_t SM_RB = SM_WR + 256 * 1024;
constexpr size_t SM_MOEMETA = SM_RB + 1024;
constexpr size_t SM_METAP = SM_MOEMETA + 4096;
constexpr size_t SM_SSQP = 4 * MiB;
static_assert(SM_METAP + 8 * 16 * 1536 * 4 <= SM_SSQP, "small map");
constexpr size_t WS_WIN = 6 * MiB;
constexpr size_t WS_WPAB = 14 * MiB;
constexpr size_t WS_WO = 16 * MiB;
constexpr size_t WS_GLU = 18 * MiB;
constexpr size_t WS_KT = 19 * MiB;
constexpr size_t WS_T2 = 21 * MiB;
constexpr size_t WS_T3 = 29 * MiB;
constexpr size_t WS_WUP = 37 * MiB;
constexpr size_t WS_W2 = 101 * MiB;
constexpr size_t WS_XB = 133 * MiB;
constexpr size_t WS_Y = 133 * MiB;
constexpr size_t WS_S = 165 * MiB;
constexpr size_t WS_XS = 173 * MiB;
constexpr size_t WS_Q = 197 * MiB;
constexpr size_t WS_SSM = 229 * MiB;
constexpr size_t WS_K = 261 * MiB;
constexpr size_t WS_VT = 295 * MiB;
constexpr size_t WS_UG = 329 * MiB;
constexpr size_t WS_SG = 361 * MiB;
constexpr size_t WS_H1B = 361 * MiB;
constexpr size_t WS_H1B8 = 425 * MiB;
constexpr size_t WS_HID = 277 * MiB;
constexpr size_t WS_YB = 133 * MiB;
constexpr size_t WS_INV = 489 * MiB;
constexpr size_t WS_MWG = 502 * MiB;
constexpr size_t WS_END = 503 * MiB;
constexpr int CAPE = 32768;
constexpr int CW_TOT = 8192;

constexpr int CW_BAR = 4096;

constexpr int RING_OFF = 0, RING_BYTES = 131072;
constexpr int P0_SCR = 16896;
constexpr int LDSCTL_OFF = 8 * P0_SCR, MISC_OFF = LDSCTL_OFF + 320;
static_assert(LDSCTL_OFF >= RING_BYTES, "lds map");
constexpr int LDS_BYTES = 147456;
constexpr int ROWTOK_OFF = 8 * 16896 + 512;
static_assert(ROWTOK_OFF + 5 * 256 * 4 <= LDS_BYTES, "lds map");
constexpr int NWAVES = 8;

#define LDS_WAIT() asm volatile("s_waitcnt lgkmcnt(0)" ::: "memory")
#define VM_WAIT() asm volatile("s_waitcnt vmcnt(0)" ::: "memory")

typedef __bf16 bf16x2_t __attribute__((ext_vector_type(2)));
__device__ __forceinline__ unsigned cvt_pk_bf16(float lo, float hi) { bf16x2_t v; v[0] = (__bf16)lo; v[1] = (__bf16)hi; return __builtin_bit_cast(unsigned, v); }
__device__ __forceinline__ float bf2f(unsigned short b) { return __builtin_bit_cast(float, (unsigned)b << 16); }
__device__ __forceinline__ float bflo(unsigned w) { return __builtin_bit_cast(float, w << 16); }
__device__ __forceinline__ float bfhi(unsigned w) { return __builtin_bit_cast(float, w & 0xffff0000u); }
__device__ __forceinline__ float fast_sigmoid(float x) { return __builtin_amdgcn_rcpf(1.0f + __expf(-x)); }
__device__ __forceinline__ float shx(float v, int k, int lane) { return __builtin_bit_cast(float, __builtin_amdgcn_ds_bpermute((lane ^ k) << 2, __builtin_bit_cast(int, v))); }
__device__ __forceinline__ float wave_sum(float v, int lane) {
#pragma unroll
    for (int o = 1; o < 64; o <<= 1) v += shx(v, o, lane);
    return v;
}

#define XB_TMO      128
#define XB_XCNT(j)  (256  + 64 * (j))
#define XB_XSUB(j)  (1280 + 64 * (j))
#define XB_XGEN(j)  (2304 + 64 * (j))
#define XB_TOP      3328
#define XB_TOPGEN   3392
#define XCD_BAR_WORDS 3456
#define XB_SPIN_CAP (1u << 18)
__device__ __forceinline__ unsigned xb_ld(unsigned* p)              { return __hip_atomic_load(p, __ATOMIC_RELAXED, __HIP_MEMORY_SCOPE_AGENT); }
__device__ __forceinline__ unsigned xb_add(unsigned* p, unsigned v) { return __hip_atomic_fetch_add(p, v, __ATOMIC_RELAXED, __HIP_MEMORY_SCOPE_AGENT); }
__device__ __forceinline__ unsigned xb_xcc_id() { return (unsigned)__builtin_amdgcn_s_getreg((3 << 11) | 20) & 0xFu; }
#define XB_SPIN(cond, bar) do { unsigned _sp = 0; while (cond) { __builtin_amdgcn_s_sleep(1); \
    if ((++_sp & 255u) == 0u) { if (xb_ld(&(bar)[XB_TMO])) break; if (_sp > XB_SPIN_CAP) { atomicAdd(&(bar)[XB_TMO], 1u); break; } } } } while (0)
struct XcdBarrier { unsigned* bar; unsigned x; volatile LAS unsigned* st; };
__device__ __forceinline__ XcdBarrier xcd_barrier_post(unsigned* bar, volatile LAS unsigned* st) {
    XcdBarrier b; b.bar = bar; b.x = (unsigned)__builtin_amdgcn_readfirstlane((int)xb_xcc_id()); b.st = st;
    if (threadIdx.x == 0) (void)xb_add(&bar[XB_XCNT(b.x)], 1u);
    return b;
}
__device__ __forceinline__ void xcd_barrier_complete(unsigned* bar, unsigned x, unsigned& nloc, unsigned& nx) {
    const unsigned G = gridDim.x * gridDim.y * gridDim.z;
    unsigned sum, cnt, mine, sp = 0u;
    for (;;) {
        sum = 0u; cnt = 0u; mine = 0u;
#pragma unroll
        for (unsigned j = 0; j < 16; ++j) { const unsigned c = xb_ld(&bar[XB_XCNT(j)]); sum += c; cnt += (c > 0u) ? 1u : 0u; mine = (j == x) ? c : mine; }
        if (sum == G) break;
        __builtin_amdgcn_s_sleep(1);
        if ((++sp & 255u) == 0u) { if (xb_ld(&bar[XB_TMO])) break; if (sp > XB_SPIN_CAP) { atomicAdd(&bar[XB_TMO], 1u); break; } }
    }
    nloc = mine > 0u ? mine : 1u; nx = cnt > 0u ? cnt : 1u;
}
__device__ __forceinline__ void xcd_barrier(const XcdBarrier& b) {
    asm volatile("s_waitcnt vmcnt(0)" ::: "memory");
    __syncthreads();
    if (threadIdx.x == 0) {
        unsigned* bar = b.bar; asm volatile("" : "+s"(bar));
        __builtin_amdgcn_s_waitcnt(0);
        unsigned bx = b.x; asm volatile("" : "+s"(bx));
        const unsigned osub = (unsigned)__builtin_amdgcn_readfirstlane((int)XB_XSUB(bx)), ogen = (unsigned)__builtin_amdgcn_readfirstlane((int)XB_XGEN(bx));
        unsigned nloc = b.st[0], nx = b.st[1];
        if (nloc == 0u) { xcd_barrier_complete(bar, bx, nloc, nx); b.st[0] = nloc; b.st[1] = nx; }
        const unsigned old = xb_add(&bar[osub], 1u);
        const unsigned gen = old / nloc;
        if (old + 1u == (gen + 1u) * nloc) {
            __builtin_amdgcn_fence(__ATOMIC_RELEASE, "agent");
            asm volatile("s_waitcnt vmcnt(0)" ::: "memory");
            const unsigned og = xb_add(&bar[XB_TOP], 1u);
            const unsigned tg = og / nx;
            if (og + 1u == (tg + 1u) * nx) xb_add(&bar[XB_TOPGEN], 1u);
            else XB_SPIN(xb_ld(&bar[XB_TOPGEN]) == tg, bar);
            __builtin_amdgcn_fence(__ATOMIC_ACQUIRE, "agent");
            xb_add(&bar[ogen], 1u);
            asm volatile("s_waitcnt vmcnt(0)" ::: "memory");
        } else {
            XB_SPIN(xb_ld(&bar[ogen]) == gen, bar);
            __builtin_amdgcn_fence(__ATOMIC_ACQUIRE, "agent");
            asm volatile("s_waitcnt vmcnt(0)" ::: "memory");
        }
    }
    __syncthreads();
}

namespace pg8 {
typedef int pg8_v4i __attribute__((ext_vector_type(4)));
typedef int pg8_v8i __attribute__((ext_vector_type(8)));
constexpr int BM = 256, BK = 64, HALF = 128, HTB = HALF * BK * 2, STAGE_BYTES = 8 * HTB, NXCD = 8, WGM = 4;
__host__ __device__ __forceinline__ int lds_byte(int r, int c) { const int st = (r >> 4) * 2 + (c >> 5), rr = r & 15, cc = c & 31, ob = rr * 64 + cc * 2; return st * 1024 + (ob ^ (((ob >> 9) & 1) << 5)); }
__host__ __device__ __forceinline__ void stage_rc(int b, int& R, int& C) { const int st = b / 1024, sb = b % 1024, swz = sb ^ (((sb >> 9) & 1) << 5); R = (st >> 1) * 16 + swz / 64; C = (st & 1) * 32 + (swz % 64) / 2; }
__host__ __device__ __forceinline__ int perm32(int rho) { const int n = rho >> 4, i = rho & 15; return 8 * (i >> 2) + 4 * n + (i & 3); }
struct Unit { int pm, pn; };
struct StaticOrder {
    int nM, nN, nwg, G, c, wgm;
    __host__ __device__ void init(int nM_, int nN_, int G_, int c_, int wgm_ = WGM) { nM = nM_; nN = nN_; nwg = nM * nN; G = G_; c = c_; wgm = wgm_; }
    __host__ __device__ bool next(int i, Unit& u) const {
        const long L = (long)i * G + c; if (L >= nwg) return false;
        int wgid = (int)L; { const int q = nwg / NXCD, r = nwg % NXCD, xcd = wgid % NXCD, off = wgid / NXCD; wgid = (xcd < r ? xcd * (q + 1) : r * (q + 1) + (xcd - r) * q) + off; }
        const int nig = wgm * nN, gid = wgid / nig, fm = gid * wgm, gsz = (nM - fm) < wgm ? (nM - fm) : wgm;
        u.pm = fm + ((wgid % nig) % gsz); u.pn = (wgid % nig) / gsz; return true;
    }
};
template <class Epi, class Sched, bool ALIGN_EPI, bool GATHER = false, bool KS = false, bool F8 = false>
__device__ __forceinline__ void gemm_phase(LAS unsigned char* lds, const int K, const Sched& S, const Epi& E, const int sc_wa = 0x7f7f) {
    int tid = threadIdx.x; asm volatile("" : "+v"(tid));
    const int wid = __builtin_amdgcn_readfirstlane(tid >> 6), lane = tid & 63, wr = wid >> 2, wc = wid & 3, fr = lane & 15, fq = lane >> 4;
    const int nt = KS ? 16 : K / BK;
    unsigned voffA[2], voffB[2]; int Rr[2], Cc[2];
#pragma unroll
    for (int i = 0; i < 2; ++i) { int R, C; stage_rc(tid * 16 + i * 8192, R, C); const int Rb = Epi::PERM ? ((R & ~31) + perm32(R & 31)) : R; Rr[i] = R; Cc[i] = C;
        voffA[i] = (unsigned)(R * K + C) * 2u; voffB[i] = (unsigned)(Rb * K + C) * 2u; }
    unsigned gA[2][2], gAn[2][2];
#pragma unroll
    for (int h2 = 0; h2 < 2; ++h2) { gA[h2][0] = gA[h2][1] = gAn[h2][0] = gAn[h2][1] = 0u; }
    const size_t kstep = (size_t)(BK * 2);
    const size_t hstep = (size_t)HALF * K * 2;
    const unsigned ldsw = (unsigned)wid * 1024u;
    const int aoff = lds_byte(wr * 64 + fr, fq * 8), boff = lds_byte(wc * 32 + fr, fq * 8);
#define PG8_SA(b, h) (((b) * 2 + (h)) * HTB)
#define PG8_SB(b, h) ((4 + (b) * 2 + (h)) * HTB)
#define PG8_STAGE(bufoff, gbase, voff) do { _Pragma("unroll") for (int _i = 0; _i < 2; ++_i) \
        __builtin_amdgcn_global_load_lds((const unsigned*)((const char*)(gbase) + (voff)[_i]), (LAS unsigned*)(lds + (bufoff) + ldsw + _i * 8192), 16, 0, 0); } while (0)
#define PG8_LD8(dst8, addr) do { const pg8_v4i lo_ = *(const LAS pg8_v4i*)(addr), hi_ = *(const LAS pg8_v4i*)((addr) + 1024); dst8 = __builtin_shufflevector(lo_, hi_, 0, 1, 2, 3, 4, 5, 6, 7); } while (0)
#define PG8_LDA(dst, b, h) do { if constexpr (F8) { _Pragma("unroll") for (int m = 0; m < 4; ++m) PG8_LD8(dst##8[m], lds + PG8_SA(b, h) + aoff + m * 2048); } \
        else { _Pragma("unroll") for (int m = 0; m < 4; ++m) _Pragma("unroll") for (int k = 0; k < 2; ++k) dst[m][k] = *(const LAS bf16x8*)(lds + PG8_SA(b, h) + aoff + m * 2048 + k * 1024); } } while (0)
#define PG8_LDB(dst, b, h) do { if constexpr (F8) { _Pragma("unroll") for (int n = 0; n < 2; ++n) PG8_LD8(dst##8[n], lds + PG8_SB(b, h) + boff + n * 2048); } \
        else { _Pragma("unroll") for (int n = 0; n < 2; ++n) _Pragma("unroll") for (int k = 0; k < 2; ++k) dst[n][k] = *(const LAS bf16x8*)(lds + PG8_SB(b, h) + boff + n * 2048 + k * 1024); } } while (0)
#define PG8_MMA(ai, bj, At, Bt) do { __builtin_amdgcn_s_setprio(1); _Pragma("unroll") for (int m = 0; m < 4; ++m) _Pragma("unroll") for (int n = 0; n < 2; ++n) { \
        if constexpr (F8) { acc[ai][bj][m][n] = __builtin_amdgcn_mfma_scale_f32_16x16x128_f8f6f4(Bt##8[n], At##8[m], acc[ai][bj][m][n], 0, 0, 0, sc_wa, 1, sc_wa); } \
        else { _Pragma("unroll") for (int k = 0; k < 2; ++k) acc[ai][bj][m][n] = __builtin_amdgcn_mfma_f32_16x16x32_bf16(Bt[n][k], At[m][k], acc[ai][bj][m][n], 0, 0, 0); } } \
        if constexpr (F8) asm volatile("" : "+v"(acc[ai][bj][0][0]), "+v"(acc[ai][bj][0][1]), "+v"(acc[ai][bj][1][0]), "+v"(acc[ai][bj][1][1]), "+v"(acc[ai][bj][2][0]), "+v"(acc[ai][bj][2][1]), "+v"(acc[ai][bj][3][0]), "+v"(acc[ai][bj][3][1]));   \
        __builtin_amdgcn_s_setprio(0); } while (0)
#define PG8_WAIT_V(n) asm volatile("s_waitcnt vmcnt(" #n ")" ::: "memory")
#define PG8_WAIT_L(n) asm volatile("s_waitcnt lgkmcnt(" #n ")" ::: "memory")
#define PG8_BAR __builtin_amdgcn_s_barrier()
#define PG8_SCHED __builtin_amdgcn_sched_barrier(0)
    Unit cur, nxt; int ui = 0;
    if (!S.next(0, cur)) return;
    f32x4 acc[2][2][4][2];
#pragma unroll
    for (int a = 0; a < 2; ++a)
#pragma unroll
        for (int b = 0; b < 2; ++b)
#pragma unroll
            for (int m = 0; m < 4; ++m)
#pragma unroll
                for (int n = 0; n < 2; ++n) acc[a][b][m][n] = (f32x4){0.f, 0.f, 0.f, 0.f};
    if constexpr (F8) {
#pragma unroll
        for (int a = 0; a < 2; ++a)
#pragma unroll
            for (int b = 0; b < 2; ++b)
#pragma unroll
                for (int m = 0; m < 4; ++m)
#pragma unroll
                    for (int n = 0; n < 2; ++n) asm volatile("" : "+v"(acc[a][b][m][n]));
    }
    bf16x8 At[4][2], B0[2][2], B1[2][2];
    pg8_v8i At8[4], B08[2], B18[2];
    const char* cA = S.aptr(cur); const char* cB = S.bptr(cur);
    if constexpr (GATHER) { S.gather(cur, Rr, Cc, K, gA); }
#define PG8_STAGE_A(bufoff, h, ko, usenext) PG8_STAGE_A2(bufoff, h, cA, ko, usenext)
#define PG8_STAGE_A2(bufoff, h, cur_base, ko, usenext) do { if constexpr (GATHER) { unsigned _v[2] = { (usenext) ? gAn[h][0] : gA[h][0], (usenext) ? gAn[h][1] : gA[h][1] }; PG8_STAGE(bufoff, cA + (ko), _v); } \
        else { PG8_STAGE(bufoff, ((usenext) ? nA : (cur_base)) + (size_t)(h) * hstep + (ko), voffA); } } while (0)
    { const char* nA = cA; (void)nA;
    PG8_STAGE(PG8_SB(0, 0), cB, voffB); PG8_STAGE(PG8_SB(0, 1), cB + hstep, voffB); PG8_STAGE_A(PG8_SA(0, 0), 0, 0, false); PG8_STAGE_A(PG8_SA(0, 1), 1, 0, false);
    if (wr == 1) PG8_BAR;
    PG8_WAIT_V(2); PG8_BAR;
    PG8_STAGE(PG8_SB(1, 0), cB + kstep, voffB); PG8_STAGE_A(PG8_SA(1, 0), 0, kstep, false); PG8_STAGE(PG8_SB(1, 1), cB + hstep + kstep, voffB);
    PG8_WAIT_V(6); PG8_BAR; }
    for (;;) {
        { int tid2 = threadIdx.x; asm volatile("" : "+v"(tid2));
#pragma unroll
          for (int i = 0; i < 2; ++i) { int R, C; stage_rc(tid2 * 16 + i * 8192, R, C); const int Rb = Epi::PERM ? ((R & ~31) + perm32(R & 31)) : R;
              voffA[i] = (unsigned)(R * K + C) * 2u; voffB[i] = (unsigned)(Rb * K + C) * 2u; } }
        const bool has_next = S.next(ui + 1, nxt);
        const char* nA = has_next ? S.aptr(nxt) : cA; const char* nB = has_next ? S.bptr(nxt) : cB;
        const char* dA = cA; const char* dB = cB; if constexpr (KS) { dA = S.aptr2(cur); dB = S.bptr2(cur); }
        if constexpr (GATHER) { if (has_next) S.gather(nxt, Rr, Cc, K, gAn); else {
#pragma unroll
            for (int h2 = 0; h2 < 2; ++h2) { gAn[h2][0] = gA[h2][0]; gAn[h2][1] = gA[h2][1]; } } }
#pragma unroll 1
        for (int t = 0; t < nt; t += 2) {
            const bool last = (t == nt - 2);
            const char* pa1 = (KS && t >= 8) ? dA : cA; const char* pa2 = (KS && t >= 6) ? dA : cA; const char* pb2 = (KS && t >= 6) ? dB : cB;
            const size_t ko1 = KS ? (size_t)((t + 1) & 7) * kstep : (size_t)(t + 1) * kstep;
            const size_t ko2 = last ? (size_t)0 : (KS ? (size_t)((t + 2) & 7) * kstep : (size_t)(t + 2) * kstep), ko3 = ko2 + kstep;
            const char* b2 = last ? nB : pb2 + ko2; const char* b3 = b2 + kstep;
            PG8_LDB(B0, 0, 0); PG8_LDB(B1, 0, 1); PG8_SCHED; PG8_LDA(At, 0, 0); PG8_STAGE_A2(PG8_SA(1, 1), 1, pa1, ko1, false);
            PG8_WAIT_V(8); PG8_WAIT_L(0); PG8_BAR; PG8_MMA(0, 0, At, B0); PG8_MMA(0, 1, At, B1); PG8_BAR; PG8_SCHED;
            PG8_LDA(At, 0, 1); PG8_STAGE(PG8_SB(0, 0), b2, voffB); PG8_STAGE(PG8_SB(0, 1), b2 + hstep, voffB); PG8_STAGE_A2(PG8_SA(0, 0), 0, pa2, ko2, last);
            PG8_WAIT_V(8); PG8_WAIT_L(0); PG8_BAR; PG8_MMA(1, 0, At, B0); PG8_MMA(1, 1, At, B1); PG8_BAR; PG8_SCHED;
            PG8_LDB(B0, 1, 0); PG8_LDB(B1, 1, 1); PG8_SCHED; PG8_LDA(At, 1, 0); PG8_STAGE_A2(PG8_SA(0, 1), 1, pa2, ko2, last);
            PG8_WAIT_V(8); PG8_WAIT_L(0); PG8_BAR; PG8_MMA(0, 0, At, B0); PG8_MMA(0, 1, At, B1); PG8_BAR; PG8_SCHED;
            PG8_LDA(At, 1, 1); PG8_STAGE(PG8_SB(1, 0), b3, voffB); PG8_STAGE(PG8_SB(1, 1), b3 + hstep, voffB); PG8_STAGE_A2(PG8_SA(1, 0), 0, pa2, ko3, last);
            PG8_WAIT_V(8); PG8_WAIT_L(0); PG8_BAR; PG8_MMA(1, 0, At, B0); PG8_MMA(1, 1, At, B1); PG8_BAR; PG8_SCHED;
            if constexpr (KS) { if (t == 6) { int efr = fr, efq = fq; asm volatile("" : "+v"(efr), "+v"(efq)); E.mid(acc, cur, wr, wc, efr, efq); } }
        }
        if constexpr (ALIGN_EPI) { if (wr == 0) PG8_BAR; }
        { int efr = fr, efq = fq; asm volatile("" : "+v"(efr), "+v"(efq));
          E(acc, cur, wr, wc, efr, efq); }
        if (!has_next) break;
#pragma unroll
        for (int a = 0; a < 2; ++a)
#pragma unroll
            for (int b = 0; b < 2; ++b)
#pragma unroll
                for (int m = 0; m < 4; ++m)
#pragma unroll
                    for (int n = 0; n < 2; ++n) { acc[a][b][m][n] = (f32x4){0.f, 0.f, 0.f, 0.f}; if constexpr (F8) asm volatile("" : "+v"(acc[a][b][m][n])); }
        cur = nxt; cA = nA; cB = nB; ++ui;
        if constexpr (GATHER) {
#pragma unroll
            for (int h2 = 0; h2 < 2; ++h2) { gA[h2][0] = gAn[h2][0]; gA[h2][1] = gAn[h2][1]; } }
        if constexpr (ALIGN_EPI) { if (wr == 1) PG8_BAR; }
    }
    PG8_WAIT_V(0);
    if constexpr (!ALIGN_EPI) { if (wr == 0) PG8_BAR; }
    PG8_BAR;
#undef PG8_SA
#undef PG8_SB
#undef PG8_STAGE
#undef PG8_STAGE_A
#undef PG8_STAGE_A2
#undef PG8_LDA
#undef PG8_LD8
#undef PG8_LDB
#undef PG8_MMA
#undef PG8_WAIT_V
#undef PG8_WAIT_L
#undef PG8_BAR
#undef PG8_SCHED
}
}
using pg8::Unit;

struct Args { const float* in[26]; float* out; unsigned char* ws; };
struct Frame {
    LAS unsigned char* lds;
    volatile LAS unsigned* MISC;
    int tid, lane, wave, vcu, G;
};

struct GOrder {
    pg8::StaticOrder so; const char* A; const char* B; size_t ta, tb;
    __device__ __forceinline__ bool next(int i, Unit& u) const { return so.next(i, u); }
    __device__ __forceinline__ const char* aptr(const Unit& u) const { return A + (size_t)u.pm * ta; }
    __device__ __forceinline__ const char* bptr(const Unit& u) const { return B + (size_t)u.pn * tb; }
};
struct P1Order {
    pg8::StaticOrder so; const char* X; const char* W; size_t t;
    __device__ __forceinline__ bool next(int i, Unit& u) const { return so.next(i, u); }
    __device__ __forceinline__ const char* aptr(const Unit& u) const { return (u.pn == 4 || u.pn == 5) ? W + (size_t)u.pn * t : X + (size_t)u.pm * t; }
    __device__ __forceinline__ const char* bptr(const Unit& u) const { return (u.pn == 4 || u.pn == 5) ? X + (size_t)u.pm * t : W + (size_t)u.pn * t; }
};
struct MergeOrder {
    pg8::StaticOrder so; const char* A; const char* B; size_t ta, tb;
    __device__ __forceinline__ bool next(int i, Unit& u) const { return so.next(i, u); }
    __device__ __forceinline__ const char* aptr(const Unit& u) const { return A + (size_t)u.pm * ta; }
    __device__ __forceinline__ const char* aptr2(const Unit& u) const { return A + (size_t)(u.pm + 128) * ta; }
    __device__ __forceinline__ const char* bptr(const Unit& u) const { return B + (size_t)u.pn * tb; }
    __device__ __forceinline__ const char* bptr2(const Unit& u) const { return B + (size_t)(u.pn + 4) * tb; }
};
struct MoeOrder {
    const int* meta; int G, c; const char* A; const char* B; size_t ta, tb;
    __device__ __forceinline__ bool next(int i, Unit& u) const {
        const int nrb = __builtin_amdgcn_readfirstlane(meta[0]);
        const int rb = i * 64 + (c & 7) * 8 + (c >> 5);
        if (rb >= nrb) return false;
        const int e = __builtin_amdgcn_readfirstlane(meta[16 + rb]);
        u.pm = rb; u.pn = e * 4 + ((c >> 3) & 3); return true;
    }
    __device__ __forceinline__ const char* aptr(const Unit& u) const { return A + (size_t)u.pm * ta; }
    __device__ __forceinline__ const char* bptr(const Unit& u) const { return B + (size_t)u.pn * tb; }
};

struct MoeOrderG {
    const int* meta; const LAS int* rowtok; int G, c; const char* A; const char* B; size_t tb;
    __device__ __forceinline__ bool next(int i, Unit& u) const {
        const int nrb = __builtin_amdgcn_readfirstlane(meta[0]);
        const int rb = i * 64 + (c & 7) * 8 + (c >> 5);
        if (rb >= nrb) return false;
        const int e = __builtin_amdgcn_readfirstlane(meta[16 + rb]);
        u.pm = rb; u.pn = e * 4 + ((c >> 3) & 3); return true;
    }
    __device__ __forceinline__ const char* aptr(const Unit&) const { return A; }
    __device__ __forceinline__ const char* bptr(const Unit& u) const { return B + (size_t)u.pn * tb; }
    __device__ __forceinline__ void gather(const Unit& u, const int (&Rr)[2], const int (&Cc)[2], int K, unsigned (&v)[2][2]) const {
        const LAS int* t = rowtok + (u.pm >> 6) * 256;
#pragma unroll
        for (int h = 0; h < 2; ++h)
#pragma unroll
            for (int i = 0; i < 2; ++i) v[h][i] = ((unsigned)t[h * 128 + Rr[i]] * (unsigned)K + (unsigned)Cc[i]) * 2u;
    }
};

#define EPI_ARGS const f32x4 (&acc)[2][2][4][2], const Unit& u, int wr, int wc, int fr, int fq
__device__ __forceinline__ v4u pack8(f32x4 a, f32x4 b) { v4u w; w.x = cvt_pk_bf16(a[0], a[1]); w.y = cvt_pk_bf16(a[2], a[3]); w.z = cvt_pk_bf16(b[0], b[1]); w.w = cvt_pk_bf16(b[2], b[3]); return w; }

struct EpiIn {
    static constexpr bool PERM = true;
    bf16 *Q, *Kb, *VT, *UG; unsigned char* SG; const float* rstd;
    __device__ __forceinline__ void operator()(EPI_ARGS) const {
        const int pn = u.pn;
        if (pn == 4 || pn == 5) {
            f32x4 rsa[2][2];
#pragma unroll
            for (int bj = 0; bj < 2; ++bj) { const int t0 = u.pm * 256 + bj * 128 + wc * 32 + 8 * fq; rsa[bj][0] = *(const f32x4*)(rstd + t0); rsa[bj][1] = *(const f32x4*)(rstd + t0 + 4); }
            asm volatile("" : "+v"(rsa[0][0]), "+v"(rsa[0][1]), "+v"(rsa[1][0]), "+v"(rsa[1][1]));
#pragma unroll
            for (int bj = 0; bj < 2; ++bj) {
                const int t0 = u.pm * 256 + bj * 128 + wc * 32 + 8 * fq; const int b = t0 >> 13, i0 = t0 & 8191;
                const f32x4 rs0 = rsa[bj][0], rs1 = rsa[bj][1];
#pragma unroll
                for (int ai = 0; ai < 2; ++ai)
#pragma unroll
                    for (int m = 0; m < 4; ++m) {
                        const int vr = (pn - 4) * 256 + ai * 128 + wr * 64 + m * 16 + fr;
                        bf16* dst = VT + ((size_t)(b * 512 + vr)) * LPB + 32 + i0;
                        *(v4u*)dst = pack8(acc[ai][bj][m][0] * rs0, acc[ai][bj][m][1] * rs1);
                    }
            }
        } else {
            float rsv[2][4];
#pragma unroll
            for (int ai = 0; ai < 2; ++ai)
#pragma unroll
                for (int m = 0; m < 4; ++m) rsv[ai][m] = rstd[u.pm * 256 + ai * 128 + wr * 64 + m * 16 + fr];
            asm volatile("" : "+v"(rsv[0][0]), "+v"(rsv[0][1]), "+v"(rsv[0][2]), "+v"(rsv[0][3]), "+v"(rsv[1][0]), "+v"(rsv[1][1]), "+v"(rsv[1][2]), "+v"(rsv[1][3]));
#pragma unroll
            for (int ai = 0; ai < 2; ++ai)
#pragma unroll
                for (int m = 0; m < 4; ++m) {
                    const int row = u.pm * 256 + ai * 128 + wr * 64 + m * 16 + fr; const float rs = rsv[ai][m];
#pragma unroll
                    for (int bj = 0; bj < 2; ++bj) {
                        const int col0 = pn * 256 + bj * 128 + wc * 32 + 8 * fq;
                        f32x4 v0 = acc[ai][bj][m][0] * rs, v1 = acc[ai][bj][m][1] * rs;
                        if (pn < 2) { *(v4u*)(Q + (size_t)row * 512 + col0) = pack8(v0 * QSCALE, v1 * QSCALE); }
                        else if (pn < 4) { const int b = row >> 13, i = row & 8191; *(v4u*)(Kb + ((size_t)(b * LPB + 32 + i)) * 512 + (col0 - 512)) = pack8(v0, v1); }
                        else if (pn < 8) { const int c = col0 - 1536; const int mrow = row >> 6;
                            *(v4u*)(UG + ((((size_t)((c >> 4) * 16 + (mrow >> 5)) * 64 + (row & 63)) * 2 + ((c & 15) >> 3)) * 32 + (mrow & 31)) * 8) = pack8(v0, v1); }
                        else {
                            unsigned g0 = 0u, g1 = 0u;
#pragma unroll
                            for (int e = 0; e < 4; ++e) { g0 = __builtin_amdgcn_cvt_pk_u8_f32(floorf(fast_sigmoid(v0[e]) * 256.0f), e, g0); g1 = __builtin_amdgcn_cvt_pk_u8_f32(floorf(fast_sigmoid(v1[e]) * 256.0f), e, g1); }
                            *(v2u*)(SG + (size_t)row * 2048 + (col0 - 2048)) = (v2u){g0, g1};
                        }
                    }
                }
        }
    }
};

struct EpiGlu {
    static constexpr bool PERM = true;
    const bf16* Y; bf16* O; const float* bias;
    __device__ __forceinline__ void operator()(EPI_ARGS) const {
#pragma unroll
        for (int bj = 0; bj < 2; ++bj) {
            const int col0 = u.pn * 256 + bj * 128 + wc * 32 + 8 * fq;
            const f32x4 b0 = *(const f32x4*)(bias + col0), b1 = *(const f32x4*)(bias + col0 + 4);
#pragma unroll
            for (int ai = 0; ai < 2; ++ai)
#pragma unroll
                for (int m = 0; m < 4; ++m) {
                    const int row = u.pm * 256 + ai * 128 + wr * 64 + m * 16 + fr;
                    const v4u yv = *(const v4u*)(Y + (size_t)row * 512 + col0);
                    f32x4 v0 = acc[ai][bj][m][0] + b0, v1 = acc[ai][bj][m][1] + b1;
                    v0[0] = bflo(yv.x) * fast_sigmoid(v0[0]); v0[1] = bfhi(yv.x) * fast_sigmoid(v0[1]); v0[2] = bflo(yv.y) * fast_sigmoid(v0[2]); v0[3] = bfhi(yv.y) * fast_sigmoid(v0[3]);
                    v1[0] = bflo(yv.z) * fast_sigmoid(v1[0]); v1[1] = bfhi(yv.z) * fast_sigmoid(v1[1]); v1[2] = bflo(yv.w) * fast_sigmoid(v1[2]); v1[3] = bfhi(yv.w) * fast_sigmoid(v1[3]);
                    *(v4u*)(O + (size_t)row * 512 + col0) = pack8(v0, v1);
                }
        }
    }
};

struct EpiMerge {
    static constexpr bool PERM = true;
    const unsigned char* SG; bf16* O;
    static __device__ __forceinline__ float gq(unsigned w, int i) { return (float)((w >> (8 * i)) & 0xffu) + 0.5f; }
    __device__ __forceinline__ void mid(f32x4 (&acc)[2][2][4][2], const Unit& u, int wr, int wc, int fr, int fq) const {
#pragma unroll
        for (int ai = 0; ai < 2; ++ai)
#pragma unroll
            for (int m = 0; m < 4; ++m) {
                const int row = u.pm * 256 + ai * 128 + wr * 64 + m * 16 + fr;
#pragma unroll
                for (int bj = 0; bj < 2; ++bj) {
                    const int col0 = u.pn * 256 + bj * 128 + wc * 32 + 8 * fq;
                    const v2u ga = *(const v2u*)(SG + (size_t)row * 2048 + col0), gb = *(const v2u*)(SG + (size_t)row * 2048 + 1024 + col0);
                    f32x4& v0 = acc[ai][bj][m][0]; f32x4& v1 = acc[ai][bj][m][1];
#pragma unroll
                    for (int e = 0; e < 4; ++e) { v0[e] *= gq(ga.x, e) * __builtin_amdgcn_rcpf(gq(gb.x, e)); v1[e] *= gq(ga.y, e) * __builtin_amdgcn_rcpf(gq(gb.y, e)); }
                }
            }
    }
    __device__ __forceinline__ void operator()(EPI_ARGS) const {
#pragma unroll
        for (int ai = 0; ai < 2; ++ai)
#pragma unroll
            for (int m = 0; m < 4; ++m) {
                const int row = u.pm * 256 + ai * 128 + wr * 64 + m * 16 + fr;
#pragma unroll
                for (int bj = 0; bj < 2; ++bj) {
                    const int col0 = u.pn * 256 + bj * 128 + wc * 32 + 8 * fq;
                    const v2u g = *(const v2u*)(SG + (size_t)row * 2048 + 1024 + col0);
                    f32x4 v0 = acc[ai][bj][m][0], v1 = acc[ai][bj][m][1];
#pragma unroll
                    for (int e = 0; e < 4; ++e) { v0[e] *= gq(g.x, e) * 0.00390625f; v1[e] *= gq(g.y, e) * 0.00390625f; }
                    *(v4u*)(O + (size_t)row * 1024 + col0) = pack8(v0, v1);
                }
            }
    }
};

struct EpiOut {
    static constexpr bool PERM = true;
    const float* X; bf16* HB; unsigned char* HB8; float* ssqp;
    __device__ __forceinline__ void operator()(EPI_ARGS) const {
#pragma unroll
        for (int ai = 0; ai < 2; ++ai)
#pragma unroll
            for (int m = 0; m < 4; ++m) {
                const int row = u.pm * 256 + ai * 128 + wr * 64 + m * 16 + fr; float ss = 0.f;
#pragma unroll
                for (int bj = 0; bj < 2; ++bj) {
                    const int col0 = u.pn * 256 + bj * 128 + wc * 32 + 8 * fq;
                    const f32x4 x0 = *(const f32x4*)(X + (size_t)row * D + col0), x1 = *(const f32x4*)(X + (size_t)row * D + col0 + 4);
                    const f32x4 v0 = acc[ai][bj][m][0] + x0, v1 = acc[ai][bj][m][1] + x1;
                    *(v4u*)(HB + (size_t)row * D + col0) = pack8(v0, v1);
                    { int p0 = 0, p1 = 0;
                      p0 = __builtin_amdgcn_cvt_pk_fp8_f32(v0[0], v0[1], p0, false); p0 = __builtin_amdgcn_cvt_pk_fp8_f32(v0[2], v0[3], p0, true);
                      p1 = __builtin_amdgcn_cvt_pk_fp8_f32(v1[0], v1[1], p1, false); p1 = __builtin_amdgcn_cvt_pk_fp8_f32(v1[2], v1[3], p1, true);
                      *(v2u*)(HB8 + (size_t)row * D + col0) = (v2u){(unsigned)p0, (unsigned)p1}; }
                    ss += (v0[0] * v0[0] + v0[1] * v0[1]) + (v0[2] * v0[2] + v0[3] * v0[3]) + (v1[0] * v1[0] + v1[1] * v1[1]) + (v1[2] * v1[2] + v1[3] * v1[3]);
                }
                { const int ln = fq * 16 + fr; ss += shx(ss, 16, ln); ss += shx(ss, 32, ln); }
                if (fq == 0) ssqp[(size_t)row * 16 + u.pn * 4 + wc] = ss;
            }
    }
};

struct EpiUp {
    static constexpr bool PERM = true;
    const float* srs; unsigned char* HID;
    __device__ __forceinline__ void operator()(EPI_ARGS) const {
        const int pnl = u.pn & 3;
        float rsv[2][4];
#pragma unroll
        for (int ai = 0; ai < 2; ++ai)
#pragma unroll
            for (int m = 0; m < 4; ++m) rsv[ai][m] = srs[u.pm * 256 + ai * 128 + wr * 64 + m * 16 + fr];
        asm volatile("" : "+v"(rsv[0][0]), "+v"(rsv[0][1]), "+v"(rsv[0][2]), "+v"(rsv[0][3]), "+v"(rsv[1][0]), "+v"(rsv[1][1]), "+v"(rsv[1][2]), "+v"(rsv[1][3]));
#pragma unroll
        for (int ai = 0; ai < 2; ++ai)
#pragma unroll
            for (int m = 0; m < 4; ++m) {
                const int slot = u.pm * 256 + ai * 128 + wr * 64 + m * 16 + fr; const float rs = rsv[ai][m];
                f32x4 h0, h1;
#pragma unroll
                for (int e = 0; e < 4; ++e) {
                    const float a0 = acc[ai][0][m][0][e] * rs, c0 = acc[ai][1][m][0][e] * rs; h0[e] = a0 * fast_sigmoid(a0) * c0 * 4.0f;
                    const float a1 = acc[ai][0][m][1][e] * rs, c1 = acc[ai][1][m][1][e] * rs; h1[e] = a1 * fast_sigmoid(a1) * c1 * 4.0f;
                }
                int p0 = 0, p1 = 0;
                p0 = __builtin_amdgcn_cvt_pk_fp8_f32(h0[0], h0[1], p0, false); p0 = __builtin_amdgcn_cvt_pk_fp8_f32(h0[2], h0[3], p0, true);
                p1 = __builtin_amdgcn_cvt_pk_fp8_f32(h1[0], h1[1], p1, false); p1 = __builtin_amdgcn_cvt_pk_fp8_f32(h1[2], h1[3], p1, true);
                *(v2u*)(HID + (size_t)slot * FF + pnl * 128 + wc * 32 + 8 * fq) = (v2u){(unsigned)p0, (unsigned)p1};
            }
    }
};

struct EpiDown {
    static constexpr bool PERM = true;
    const int* sdst; const float* sgate; unsigned char* YB;
    __device__ __forceinline__ void operator()(EPI_ARGS) const {
        const int pnl = u.pn & 3;
#pragma unroll
        for (int ai = 0; ai < 2; ++ai)
#pragma unroll
            for (int m = 0; m < 4; ++m) {
                const int slot = u.pm * 256 + ai * 128 + wr * 64 + m * 16 + fr; const int dst = sdst[slot]; const float gt = sgate[slot] * 16.0f;
                if (dst >= 0) {
#pragma unroll
                    for (int bj = 0; bj < 2; ++bj) {
                        const f32x4 a = acc[ai][bj][m][0] * gt, c2 = acc[ai][bj][m][1] * gt; int p0 = 0, p1 = 0;
                        p0 = __builtin_amdgcn_cvt_pk_fp8_f32(a[0], a[1], p0, false); p0 = __builtin_amdgcn_cvt_pk_fp8_f32(a[2], a[3], p0, true);
                        p1 = __builtin_amdgcn_cvt_pk_fp8_f32(c2[0], c2[1], p1, false); p1 = __builtin_amdgcn_cvt_pk_fp8_f32(c2[2], c2[3], p1, true);
                        *(v2u*)(YB + ((unsigned)dst * (unsigned)D + (unsigned)(pnl * 256 + bj * 128 + wc * 32 + 8 * fq))) = (v2u){(unsigned)p0, (unsigned)p1};
                    }
                }
            }
    }
};

__device__ __forceinline__ void p0_transpose_block(const float* W, int N, int k0, int n0, bf16* dst, int ldk, const float* ksc, LAS float* scr, int lane) {
#pragma unroll 8
    for (int i = 0; i < 32; ++i) { const int kk = 2 * i + (lane >> 5); float v = W[(size_t)(k0 + kk) * N + n0 + (lane & 31)]; if (ksc) v *= ksc[k0 + kk]; scr[kk * 33 + (lane & 31)] = v; }
    LDS_WAIT(); asm volatile("" ::: "memory");
    const int c = lane & 7;
#pragma unroll
    for (int j = 0; j < 4; ++j) { const int n = (lane >> 3) + 8 * j; const LAS float* s = scr + (8 * c) * 33 + n;
        v4u o; o.x = cvt_pk_bf16(s[0 * 33], s[1 * 33]); o.y = cvt_pk_bf16(s[2 * 33], s[3 * 33]); o.z = cvt_pk_bf16(s[4 * 33], s[5 * 33]); o.w = cvt_pk_bf16(s[6 * 33], s[7 * 33]);
        *(v4u*)(dst + (size_t)n * ldk + k0 + 8 * c) = o; }
    LDS_WAIT(); asm volatile("" ::: "memory");
}


__device__ __forceinline__ float gelu_tanh(float x) { const float u = 0.7978845608028654f * (x + 0.044715f * x * x * x); return x * fast_sigmoid(2.0f * u); }
typedef unsigned short us4 __attribute__((ext_vector_type(4)));

__device__ __forceinline__ void attn_unit(const bf16* Qb, const bf16* Kb, const bf16* VT, bf16* Ob, int b, int head, int qb, int lane, LAS unsigned char* wl) {
    const int l31 = lane & 31, h = lane >> 5;
    const int row = b * SEQ + qb * 32 + l31;
    bf16x8 qf[4];
#pragma unroll
    for (int st = 0; st < 4; ++st) qf[st] = *(const bf16x8*)(Qb + (size_t)row * 512 + head * 64 + 16 * st + 8 * h);
    const int Pq0 = 16 + qb * 32, qpos = Pq0 + l31;
    f32x16 o0, o1;
#pragma unroll
    for (int r = 0; r < 16; ++r) { o0[r] = 0.f; o1[r] = 0.f; }
    float carry = 1.f;
    LAS unsigned char* kl = wl; LAS unsigned char* vl = wl + 32 * 144;
    const bf16* kg = Kb + ((size_t)b * LPB + 16 + (lane >> 3)) * 512 + head * 64 + (lane & 7) * 8;
    const bf16* vg = VT + ((size_t)(b * 512 + head * 64 + (lane >> 2))) * LPB + 16 + (lane & 3) * 8;
    const int kwo = (lane >> 3) * 144 + (lane & 7) * 16, vwo = (lane >> 2) * 72 + (lane & 3) * 16;
    v4u krx[4], vrx[4], kry[4], vry[4];
#define ATT_GLOAD(kr, vr, kbx) do { _Pragma("unroll") for (int i = 0; i < 4; ++i) { kr[i] = *(const v4u*)(kg + (long)((kbx) + 8 * i) * 512); vr[i] = *(const v4u*)(vg + (size_t)(16 * i) * LPB + (long)(kbx)); } } while (0)
#define ATT_STAGE(kr, vr) do { _Pragma("unroll") for (int i = 0; i < 4; ++i) { *(LAS v4u*)(kl + kwo + i * 8 * 144) = kr[i]; \
        *(LAS v2u*)(vl + vwo + i * 16 * 72) = (v2u){vr[i].x, vr[i].y}; *(LAS v2u*)(vl + vwo + i * 16 * 72 + 8) = (v2u){vr[i].z, vr[i].w}; } } while (0)
#define ATT_FRAGS(Sx, vax, vbx) do { bf16x8 kf_[4]; _Pragma("unroll") for (int st = 0; st < 4; ++st) kf_[st] = *(const LAS bf16x8*)(kl + l31 * 144 + st * 32 + 16 * h); \
        _Pragma("unroll") for (int db = 0; db < 2; ++db) _Pragma("unroll") for (int s2 = 0; s2 < 2; ++s2) { const LAS unsigned char* vp = vl + (db * 32 + l31) * 72 + (16 * s2 + 4 * h) * 2; vax[db][s2] = *(const LAS v2u*)vp; vbx[db][s2] = *(const LAS v2u*)(vp + 16); } \
        _Pragma("unroll") for (int r = 0; r < 16; ++r) Sx[r] = 0.f; \
        _Pragma("unroll") for (int st = 0; st < 4; ++st) Sx = __builtin_amdgcn_mfma_f32_32x32x16_bf16(kf_[st], qf[st], Sx, 0, 0, 0); } while (0)
#define ATT_TILE(Sx, vax, vbx, kbx) do { \
        float be[16], kp[16]; \
        const bool boundary = ((kbx) + 31 >= Pq0) || ((kbx) < 0);        \
        _Pragma("unroll") for (int r = 0; r < 16; ++r) { const float e = __builtin_amdgcn_exp2f(-Sx[r]); be[r] = __builtin_amdgcn_rcpf(1.0f + e); kp[r] = 1.0f - be[r]; } \
        if (boundary) { _Pragma("unroll") for (int r = 0; r < 16; ++r) { const int key = (kbx) + (r & 3) + 8 * (r >> 2) + 4 * h; const bool valid = (key < qpos) && (key >= 0); \
                be[r] = valid ? be[r] : 0.f; kp[r] = valid ? kp[r] : 1.f; } } \
        float gs[4], pg[4]; \
        _Pragma("unroll") for (int g = 0; g < 4; ++g) { gs[g] = (kp[4 * g] * kp[4 * g + 1]) * (kp[4 * g + 2] * kp[4 * g + 3]); pg[g] = shx(gs[g], 32, lane); } \
        float w[16]; float later = carry; \
        _Pragma("unroll") for (int g = 3; g >= 0; --g) { \
            const float p3 = later * (h == 0 ? pg[g] : 1.f); \
            const float p2 = p3 * kp[4 * g + 3], p1 = p2 * kp[4 * g + 2], p0 = p1 * kp[4 * g + 1]; \
            w[4 * g + 3] = be[4 * g + 3] * p3; w[4 * g + 2] = be[4 * g + 2] * p2; w[4 * g + 1] = be[4 * g + 1] * p1; w[4 * g] = be[4 * g] * p0; \
            later *= gs[g] * pg[g]; } \
        carry = later; \
        _Pragma("unroll") for (int s2 = 0; s2 < 2; ++s2) { \
            v4u wp; wp.x = cvt_pk_bf16(w[8 * s2], w[8 * s2 + 1]); wp.y = cvt_pk_bf16(w[8 * s2 + 2], w[8 * s2 + 3]); wp.z = cvt_pk_bf16(w[8 * s2 + 4], w[8 * s2 + 5]); wp.w = cvt_pk_bf16(w[8 * s2 + 6], w[8 * s2 + 7]); \
            const bf16x8 wf = __builtin_bit_cast(bf16x8, wp); \
            v4u v0; v0.x = vax[0][s2].x; v0.y = vax[0][s2].y; v0.z = vbx[0][s2].x; v0.w = vbx[0][s2].y; \
            v4u v1; v1.x = vax[1][s2].x; v1.y = vax[1][s2].y; v1.z = vbx[1][s2].x; v1.w = vbx[1][s2].y; \
            o0 = __builtin_amdgcn_mfma_f32_32x32x16_bf16(__builtin_bit_cast(bf16x8, v0), wf, o0, 0, 0, 0); \
            o1 = __builtin_amdgcn_mfma_f32_32x32x16_bf16(__builtin_bit_cast(bf16x8, v1), wf, o1, 0, 0, 0); } } while (0)
#define ATT_STEP(kr, vr, kbx) do { ATT_STAGE(kr, vr); const int kb2_ = ((kbx) - 64 > -32) ? (kbx) - 64 : (kbx); ATT_GLOAD(kr, vr, kb2_); \
        f32x16 S_; v2u va_[2][2], vb_[2][2]; ATT_FRAGS(S_, va_, vb_); ATT_TILE(S_, va_, vb_, kbx); } while (0)
    ATT_GLOAD(krx, vrx, Pq0);
    { const int kb1 = (Pq0 - 32 > -32) ? Pq0 - 32 : Pq0; ATT_GLOAD(kry, vry, kb1); }
    for (int kb = Pq0; ; kb -= 64) {
        ATT_STEP(krx, vrx, kb);
        if (__all(carry < 9.3132257e-10f)) break;
        if (!((kb - 32) > -32)) break;
        ATT_STEP(kry, vry, kb - 32);
        if (__all(carry < 9.3132257e-10f)) break;
        if (!((kb - 64) > -32)) break;
    }
#undef ATT_STEP
#undef ATT_TILE
#undef ATT_GLOAD
#undef ATT_STAGE
#undef ATT_FRAGS
    bf16* op = Ob + (size_t)row * 512 + head * 64 + 4 * h;
#pragma unroll
    for (int g = 0; g < 4; ++g) {
        v2u a; a.x = cvt_pk_bf16(o0[4 * g], o0[4 * g + 1]); a.y = cvt_pk_bf16(o0[4 * g + 2], o0[4 * g + 3]); *(v2u*)(op + 8 * g) = a;
        v2u d; d.x = cvt_pk_bf16(o1[4 * g], o1[4 * g + 1]); d.y = cvt_pk_bf16(o1[4 * g + 2], o1[4 * g + 3]); *(v2u*)(op + 32 + 8 * g) = d;
    }
}


struct Tr64 { const float* W; int N, k0, n0, ldk; bf16* dst; const float* ksc; int f8; float osc; };
__device__ __forceinline__ void tr64_load(const Tr64& t, f32x4 (&v)[16], int lane) {
    const float* p = t.W + (size_t)(t.k0 + (lane >> 4)) * t.N + t.n0 + 4 * (lane & 15);
#pragma unroll
    for (int i = 0; i < 16; ++i) v[i] = __builtin_nontemporal_load((const f32x4*)(p + (size_t)(4 * i) * t.N));
}
__device__ __forceinline__ void tr64_store(const Tr64& t, const f32x4 (&v)[16], LAS float* scr, int lane) {
    const int cch = lane & 7;
    f32x4 g0 = (f32x4){1.f, 1.f, 1.f, 1.f}, g1 = g0;
    if (t.ksc) { g0 = *(const f32x4*)(t.ksc + t.k0 + 8 * cch); g1 = *(const f32x4*)(t.ksc + t.k0 + 8 * cch + 4); }
    { LAS float* w = scr + (lane >> 4) * 65 + 4 * (lane & 15);
#pragma unroll
        for (int i = 0; i < 16; ++i) { w[(4 * i) * 65 + 0] = v[i][0]; w[(4 * i) * 65 + 1] = v[i][1]; w[(4 * i) * 65 + 2] = v[i][2]; w[(4 * i) * 65 + 3] = v[i][3]; } }
    LDS_WAIT(); asm volatile("" ::: "memory");
    if (t.f8) { g0 = g0 * t.osc; g1 = g1 * t.osc;
#pragma unroll
        for (int jj = 0; jj < 8; ++jj) { const int n = (lane >> 3) + 8 * jj; const LAS float* sp = scr + (8 * cch) * 65 + n; int p0 = 0, p1 = 0;
            p0 = __builtin_amdgcn_cvt_pk_fp8_f32(sp[0 * 65] * g0[0], sp[1 * 65] * g0[1], p0, false); p0 = __builtin_amdgcn_cvt_pk_fp8_f32(sp[2 * 65] * g0[2], sp[3 * 65] * g0[3], p0, true);
            p1 = __builtin_amdgcn_cvt_pk_fp8_f32(sp[4 * 65] * g1[0], sp[5 * 65] * g1[1], p1, false); p1 = __builtin_amdgcn_cvt_pk_fp8_f32(sp[6 * 65] * g1[2], sp[7 * 65] * g1[3], p1, true);
            *(v2u*)((unsigned char*)t.dst + (size_t)n * t.ldk + t.k0 + 8 * cch) = (v2u){(unsigned)p0, (unsigned)p1}; }
    } else {
#pragma unroll
    for (int jj = 0; jj < 8; ++jj) { const int n = (lane >> 3) + 8 * jj; const LAS float* sp = scr + (8 * cch) * 65 + n;
        v4u o; o.x = cvt_pk_bf16(sp[0 * 65] * g0[0], sp[1 * 65] * g0[1]); o.y = cvt_pk_bf16(sp[2 * 65] * g0[2], sp[3 * 65] * g0[3]);
        o.z = cvt_pk_bf16(sp[4 * 65] * g1[0], sp[5 * 65] * g1[1]); o.w = cvt_pk_bf16(sp[6 * 65] * g1[2], sp[7 * 65] * g1[3]);
        *(v4u*)(t.dst + (size_t)n * t.ldk + t.k0 + 8 * cch) = o; }
    }
    LDS_WAIT(); asm volatile("" ::: "memory");
}
constexpr int I_E1 = 32 * 16 * 8, I_E3 = I_E1, I_E2 = 32 * 8 * 16, NEX = I_E1 + I_E3 + I_E2;
__device__ __forceinline__ Tr64 expert_item(int r, const float* ew1, const float* ew3, const float* ew2, const float* g_ffn, bf16* WupT, bf16* W2T) {
    Tr64 t; t.f8 = 1;
    if (r < I_E1 + I_E3) { const int w3 = r >= I_E1; if (w3) r -= I_E1; const int e = r >> 7; t.k0 = 64 * ((r >> 3) & 15); t.n0 = 64 * (r & 7);
        const int drow = (t.n0 >> 7) * 256 + (t.n0 & 127) + (w3 ? 128 : 0);
        t.W = (w3 ? ew3 : ew1) + (size_t)e * D * FF; t.N = FF; t.dst = (bf16*)((unsigned char*)WupT + ((size_t)e * 1024 + drow) * 1024); t.ldk = 1024; t.ksc = g_ffn; t.osc = 32.0f; }
    else { r -= I_E1 + I_E3; const int e = r >> 7; t.k0 = 64 * ((r >> 4) & 7); t.n0 = 64 * (r & 15);
        t.W = ew2 + (size_t)e * FF * D; t.N = D; t.dst = (bf16*)((unsigned char*)W2T + ((size_t)e * 1024 + t.n0) * 512); t.ldk = 512; t.ksc = nullptr; t.osc = 16.0f; }
    return t;
}

__global__ void __launch_bounds__(NWAVES * 64, 2) fwd_kernel(Args args) {
    extern __shared__ __attribute__((aligned(16))) unsigned char lds_raw[];
    Frame F;
    F.lds = (LAS unsigned char*)lds_raw;
    F.MISC = (volatile LAS unsigned*)(F.lds + MISC_OFF);
    F.tid = threadIdx.x; F.lane = F.tid & 63; F.wave = __builtin_amdgcn_readfirstlane(F.tid >> 6);
    F.G = gridDim.x; { const int bx = blockIdx.x; F.vcu = (F.G % 8 == 0) ? (bx % 8) * (F.G / 8) + bx / 8 : bx; }
    unsigned char* ws = args.ws;
    gu32* ctl = (gu32*)(ws + WS_CTL);
    for (int u = F.tid; u < (LDS_BYTES - LDSCTL_OFF) / 4; u += NWAVES * 64) ((LAS unsigned*)(F.lds + LDSCTL_OFF))[u] = 0u;
    __syncthreads();
    XcdBarrier bar = xcd_barrier_post((unsigned*)(ctl + CW_BAR), F.MISC + 8);
    const int wave = F.wave, c = F.vcu;
    const int gw = c * NWAVES + wave, NGW = F.G * NWAVES;

    const float* x = args.in[0]; const float* meta_tok = args.in[1]; const float* g_mix = args.in[2]; const float* w_in = args.in[3];
    const float* lam_re = args.in[4]; const float* lam_im = args.in[5]; const float* log_dt = args.in[6];
    const float* b_re = args.in[7]; const float* b_im = args.in[8]; const float* c_re = args.in[9]; const float* c_im = args.in[10];
    const float* ssm_d = args.in[11]; const float* glu_w = args.in[12]; const float* glu_b = args.in[13];
    const float* w_pa = args.in[14]; const float* w_pb = args.in[15]; const float* w_out = args.in[16]; const float* g_ffn = args.in[17];
    const float* rg_w = args.in[18]; const float* rg_b = args.in[19]; const float* re_w = args.in[20]; const float* re_b = args.in[21];
    const float* ew1 = args.in[22]; const float* ew3 = args.in[23]; const float* ew2 = args.in[24]; const float* g_fin = args.in[25];
    float* out = args.out;
    float* rstd1 = (float*)(ws + SM_RSTD1); float* rstd2 = (float*)(ws + SM_RSTD2);
    int* eid = (int*)(ws + SM_EID); float* gatev = (float*)(ws + SM_GATE); int* cntg = (int*)(ws + SM_CNT);
    float* umeta = (float*)(ws + SM_UMETA); float* bbar_g = (float*)(ws + SM_BBAR); float* lbar_g = (float*)(ws + SM_LBAR); float* l64_g = (float*)(ws + SM_L64);
    int* sdst = (int*)(ws + SM_SDST); float* sgate = (float*)(ws + SM_SGATE); float* srs = (float*)(ws + SM_SRS);
    float* metapart = (float*)(ws + SM_METAP);
    bf16* wr_t = (bf16*)(ws + SM_WR); float* rbias = (float*)(ws + SM_RB); int* moemeta = (int*)(ws + SM_MOEMETA); float* ssqp = (float*)(ws + SM_SSQP);
    bf16* WinT = (bf16*)(ws + WS_WIN); bf16* WpabT = (bf16*)(ws + WS_WPAB); bf16* WoT = (bf16*)(ws + WS_WO); bf16* GluT = (bf16*)(ws + WS_GLU);
    bf16* KT = (bf16*)(ws + WS_KT); bf16* T2 = (bf16*)(ws + WS_T2); bf16* T3 = (bf16*)(ws + WS_T3);
    bf16* WupT = (bf16*)(ws + WS_WUP); bf16* W2T = (bf16*)(ws + WS_W2);
    unsigned char* XB = ws + WS_XB; bf16* MRG = (bf16*)(ws + WS_XB);
    bf16* Qb = (bf16*)(ws + WS_Q); bf16* SSMb = (bf16*)(ws + WS_SSM); bf16* Kb = (bf16*)(ws + WS_K); bf16* VT = (bf16*)(ws + WS_VT);
    bf16* UG = (bf16*)(ws + WS_UG); bf16* Yb = (bf16*)(ws + WS_Y); float* Sst = (float*)(ws + WS_S); bf16* Xs = (bf16*)(ws + WS_XS);
    bf16* H1B = (bf16*)(ws + WS_H1B); unsigned char* H1B8 = ws + WS_H1B8; unsigned char* HID = ws + WS_HID; unsigned char* YB = (unsigned char*)(ws + WS_YB);
    unsigned char* SG = ws + WS_SG;
    int* inv_tok = (int*)(ws + WS_INV); float* inv_gate = (float*)(ws + WS_INV + (size_t)NE * CAPE * 4); float* inv_rs = (float*)(ws + WS_INV + (size_t)2 * NE * CAPE * 4);
    int* mymeta = (int*)(ws + WS_MWG) + (size_t)blockIdx.x * 512; unsigned* etot = (unsigned*)(ctl + CW_TOT);

    for (int rep = 0; rep < REP_P0; ++rep) {
        int tid = threadIdx.x; asm volatile("" : "+v"(tid)); const int lane = tid & 63; (void)lane;
        if (rep) { __syncthreads(); if (tid == 0) F.MISC[0] = 0u; __syncthreads(); }
        if (c & 1) {
            LAS float* scr = (LAS float*)(F.lds + wave * P0_SCR);
            constexpr int I_IN = 16 * 64, I_PA = 8 * 16, I_PB = 8 * 16, I_O = 16 * 16, I_G = 8 * 8;
            constexpr int NTR = I_IN + I_PA + I_PB + I_O + I_G, NXR = M / 4, NITEMS = NTR + NXR;
            const int per_wg = (REP_P0S * NITEMS + F.G - 1) / F.G;
            for (;;) {
                int kq = 0; if (lane == 0) kq = (int)__hip_atomic_fetch_add((unsigned*)(F.MISC + 0), 1u, __ATOMIC_RELAXED, __HIP_MEMORY_SCOPE_WORKGROUP);
                kq = __builtin_amdgcn_readfirstlane(kq);
                if (kq >= per_wg) break;
                int it = kq * F.G + c; if (it >= REP_P0S * NITEMS) break;
                if (REP_P0S > 1) it %= NITEMS;
                if (it >= NTR) {
                    const int m0 = (it - NTR) * 4; f32x4 v[4][4];
#pragma unroll
                    for (int q = 0; q < 4; ++q) { const f32x4* xr = (const f32x4*)(x + (size_t)(m0 + q) * D) + lane;
#pragma unroll
                        for (int jj = 0; jj < 4; ++jj) v[q][jj] = __builtin_nontemporal_load(&xr[64 * jj]); }
#pragma unroll
                    for (int q = 0; q < 4; ++q) { float ss = 0.f;
#pragma unroll
                        for (int jj = 0; jj < 4; ++jj) ss += (v[q][jj][0] * v[q][jj][0] + v[q][jj][1] * v[q][jj][1]) + (v[q][jj][2] * v[q][jj][2] + v[q][jj][3] * v[q][jj][3]);
                        ss = wave_sum(ss, lane);
                        if (lane == 0) rstd1[m0 + q] = 1.0f / sqrtf(ss * (1.0f / D) + RMS_EPS);
                        unsigned* o4 = (unsigned*)(XB + (size_t)(m0 + q) * D) + lane;
#pragma unroll
                        for (int jj = 0; jj < 4; ++jj) { int p = 0; p = __builtin_amdgcn_cvt_pk_fp8_f32(v[q][jj][0], v[q][jj][1], p, false); p = __builtin_amdgcn_cvt_pk_fp8_f32(v[q][jj][2], v[q][jj][3], p, true); o4[64 * jj] = (unsigned)p; } }
                    continue;
                }
                int r = it; const float* W; int N, k0, n0, ldk; bf16* dst; const float* ksc = nullptr; int f8 = 0; float osc = 1.0f;
                if (r < I_IN) { W = w_in; N = INC; k0 = 64 * (r >> 6); n0 = 64 * (r & 63); dst = (bf16*)((unsigned char*)WinT + (size_t)n0 * 1024); ldk = 1024; ksc = g_mix; f8 = 1; osc = 32.0f; }
                else if ((r -= I_IN) < I_PA) { W = w_pa; N = D; k0 = 64 * (r >> 4); n0 = 64 * (r & 15); dst = WpabT + (size_t)n0 * 512; ldk = 512; }
                else if ((r -= I_PA) < I_PB) { W = w_pb; N = D; k0 = 64 * (r >> 4); n0 = 64 * (r & 15); dst = WpabT + (size_t)(1024 + n0) * 512; ldk = 512; }
                else if ((r -= I_PB) < I_O) { W = w_out; N = D; k0 = 64 * (r >> 4); n0 = 64 * (r & 15); dst = WoT + (size_t)n0 * 1024; ldk = 1024; }
                else { r -= I_O; W = glu_w; N = SW; k0 = 64 * (r >> 3); n0 = 64 * (r & 7); dst = GluT + (size_t)n0 * 512; ldk = 512; }
                { Tr64 t; t.W = W; t.N = N; t.k0 = k0; t.n0 = n0; t.ldk = ldk; t.dst = dst; t.ksc = ksc; t.f8 = f8; t.osc = osc; f32x4 tv[16]; tr64_load(t, tv, lane); tr64_store(t, tv, scr, lane); }
            }
            __syncthreads();
        }
        {
            const int g = c >> 3, j = c & 7;
            LAS f32x2* LP = (LAS f32x2*)(F.lds);
            LAS f32x2* BB = (LAS f32x2*)(F.lds + 33792);
            LAS f32x2* CC = (LAS f32x2*)(F.lds + 33792 + 8192);
            LAS f32x2* CL = (LAS f32x2*)(F.lds + 33792 + 16384);
            LAS float* mrs = (LAS float*)(F.lds + 33792 + 16384 + 65536);
            const float dt = expf(log_dt[g]);
#pragma unroll 1
            for (int idx = tid; idx < 65 * 64; idx += 512) {
                const int n = idx >> 6, p = idx & 63; const float lr = lam_re[g * 64 + p], li = lam_im[g * 64 + p];
                const float mag = expf((float)n * (lr * dt));
                const float rev1 = (li * dt) * 0.15915494309189535f; const float hi = (float)n * rev1; const float lo = fmaf((float)n, rev1, -hi);
                const float fr_ = (hi - rintf(hi)) + lo; const float sn = __builtin_amdgcn_sinf(fr_), cs = __builtin_amdgcn_cosf(fr_);
                LP[idx] = (f32x2){mag * cs, mag * sn};
            }
            for (int idx = tid; idx < 1024; idx += 512) { const int cc = idx >> 6, p = idx & 63; CC[idx] = (f32x2){c_re[(g * 16 + cc) * 64 + p], c_im[(g * 16 + cc) * 64 + p]}; }
            for (int r = 2 * wave; r < 2 * wave + 2; ++r) {
                float ss = 0.f;
#pragma unroll
                for (int i = 0; i < 16; ++i) { const float v = meta_tok[r * 1024 + lane + 64 * i]; ss += v * v; }
                ss = wave_sum(ss, lane);
                if (lane == 0) mrs[r] = 1.0f / sqrtf(ss * (1.0f / 1024.0f) + RMS_EPS);
            }
            __syncthreads();
            for (int idx = tid; idx < 1024; idx += 512) {
                const int p = idx >> 4, cp = idx & 15; const float lr = lam_re[g * 64 + p], li = lam_im[g * 64 + p];
                const f32x2 L1 = LP[64 + p]; const float nr = L1.x - 1.0f, ni = L1.y, den = lr * lr + li * li;
                const float fre = (nr * lr + ni * li) / den, fim = (ni * lr - nr * li) / den;
                const float br = b_re[(g * 64 + p) * 16 + cp], bi = b_im[(g * 64 + p) * 16 + cp];
                const f32x2 v = (f32x2){fre * br - fim * bi, fre * bi + fim * br};
                BB[idx] = v;
                if (j == 0) { bbar_g[((g * 64 + p) * 16 + cp) * 2] = v.x; bbar_g[((g * 64 + p) * 16 + cp) * 2 + 1] = v.y; }
            }
#pragma unroll 2
            for (int idx = tid; idx < 8192; idx += 512) { const int nl = idx >> 10, cc = (idx >> 6) & 15, p = idx & 63; const f32x2 C = CC[cc * 64 + p], L = LP[(8 * j + nl) * 64 + p];
                CL[idx] = (f32x2){C.x * L.x - C.y * L.y, C.x * L.y + C.y * L.x}; }
            if (j == 0 && tid < 64) { const f32x2 L1 = LP[64 + tid], L64 = LP[64 * 64 + tid];
                lbar_g[(g * 64 + tid) * 2] = L1.x; lbar_g[(g * 64 + tid) * 2 + 1] = L1.y; l64_g[(g * 64 + tid) * 2] = L64.x; l64_g[(g * 64 + tid) * 2 + 1] = L64.y; }
            __syncthreads();
#pragma unroll 1
            for (int idx = tid; idx < 2048; idx += 512) {
                const int nl = idx >> 8, cc = (idx >> 4) & 15, cp = idx & 15; float a = 0.f;
                const LAS f32x2* clp = CL + (nl * 16 + cc) * 64;
#pragma unroll 8
                for (int p = 0; p < 64; ++p) { const f32x2 X = clp[p], B = BB[p * 16 + cp]; a += X.x * B.x - X.y * B.y; }
                const int n = 8 * j + nl;
                if (n == 0 && cc == cp) a += ssm_d[g * 16 + cc];
                KT[((size_t)(g * KT_ROWS + n + 1)) * 256 + cc * 16 + cp] = (bf16)(cvt_pk_bf16(a, 0.f) & 0xffffu);
            }
            if (j == 0 && tid < 256) KT[((size_t)(g * KT_ROWS)) * 256 + tid] = 0;
#pragma unroll 2
            for (int idx = tid; idx < 16384; idx += 512) {
                const int kk = idx & 127, nn = idx >> 7; const int s2 = 8 * j + (kk >> 4), cp = kk & 15, ri = nn >> 6, p = nn & 63;
                const f32x2 L = LP[(63 - s2) * 64 + p], B = BB[p * 16 + cp];
                const float v = ri ? (L.x * B.y + L.y * B.x) : (L.x * B.x - L.y * B.y);
                T2[((((size_t)(g * 4 + (nn >> 5)) * 64 + s2) * 2 + (cp >> 3)) * 32 + (nn & 31)) * 8 + (cp & 7)] = (bf16)(cvt_pk_bf16(v, 0.f) & 0xffffu);
            }
#pragma unroll 2
            for (int idx = tid; idx < 16384; idx += 512) {
                const int kk = idx & 127, nl = idx >> 7; const int t = 8 * j + (nl >> 4), cc = nl & 15, ri = kk >> 6, p = kk & 63;
                const f32x2 L = LP[(t + 1) * 64 + p], C = CC[cc * 64 + p];
                const float v = ri ? -(C.x * L.y + C.y * L.x) : (C.x * L.x - C.y * L.y);
                T3[((((size_t)(g * 32 + (t >> 1)) * 8 + (kk >> 4)) * 2 + ((kk >> 3) & 1)) * 32 + (t & 1) * 16 + cc) * 8 + (kk & 7)] = (bf16)(cvt_pk_bf16(v, 0.f) & 0xffffu);
            }
            float my_rs[16];
            if (wave == 0 && c < 192) {
#pragma unroll
                for (int r = 0; r < 16; ++r) my_rs[r] = mrs[r];
            }
            __syncthreads();
            LAS float* scr = (LAS float*)(F.lds + wave * P0_SCR);
            if (wave == 0 && c < 192) {
                const int cb = c >> 3, kp = c & 7, k0 = 128 * kp, n = 512 + 64 * cb + lane;
#pragma unroll
                for (int r = 0; r < 16; ++r) { const float g0 = g_mix[k0 + lane], g1 = g_mix[k0 + 64 + lane];
                    scr[r * 128 + lane] = meta_tok[r * 1024 + k0 + lane] * my_rs[r] * g0; scr[r * 128 + 64 + lane] = meta_tok[r * 1024 + k0 + 64 + lane] * my_rs[r] * g1; }
                LDS_WAIT(); asm volatile("" ::: "memory");
                float a[16];
#pragma unroll
                for (int r = 0; r < 16; ++r) a[r] = 0.f;
#pragma unroll 4
                for (int k = 0; k < 128; k += 4) {
                    const float w0 = w_in[(size_t)(k0 + k) * INC + n], w1 = w_in[(size_t)(k0 + k + 1) * INC + n], w2 = w_in[(size_t)(k0 + k + 2) * INC + n], w3 = w_in[(size_t)(k0 + k + 3) * INC + n];
#pragma unroll
                    for (int r = 0; r < 16; ++r) { const f32x4 xv = *(const LAS f32x4*)(scr + r * 128 + k); a[r] += xv[0] * w0 + xv[1] * w1 + xv[2] * w2 + xv[3] * w3; }
                }
#pragma unroll
                for (int r = 0; r < 16; ++r) metapart[((size_t)kp * 16 + r) * 1536 + 64 * cb + lane] = a[r];
                LDS_WAIT(); asm volatile("" ::: "memory");
            } else if (wave == 1 && c < 64) {
                const int n = c;
#pragma unroll 4
                for (int i = 0; i < 16; ++i) { const int k = lane + 64 * i; float v = 0.f;
                    if (n < 4) v = rg_w[k * 4 + n] * g_ffn[k]; else if (n < 36) v = re_w[k * 32 + (n - 4)] * g_ffn[k];
                    const unsigned hi = cvt_pk_bf16(v, 0.f) & 0xffffu; const float lo = v - bf2f((unsigned short)hi);
                    const int fo = ((((n >> 5) * 64 + (k >> 4)) * 2 + ((k >> 3) & 1)) * 32 + (n & 31)) * 8 + (k & 7);
                    wr_t[fo] = (bf16)hi; wr_t[65536 + fo] = (bf16)(cvt_pk_bf16(lo, 0.f) & 0xffffu); }
                if (lane == 0) rbias[n] = n < 4 ? rg_b[n] : (n < 36 ? re_b[n - 4] : 0.f);
            } else if (wave == 1 && c < 72) {
                const int it = c - 64, b = it >> 1;
                if (it & 1) { for (int idx = lane; idx < 512 * 16; idx += 64) { const int cc = idx >> 4, r = idx & 15; VT[((size_t)(b * 512 + cc)) * LPB + r] = 0; } }
                else { for (int idx = lane; idx < 16 * 512; idx += 64) Kb[((size_t)(b * LPB)) * 512 + idx] = 0; }
            }
            if (!(c & 1)) {
            constexpr int I_IN = 16 * 64, I_PA = 8 * 16, I_PB = 8 * 16, I_O = 16 * 16, I_G = 8 * 8;
            constexpr int NTR = I_IN + I_PA + I_PB + I_O + I_G, NXR = M / 4, NITEMS = NTR + NXR;
            const int per_wg = (REP_P0S * NITEMS + F.G - 1) / F.G;
            for (;;) {
                int kq = 0; if (lane == 0) kq = (int)__hip_atomic_fetch_add((unsigned*)(F.MISC + 0), 1u, __ATOMIC_RELAXED, __HIP_MEMORY_SCOPE_WORKGROUP);
                kq = __builtin_amdgcn_readfirstlane(kq);
                if (kq >= per_wg) break;
                int it = kq * F.G + c; if (it >= REP_P0S * NITEMS) break;
                if (REP_P0S > 1) it %= NITEMS;
                if (it >= NTR) {
                    const int m0 = (it - NTR) * 4; f32x4 v[4][4];
#pragma unroll
                    for (int q = 0; q < 4; ++q) { const f32x4* xr = (const f32x4*)(x + (size_t)(m0 + q) * D) + lane;
#pragma unroll
                        for (int jj = 0; jj < 4; ++jj) v[q][jj] = __builtin_nontemporal_load(&xr[64 * jj]); }
#pragma unroll
                    for (int q = 0; q < 4; ++q) { float ss = 0.f;
#pragma unroll
                        for (int jj = 0; jj < 4; ++jj) ss += (v[q][jj][0] * v[q][jj][0] + v[q][jj][1] * v[q][jj][1]) + (v[q][jj][2] * v[q][jj][2] + v[q][jj][3] * v[q][jj][3]);
                        ss = wave_sum(ss, lane);
                        if (lane == 0) rstd1[m0 + q] = 1.0f / sqrtf(ss * (1.0f / D) + RMS_EPS);
                        unsigned* o4 = (unsigned*)(XB + (size_t)(m0 + q) * D) + lane;
#pragma unroll
                        for (int jj = 0; jj < 4; ++jj) { int p = 0; p = __builtin_amdgcn_cvt_pk_fp8_f32(v[q][jj][0], v[q][jj][1], p, false); p = __builtin_amdgcn_cvt_pk_fp8_f32(v[q][jj][2], v[q][jj][3], p, true); o4[64 * jj] = (unsigned)p; } }
                    continue;
                }
                int r = it; const float* W; int N, k0, n0, ldk; bf16* dst; const float* ksc = nullptr; int f8 = 0; float osc = 1.0f;
                if (r < I_IN) { W = w_in; N = INC; k0 = 64 * (r >> 6); n0 = 64 * (r & 63); dst = (bf16*)((unsigned char*)WinT + (size_t)n0 * 1024); ldk = 1024; ksc = g_mix; f8 = 1; osc = 32.0f; }
                else if ((r -= I_IN) < I_PA) { W = w_pa; N = D; k0 = 64 * (r >> 4); n0 = 64 * (r & 15); dst = WpabT + (size_t)n0 * 512; ldk = 512; }
                else if ((r -= I_PA) < I_PB) { W = w_pb; N = D; k0 = 64 * (r >> 4); n0 = 64 * (r & 15); dst = WpabT + (size_t)(1024 + n0) * 512; ldk = 512; }
                else if ((r -= I_PB) < I_O) { W = w_out; N = D; k0 = 64 * (r >> 4); n0 = 64 * (r & 15); dst = WoT + (size_t)n0 * 1024; ldk = 1024; }
                else { r -= I_O; W = glu_w; N = SW; k0 = 64 * (r >> 3); n0 = 64 * (r & 7); dst = GluT + (size_t)n0 * 512; ldk = 512; }
                { Tr64 t; t.W = W; t.N = N; t.k0 = k0; t.n0 = n0; t.ldk = ldk; t.dst = dst; t.ksc = ksc; t.f8 = f8; t.osc = osc; f32x4 tv[16]; tr64_load(t, tv, lane); tr64_store(t, tv, scr, lane); }
            }
            }
        }
    }
    xcd_barrier(bar);

#if PH_MAX >= 1
    for (int rep = 0; rep < REP_P1; ++rep) {
        P1Order S; S.so.init(M / 256, INC / 256, F.G, (int)blockIdx.x, WGM_P1); S.X = (const char*)XB; S.W = (const char*)WinT; S.t = (size_t)256 * 1024;
        EpiIn E{Qb, Kb, VT, UG, SG, rstd1};
        pg8::gemm_phase<EpiIn, P1Order, true, false, false, true>(F.lds + RING_OFF, 512, S, E, 0x7f7a);
        if (rep == REP_P1 - 1) {
            int tid = threadIdx.x; asm volatile("" : "+v"(tid));
            const int t = c * 512 + tid;
            if (t < 16 * 1536) {
                const int r = t / 1536, n = t % 1536; float sacc = 0.f;
#pragma unroll
                for (int kp = 0; kp < 8; ++kp) sacc += metapart[((size_t)kp * 16 + r) * 1536 + n];
                const bf16 hv = (bf16)(cvt_pk_bf16(sacc, 0.f) & 0xffffu);
                if (n < 512) { for (int b = 0; b < NB; ++b) Kb[((size_t)(b * LPB + 16 + r)) * 512 + n] = hv; }
                else if (n < 1024) { for (int b = 0; b < NB; ++b) VT[((size_t)(b * 512 + (n - 512))) * LPB + 16 + r] = hv; }
                else umeta[r * 512 + (n - 1024)] = sacc;
            }
        }
    }
    xcd_barrier(bar);
#endif


#if PH_MAX >= 2
    for (int rep = 0; rep < REP_SSM; ++rep) {
    if (c < 128) {
        int tid = threadIdx.x; asm volatile("" : "+v"(tid)); const int lane = tid & 63;
        const int b = c >> 5, g = c & 31;
        LAS float* SL = (LAS float*)(F.lds);
        LAS f32x2* ends = (LAS f32x2*)(F.lds + 128 * 129 * 4);
        {
            const int mbl = wave >> 1, nh = wave & 1, mb = 4 * b + mbl;
            const int l31 = lane & 31, h = lane >> 5;
            f32x16 a2[2];
#pragma unroll
            for (int r = 0; r < 16; ++r) { a2[0][r] = 0.f; a2[1][r] = 0.f; }
            const bf16* ua = UG + (size_t)(g * 16 + mb) * 64 * 512 + lane * 8;
            const bf16* t2 = T2 + (size_t)(g * 4 + 2 * nh) * 64 * 512 + lane * 8;
#pragma unroll 8
            for (int s2 = 0; s2 < 64; ++s2) {
                const bf16x8 a = *(const bf16x8*)(ua + s2 * 512);
                const bf16x8 b0 = *(const bf16x8*)(t2 + s2 * 512), b1 = *(const bf16x8*)(t2 + 64 * 512 + s2 * 512);
                a2[0] = __builtin_amdgcn_mfma_f32_32x32x16_bf16(a, b0, a2[0], 0, 0, 0);
                a2[1] = __builtin_amdgcn_mfma_f32_32x32x16_bf16(a, b1, a2[1], 0, 0, 0);
            }
#pragma unroll
            for (int t = 0; t < 2; ++t)
#pragma unroll
                for (int r = 0; r < 16; ++r) SL[(32 * mbl + (r & 3) + 8 * (r >> 2) + 4 * h) * 129 + (2 * nh + t) * 32 + l31] = a2[t][r];
        }
        __syncthreads();
        {
            const int seg = wave & 3, p = lane;
            const float lr = lbar_g[(g * 64 + p) * 2], li = lbar_g[(g * 64 + p) * 2 + 1], qr = l64_g[(g * 64 + p) * 2], qi = l64_g[(g * 64 + p) * 2 + 1];
            float vr[32], vi[32];
            float cr = 0.f, ci = 0.f, q32r = qr, q32i = qi;
            if (wave < 4) {
#pragma unroll
                for (int m = 0; m < 32; ++m) { vr[m] = SL[(32 * seg + m) * 129 + p]; vi[m] = SL[(32 * seg + m) * 129 + 64 + p]; }
                float xr = 0.f, xi = 0.f;
#pragma unroll
                for (int m = 0; m < 32; ++m) { const float sr = vr[m], si = vi[m]; vr[m] = xr; vi[m] = xi; const float nr = qr * xr - qi * xi + sr, ni = qr * xi + qi * xr + si; xr = nr; xi = ni; }
                ends[seg * 64 + p] = (f32x2){xr, xi};
                for (int r = 0; r < NMETA; ++r) {
                    float bur = 0.f, bui = 0.f;
#pragma unroll
                    for (int cp = 0; cp < 16; ++cp) { const float uv = umeta[r * 512 + 16 * g + cp]; bur += bbar_g[((g * 64 + p) * 16 + cp) * 2] * uv; bui += bbar_g[((g * 64 + p) * 16 + cp) * 2 + 1] * uv; }
                    const float nr = lr * cr - li * ci + bur, ni = lr * ci + li * cr + bui; cr = nr; ci = ni;
                }
#pragma unroll
                for (int k = 0; k < 5; ++k) { const float nr = q32r * q32r - q32i * q32i, ni = 2.0f * q32r * q32i; q32r = nr; q32i = ni; }
            }
            __syncthreads();
            if (wave < 4) {
                for (int k = 0; k < seg; ++k) { const f32x2 e = ends[k * 64 + p]; const float nr = q32r * cr - q32i * ci + e.x, ni = q32r * ci + q32i * cr + e.y; cr = nr; ci = ni; }
                float pr_ = 1.f, pi_ = 0.f;
#pragma unroll
                for (int m = 0; m < 32; ++m) {
                    const float Xr = vr[m] + (pr_ * cr - pi_ * ci), Xi = vi[m] + (pr_ * ci + pi_ * cr);
                    { const int mrow = b * 128 + 32 * seg + m;
                      const size_t xo = ((((size_t)(g * 16 + (mrow >> 5)) * 8 + (p >> 4)) * 2 + ((p >> 3) & 1)) * 32 + (mrow & 31)) * 8 + (p & 7);
                      Xs[xo] = (bf16)(cvt_pk_bf16(Xr, 0.f) & 0xffffu); Xs[xo + 4 * 512] = (bf16)(cvt_pk_bf16(Xi, 0.f) & 0xffffu); }
                    const float nr = pr_ * qr - pi_ * qi, ni = pr_ * qi + pi_ * qr; pr_ = nr; pi_ = ni;
                }
            }
        }
        __syncthreads();
    }
    if (rep == 0) {
        int tid = threadIdx.x; asm volatile("" : "+v"(tid)); const int lane = tid & 63; (void)lane;
        LAS float* scr = (LAS float*)(F.lds + wave * P0_SCR);
#pragma unroll 1
        for (int pass = 0; pass < 2; ++pass) {
            const bool do_att = (pass == 0) != (wave >= 4);
            if (do_att) {
                const int nu = (c < 128) ? 3 : 5;
#pragma unroll 1
                for (int rp = 0; rp < REP_ATT; ++rp)
#pragma unroll 1
                for (int i = 0; i < nu; ++i) { const int cc = (i < 4) ? c : c - 128; const int qi = (i < 4) ? i : 3;
                    attn_unit(Qb, Kb, VT, (rp == REP_ATT - 1) ? Qb : SSMb, cc >> 6, wave, (cc & 63) * 4 + qi, lane, (LAS unsigned char*)scr); }
            } else {
#pragma unroll 1
                for (int k = 0; k < 4; k += 2) {
                    const Tr64 ta = expert_item(c + 256 * (wave + 8 * k), ew1, ew3, ew2, g_ffn, WupT, W2T);
                    const Tr64 tb = expert_item(c + 256 * (wave + 8 * (k + 1)), ew1, ew3, ew2, g_ffn, WupT, W2T);
                    f32x4 va[16], vb[16];
                    tr64_load(ta, va, lane); tr64_load(tb, vb, lane);
                    tr64_store(ta, va, scr, lane); tr64_store(tb, vb, scr, lane);
                }
            }
        }
    }
    xcd_barrier(bar);
    for (int ui = 0; ui < 2; ++ui) {
        int tid = threadIdx.x; asm volatile("" : "+v"(tid)); const int lane = tid & 63; (void)lane;
        const int U = c * 2 + ui; const int g = U >> 4, mb = U & 15;
        const int l31 = lane & 31, h = lane >> 5;
        LAS unsigned char* UT = F.lds;
        LAS unsigned char* KTl = F.lds + 65536;
        __syncthreads();
        {
            const unsigned char* usrc = (const unsigned char*)(UG + (size_t)(g * 16 + mb) * 64 * 512);
#pragma unroll
            for (int i = 0; i < 8; ++i) { const int idx = tid + 512 * i; *(LAS v4u*)(UT + idx * 16) = *(const v4u*)(usrc + (size_t)idx * 16); }
            const unsigned char* ksrc = (const unsigned char*)(KT + (size_t)g * KT_ROWS * 256);
            for (int idx = tid; idx < 2080; idx += 512) *(LAS v4u*)(KTl + idx * 16) = *(const v4u*)(ksrc + (size_t)idx * 16);
        }
        f32x16 ac[4];
#pragma unroll
        for (int j = 0; j < 4; ++j)
#pragma unroll
            for (int r = 0; r < 16; ++r) ac[j][r] = 0.f;
        {
            const bf16* xa = Xs + (size_t)(g * 16 + mb) * 8 * 512 + lane * 8;
            const bf16* t3 = T3 + (size_t)(g * 32) * 8 * 512 + lane * 8;
#pragma unroll
            for (int kh = 0; kh < 2; ++kh) {
                bf16x8 xa4[4], tb[4][4];
#pragma unroll
                for (int k2 = 0; k2 < 4; ++k2) { xa4[k2] = *(const bf16x8*)(xa + (kh * 4 + k2) * 512);
#pragma unroll
                    for (int j = 0; j < 4; ++j) { const int tp = (j == 0) ? 2 * wave : (j == 1) ? 2 * wave + 1 : (j == 2) ? 30 - 2 * wave : 31 - 2 * wave; tb[k2][j] = *(const bf16x8*)(t3 + ((size_t)tp * 8 + (kh * 4 + k2)) * 512); } }
#pragma unroll
                for (int k2 = 0; k2 < 4; ++k2)
#pragma unroll
                    for (int j = 0; j < 4; ++j) ac[j] = __builtin_amdgcn_mfma_f32_32x32x16_bf16(xa4[k2], tb[k2][j], ac[j], 0, 0, 0);
            }
        }
        __syncthreads();
        {
            const LAS unsigned char* ap = UT + lane * 16;
            const LAS unsigned char* kp = KTl + (l31 >> 4) * 512 + (l31 & 15) * 32 + 16 * h;
            const int tA0 = 2 * wave, tA1 = 30 - 2 * wave;
            bf16x8 pv0[2], pv1[2];
            pv0[0] = *(const LAS bf16x8*)(kp + (2 * tA0 + 3) * 512); pv0[1] = *(const LAS bf16x8*)(kp + (2 * tA0 + 2) * 512);
            pv1[0] = *(const LAS bf16x8*)(kp + (2 * tA1 + 3) * 512); pv1[1] = *(const LAS bf16x8*)(kp + (2 * tA1 + 2) * 512);
#pragma unroll 1
            for (int s0 = 0; s0 < 64; s0 += 2) {
#pragma unroll
                for (int par = 0; par < 2; ++par) {
                    const int s2 = s0 + par;
                    const bf16x8 a = *(const LAS bf16x8*)(ap + s2 * 1024);
                    if (s2 <= 2 * tA0 + 3) { ac[1] = __builtin_amdgcn_mfma_f32_32x32x16_bf16(a, pv0[par], ac[1], 0, 0, 0);
                        if (s2 <= 2 * tA0 + 1) { const bf16x8 f = *(const LAS bf16x8*)(kp + (2 * tA0 - s2 + 1) * 512); ac[0] = __builtin_amdgcn_mfma_f32_32x32x16_bf16(a, f, ac[0], 0, 0, 0); pv0[par] = f; } }
                    if (s2 <= 2 * tA1 + 3) { ac[3] = __builtin_amdgcn_mfma_f32_32x32x16_bf16(a, pv1[par], ac[3], 0, 0, 0);
                        if (s2 <= 2 * tA1 + 1) { const bf16x8 f = *(const LAS bf16x8*)(kp + (2 * tA1 - s2 + 1) * 512); ac[2] = __builtin_amdgcn_mfma_f32_32x32x16_bf16(a, f, ac[2], 0, 0, 0); pv1[par] = f; } }
                }
            }
        }
#pragma unroll
        for (int j = 0; j < 4; ++j) { const int tp = (j == 0) ? 2 * wave : (j == 1) ? 2 * wave + 1 : (j == 2) ? 30 - 2 * wave : 31 - 2 * wave; const int t = 2 * tp + (l31 >> 4);
#pragma unroll
            for (int r = 0; r < 16; ++r) { const int m = 32 * mb + (r & 3) + 8 * (r >> 2) + 4 * h;
                Yb[((size_t)m * 64 + t) * 512 + 16 * g + (l31 & 15)] = (bf16)(cvt_pk_bf16(gelu_tanh(ac[j][r]), 0.f) & 0xffffu); } }
    }

    xcd_barrier(bar);
    }
    for (int rep = 0; rep < REP_MIX; ++rep) {
    {
        GOrder S; S.so.init(M / 256, SW / 256, F.G, (int)blockIdx.x, WGM_GLU); S.A = (const char*)Yb; S.B = (const char*)GluT; S.ta = (size_t)256 * 512 * 2; S.tb = (size_t)256 * 512 * 2;
        EpiGlu E{Yb, SSMb, glu_b};
        pg8::gemm_phase<EpiGlu, GOrder, true>(F.lds + RING_OFF, 512, S, E);
    }
    xcd_barrier(bar);
    {
        MergeOrder S; S.so.init(M / 256, D / 256, F.G, (int)blockIdx.x, WGM_MRG); S.A = (const char*)Qb; S.B = (const char*)WpabT; S.ta = (size_t)256 * 512 * 2; S.tb = (size_t)256 * 512 * 2;
        EpiMerge E{SG, MRG};
        pg8::gemm_phase<EpiMerge, MergeOrder, true, false, true>(F.lds + RING_OFF, 512, S, E);
    }
    xcd_barrier(bar);
    {
        GOrder S; S.so.init(M / 256, D / 256, F.G, (int)blockIdx.x, WGM_WO); S.A = (const char*)MRG; S.B = (const char*)WoT; S.ta = (size_t)256 * 1024 * 2; S.tb = (size_t)256 * 1024 * 2;
        EpiOut E{x, H1B, H1B8, ssqp};
        pg8::gemm_phase<EpiOut, GOrder, true>(F.lds + RING_OFF, 1024, S, E);
    }
    xcd_barrier(bar);
    }
#endif

#if PH_MAX >= 3
    for (int rep = 0; rep < REP_RT; ++rep) {
    {
        int tid = threadIdx.x; asm volatile("" : "+v"(tid)); const int lane = tid & 63; (void)lane;
        LAS float* lg = (LAS float*)(F.lds);
        LAS int* cntl = (LAS int*)(F.lds + 2 * 128 * 65 * 4);
        LAS int* basel = cntl + 32; LAS int* eloc = basel + 32; LAS float* gloc = (LAS float*)(eloc + 256); LAS float* rloc = gloc + 256;
        if (tid < 32) cntl[tid] = 0;
        const int mt = wave & 3, kh = wave >> 2, l31 = lane & 31, h = lane >> 5;
        {
            const int row = 128 * c + 32 * mt + l31;
            f32x16 a0, a1;
#pragma unroll
            for (int r = 0; r < 16; ++r) { a0[r] = 0.f; a1[r] = 0.f; }
            const bf16* hp = H1B + (size_t)row * D + 512 * kh + 8 * h;
            const bf16* w0 = wr_t + (size_t)(32 * kh) * 512 + lane * 8;
#pragma unroll 8
            for (int ks = 0; ks < 32; ++ks) {
                const bf16x8 av = *(const bf16x8*)(hp + 16 * ks);
                const bf16x8 bh0 = *(const bf16x8*)(w0 + 512 * ks), bl0 = *(const bf16x8*)(w0 + 65536 + 512 * ks);
                const bf16x8 bh1 = *(const bf16x8*)(w0 + 32768 + 512 * ks), bl1 = *(const bf16x8*)(w0 + 32768 + 65536 + 512 * ks);
                a0 = __builtin_amdgcn_mfma_f32_32x32x16_bf16(av, bh0, a0, 0, 0, 0);
                a0 = __builtin_amdgcn_mfma_f32_32x32x16_bf16(av, bl0, a0, 0, 0, 0);
                a1 = __builtin_amdgcn_mfma_f32_32x32x16_bf16(av, bh1, a1, 0, 0, 0);
                a1 = __builtin_amdgcn_mfma_f32_32x32x16_bf16(av, bl1, a1, 0, 0, 0);
            }
#pragma unroll
            for (int r = 0; r < 16; ++r) { const int rr = 32 * mt + (r & 3) + 8 * (r >> 2) + 4 * h; lg[(kh * 128 + rr) * 65 + l31] = a0[r]; lg[(kh * 128 + rr) * 65 + 32 + l31] = a1[r]; }
        }
        __syncthreads();
        if (tid < 128) {
            const int row = 128 * c + tid; float ss = 0.f;
#pragma unroll
            for (int j = 0; j < 16; ++j) ss += ssqp[(size_t)row * 16 + j];
            const float rs = 1.0f / sqrtf(ss * (1.0f / D) + RMS_EPS); rstd2[row] = rs;
            const LAS float* l = lg + tid * 65; const LAS float* l2 = lg + (128 + tid) * 65;
            float gl[4]; int gi = 0; float gm;
#pragma unroll
            for (int j = 0; j < 4; ++j) gl[j] = rs * (l[j] + l2[j]) + rbias[j];
            gm = gl[0];
#pragma unroll
            for (int j = 1; j < 4; ++j) if (gl[j] > gm) { gm = gl[j]; gi = j; }
            float den = 0.f;
#pragma unroll
            for (int j = 0; j < 4; ++j) den += expf(gl[j] - gm);
            const float ptop = 1.0f / den;
            float v0 = -3.0e38f, v1 = -3.0e38f; int i0 = 0, i1 = 0;
            for (int j = 0; j < 8; ++j) { const float v = rs * (l[4 + gi * 8 + j] + l2[4 + gi * 8 + j]) + rbias[4 + gi * 8 + j];
                if (v > v0) { v1 = v0; i1 = i0; v0 = v; i0 = j; } else if (v > v1) { v1 = v; i1 = j; } }
            const float e1 = expf(v1 - v0); const float g0 = ptop / (1.0f + e1), g1 = ptop * e1 / (1.0f + e1);
            const int ea = gi * 8 + i0, eb = gi * 8 + i1;
            eloc[2 * tid] = ea; eloc[2 * tid + 1] = eb; gloc[2 * tid] = g0; gloc[2 * tid + 1] = g1; rloc[tid] = rs;
            atomicAdd((int*)(cntl + ea), 1); atomicAdd((int*)(cntl + eb), 1);
        }
        __syncthreads();
        if (tid < 32) basel[tid] = (int)__hip_atomic_fetch_add(etot + tid, (unsigned)cntl[tid], __ATOMIC_RELAXED, __HIP_MEMORY_SCOPE_AGENT);
        __syncthreads();
        if (tid < 256) {
            const int e = eloc[tid]; int rank = 0;
            for (int a = 0; a < tid; ++a) rank += (eloc[a] == e) ? 1 : 0;
            const int idx = e * CAPE + basel[e] + rank;
            inv_tok[idx] = 128 * c * 2 + tid; inv_gate[idx] = gloc[tid]; inv_rs[idx] = rloc[tid >> 1];
        }
    }
    xcd_barrier(bar);
    }
    for (int rep = 0; rep < REP_MOE; ++rep) {
    {
        LAS int* rowtok = (LAS int*)(F.lds + ROWTOK_OFF);
        { int tid = threadIdx.x; asm volatile("" : "+v"(tid));
          LAS int* tot = (LAS int*)(F.lds); LAS int* pst = tot + 32; LAS int* blke = pst + 40;
          if (tid < 32) tot[tid] = (int)etot[tid];
          __syncthreads();
          if (tid == 0) { int p = 0; for (int e = 0; e < 32; ++e) { pst[e] = p; p += ((tot[e] + 255) >> 8) << 8; } pst[32] = p; mymeta[0] = p >> 8; }
          __syncthreads();
          if (tid < 32) { for (int rb = pst[tid] >> 8; rb < (pst[tid + 1] >> 8); ++rb) { blke[rb] = tid; mymeta[16 + rb] = tid; } }
          __syncthreads();
          const int nrb = pst[32] >> 8; const int cb = (int)blockIdx.x;
          for (int idx = tid; idx < 5 * 256; idx += 512) { const int rb = (idx >> 8) * 64 + (cb & 7) * 8 + (cb >> 5); int tk = 0;
              if (rb < nrb) { const int e = blke[rb]; const int slot = rb * 256 + (idx & 255); const int rel = slot - pst[e]; const bool ok = rel < tot[e];
                  const int t2 = ok ? inv_tok[e * CAPE + rel] : -1; tk = ok ? (t2 >> 1) : 0;
                  sdst[slot] = t2; sgate[slot] = ok ? inv_gate[e * CAPE + rel] : 0.f; srs[slot] = ok ? inv_rs[e * CAPE + rel] : 0.f; }
              rowtok[idx] = tk; }
          asm volatile("s_waitcnt vmcnt(0)" ::: "memory");
          __syncthreads(); }
        MoeOrderG S; S.meta = mymeta; S.rowtok = rowtok; S.G = F.G; S.c = (int)blockIdx.x; S.A = (const char*)H1B8; S.B = (const char*)WupT; S.tb = (size_t)256 * 1024;
        EpiUp E{srs, HID};
        pg8::gemm_phase<EpiUp, MoeOrderG, true, true, false, true>(F.lds + RING_OFF, 512, S, E, 0x7f7a);
        if (rep == 0) {
            int tid = threadIdx.x; asm volatile("" : "+v"(tid)); const int lane = tid & 63;
            const int nrb = __builtin_amdgcn_readfirstlane(mymeta[0]); const int cb = (int)blockIdx.x;
            int T = nrb - 256; T = T < 0 ? 0 : (T > 32 ? 32 : T);
            const int r5 = (cb & 7) * 8 + (cb >> 5);
            if (r5 >= T) {
                const int nidle = (64 - T) * 4, me = (r5 - T) * 4 + ((cb >> 3) & 3);
                LAS float* scr = (LAS float*)(F.lds + wave * P0_SCR);
#pragma unroll 1
                for (int it = me + nidle * wave; it < I_E2; it += nidle * 8) {
                    const Tr64 t = expert_item(I_E1 + I_E3 + it, ew1, ew3, ew2, g_ffn, WupT, W2T);
                    f32x4 tv[16]; tr64_load(t, tv, lane); tr64_store(t, tv, scr, lane);
                }
            }
        }
    }
    xcd_barrier(bar);
    {
        MoeOrder S; S.meta = mymeta; S.G = F.G; S.c = (int)blockIdx.x; S.A = (const char*)HID; S.B = (const char*)W2T; S.ta = (size_t)256 * 512; S.tb = (size_t)256 * 512;
        EpiDown E{sdst, sgate, YB};
        pg8::gemm_phase<EpiDown, MoeOrder, true, false, false, true>(F.lds + RING_OFF, 256, S, E, 0x7d7b);
    }
    xcd_barrier(bar);
    }
#endif

#ifdef DBG_COPYSG
    for (int m = gw; m < M; m += NGW) { for (int j = 0; j < 16; ++j) HID[(size_t)m * 512 + ((lane + 64 * j) & 511)] = SG[(size_t)m * 2048 + DBG_COL0 + ((lane + 64 * j) & 511)]; }
    xcd_barrier(bar);
#endif
#ifdef DBG_BUF
    {
        for (int m = gw; m < M; m += NGW) {
            const bf16* src = DBG_BUF; const size_t ld = DBG_LD;
            float v[16];
#pragma unroll
            for (int j = 0; j < 16; ++j) v[j] = DBG_SCALE * bf2f(src[(size_t)(m % DBG_ROWS) * ld + ((lane + 64 * j) % ld)]);
            asm volatile("" ::: "memory");
#pragma unroll
            for (int j = 0; j < 16; ++j) out[(size_t)m * D + lane + 64 * j] = v[j];
        }
    }
#else
    for (int rep = 0; rep < REP_FIN; ++rep) {
        int tid = threadIdx.x; asm volatile("" : "+v"(tid)); const int lane = tid & 63; (void)lane;
        for (int m = gw; m < M; m += NGW) {
            f32x4 v[4]; float s = 0.f;
            { const v2u* hr = (const v2u*)(H1B + (size_t)m * D) + lane;
#pragma unroll
              for (int j = 0; j < 4; ++j) { const v2u a = hr[64 * j]; v[j][0] = bflo(a.x); v[j][1] = bfhi(a.x); v[j][2] = bflo(a.y); v[j][3] = bfhi(a.y); } }
#if PH_MAX >= 3
            const unsigned* y0 = (const unsigned*)(YB + (size_t)(2 * m) * D) + lane; const unsigned* y1 = (const unsigned*)(YB + (size_t)(2 * m + 1) * D) + lane;
#pragma unroll
            for (int j = 0; j < 4; ++j) { const int a = (int)y0[64 * j], b = (int)y1[64 * j];
                v[j][0] += (__builtin_amdgcn_cvt_f32_fp8(a, 0) + __builtin_amdgcn_cvt_f32_fp8(b, 0)) * 0.0625f; v[j][1] += (__builtin_amdgcn_cvt_f32_fp8(a, 1) + __builtin_amdgcn_cvt_f32_fp8(b, 1)) * 0.0625f;
                v[j][2] += (__builtin_amdgcn_cvt_f32_fp8(a, 2) + __builtin_amdgcn_cvt_f32_fp8(b, 2)) * 0.0625f; v[j][3] += (__builtin_amdgcn_cvt_f32_fp8(a, 3) + __builtin_amdgcn_cvt_f32_fp8(b, 3)) * 0.0625f; }
#endif
#pragma unroll
            for (int j = 0; j < 4; ++j) s += (v[j][0] * v[j][0] + v[j][1] * v[j][1]) + (v[j][2] * v[j][2] + v[j][3] * v[j][3]);
            const float rs = 1.0f / sqrtf(wave_sum(s, lane) * (1.0f / D) + RMS_EPS);
            f32x4* o = (f32x4*)(out + (size_t)m * D) + lane;
#pragma unroll
            for (int j = 0; j < 4; ++j) { const f32x4 g = *((const f32x4*)g_fin + lane + 64 * j); __builtin_nontemporal_store(v[j] * rs * g, &o[64 * j]); }
        }
    }
#endif
}

extern "C" void kernel_launch(void* const* d_in, const int* in_sizes, int n_in, void* d_out, int out_size, void* d_ws, size_t ws_size, hipStream_t stream) {
    static int grid = 0;
    if (grid == 0) {
        if (n_in != 26 || out_size != M * D || ws_size < WS_END) { fprintf(stderr, "kernel_launch: unexpected sizes n_in %d out %d ws %zu\n", n_in, out_size, ws_size); grid = -1; return; }
        int dev = 0, cus = 0, per_cu = 0;
        if (hipGetDevice(&dev) != hipSuccess || hipDeviceGetAttribute(&cus, hipDeviceAttributeMultiprocessorCount, dev) != hipSuccess) { grid = -1; return; }
        if (hipFuncSetAttribute((const void*)fwd_kernel, hipFuncAttributeMaxDynamicSharedMemorySize, LDS_BYTES) != hipSuccess) { fprintf(stderr, "kernel_launch: hipFuncSetAttribute failed\n"); grid = -1; return; }
        if (hipOccupancyMaxActiveBlocksPerMultiprocessor(&per_cu, (const void*)fwd_kernel, NWAVES * 64, LDS_BYTES) != hipSuccess || per_cu < 1)
            fprintf(stderr, "kernel_launch: occupancy query reports %d\n", per_cu);
        (void)hipGetLastError();
        grid = cus;
        if (grid != 256) fprintf(stderr, "kernel_launch: %d CUs (built for 256)\n", grid);
    }
    if (grid < 0) return;
    if (hipMemsetAsync((char*)d_ws + WS_CTL, 0, CTL_ZERO_BYTES, stream) != hipSuccess) return;
    Args a{};
    for (int i = 0; i < 26; ++i) a.in[i] = (const float*)d_in[i];
    a.out = (float*)d_out; a.ws = (unsigned char*)d_ws;
    hipLaunchKernelGGL(fwd_kernel, dim3(grid), dim3(NWAVES * 64), LDS_BYTES, stream, a);
}
```

```cpp
#include <hip/hip_runtime.h>
#include <cstdio>
#include <cstdint>

#ifndef REP_P0
#define REP_P0 1
#endif
#ifndef WGM_P1
#define WGM_P1 2
#endif
#ifndef WGM_GLU
#define WGM_GLU 4
#endif
#ifndef WGM_MRG
#define WGM_MRG 4
#endif
#ifndef WGM_WO
#define WGM_WO 4
#endif
#ifndef REP_P0S
#define REP_P0S 1
#endif
#ifndef REP_P1
#define REP_P1 1
#endif
#ifndef REP_SSM
#define REP_SSM 1
#endif
#ifndef REP_ATT
#define REP_ATT 1
#endif
#ifndef REP_MIX
#define REP_MIX 1
#endif
#ifndef REP_RT
#define REP_RT 1
#endif
#ifndef REP_MOE
#define REP_MOE 1
#endif
#ifndef REP_FIN
#define REP_FIN 1
#endif
#ifndef PH_MAX
#define PH_MAX 3
#endif

#define GAS __attribute__((address_space(1)))
#define LAS __attribute__((address_space(3)))
typedef unsigned short bf16;
typedef unsigned v4u __attribute__((ext_vector_type(4)));
typedef unsigned v2u __attribute__((ext_vector_type(2)));
typedef float f32x2 __attribute__((ext_vector_type(2)));
typedef float f32x4 __attribute__((ext_vector_type(4)));
typedef float f32x16 __attribute__((ext_vector_type(16)));
typedef short bf16x8 __attribute__((ext_vector_type(8)));
typedef GAS unsigned gu32;

constexpr int D = 1024, NB = 4, SEQ = 8192, M = NB * SEQ, NMETA = 16;
constexpr int ATW = 512, NH = 8, HD = 64, SW = 512, NG = 32, GC = 16, NP = 64, INC = 4096;
constexpr int NE = 32, FF = 512;
constexpr int LPB = 8224;
constexpr int KT_ROWS = 66;
constexpr int MAXRB = 288;
constexpr float RMS_EPS = 1e-6f;
constexpr float QSCALE = 0.125f * 1.4426950408889634f;

constexpr size_t MiB = 1u << 20;
constexpr size_t WS_CTL = 0, CTL_ZERO_BYTES = 1 * MiB;
constexpr size_t WS_SMALL = 1 * MiB;
constexpr size_t SM_RSTD1 = WS_SMALL;
constexpr size_t SM_RSTD2 = SM_RSTD1 + 128 * 1024;
constexpr size_t SM_EID = SM_RSTD2 + 128 * 1024;
constexpr size_t SM_GATE = SM_EID + 256 * 1024;
constexpr size_t SM_CNT = SM_GATE + 256 * 1024;
constexpr size_t SM_UMETA = SM_CNT + 32 * 1024;
constexpr size_t SM_BBAR = SM_UMETA + 32 * 1024;
constexpr size_t SM_LBAR = SM_BBAR + 256 * 1024;
constexpr size_t SM_L64 = SM_LBAR + 16 * 1024;
constexpr size_t SM_SDST = SM_L64 + 16 * 1024;
constexpr size_t SM_SGATE = SM_SDST + 288 * 1024;
constexpr size_t SM_SRS = SM_SGATE + 288 * 1024;
constexpr size_t SM_WR = SM_SRS + 288 * 1024;
constexpr size_t SM_RB = SM_WR + 256 * 1024;
constexpr size_t SM_MOEMETA = SM_RB + 1024;
constexpr size_t SM_METAP = SM_MOEMETA + 4096;
constexpr size_t SM_SSQP = 4 * MiB;
static_assert(SM_METAP + 8 * 16 * 1536 * 4 <= SM_SSQP, "small map");
constexpr size_t WS_WIN = 6 * MiB;
constexpr size_t WS_WPAB = 14 * MiB;
constexpr size_t WS_WO = 16 * MiB;
constexpr size_t WS_GLU = 18 * MiB;
constexpr size_t WS_KT = 19 * MiB;
constexpr size_t WS_T2 = 21 * MiB;
constexpr size_t WS_T3 = 29 * MiB;
constexpr size_t WS_WUP = 37 * MiB;
constexpr size_t WS_W2 = 101 * MiB;
constexpr size_t WS_XB = 133 * MiB;
constexpr size_t WS_Y = 133 * MiB;
constexpr size_t WS_S = 165 * MiB;
constexpr size_t WS_XS = 173 * MiB;
constexpr size_t WS_Q = 197 * MiB;
constexpr size_t WS_SSM = 229 * MiB;
constexpr size_t WS_K = 261 * MiB;
constexpr size_t WS_VT = 295 * MiB;
constexpr size_t WS_UG = 329 * MiB;
constexpr size_t WS_SG = 361 * MiB;
constexpr size_t WS_H1B = 361 * MiB;
constexpr size_t WS_H1B8 = 425 * MiB;
constexpr size_t WS_HID = 277 * MiB;
constexpr size_t WS_YB = 133 * MiB;
constexpr size_t WS_INV = 489 * MiB;
constexpr size_t WS_MWG = 502 * MiB;
constexpr size_t WS_END = 503 * MiB;
constexpr int CAPE = 32768;
constexpr int CW_TOT = 8192;

constexpr int CW_BAR = 4096;

constexpr int RING_OFF = 0, RING_BYTES = 131072;
constexpr int P0_SCR = 16896;
constexpr int LDSCTL_OFF = 8 * P0_SCR, MISC_OFF = LDSCTL_OFF + 320;
static_assert(LDSCTL_OFF >= RING_BYTES, "lds map");
constexpr int LDS_BYTES = 147456;
constexpr int ROWTOK_OFF = 8 * 16896 + 512;
static_assert(ROWTOK_OFF + 5 * 256 * 4 <= LDS_BYTES, "lds map");
constexpr int NWAVES = 8;

#define LDS_WAIT() asm volatile("s_waitcnt lgkmcnt(0)" ::: "memory")
#define VM_WAIT() asm volatile("s_waitcnt vmcnt(0)" ::: "memory")

typedef __bf16 bf16x2_t __attribute__((ext_vector_type(2)));
__device__ __forceinline__ unsigned cvt_pk_bf16(float lo, float hi) { bf16x2_t v; v[0] = (__bf16)lo; v[1] = (__bf16)hi; return __builtin_bit_cast(unsigned, v); }
__device__ __forceinline__ float bf2f(unsigned short b) { return __builtin_bit_cast(float, (unsigned)b << 16); }
__device__ __forceinline__ float bflo(unsigned w) { return __builtin_bit_cast(float, w << 16); }
__device__ __forceinline__ float bfhi(unsigned w) { return __builtin_bit_cast(float, w & 0xffff0000u); }
__device__ __forceinline__ float fast_sigmoid(float x) { return __builtin_amdgcn_rcpf(1.0f + __expf(-x)); }
__device__ __forceinline__ float shx(float v, int k, int lane) { return __builtin_bit_cast(float, __builtin_amdgcn_ds_bpermute((lane ^ k) << 2, __builtin_bit_cast(int, v))); }
__device__ __forceinline__ float wave_sum(float v, int lane) {
#pragma unroll
    for (int o = 1; o < 64; o <<= 1) v += shx(v, o, lane);
    return v;
}

#define XB_TMO      128
#define XB_XCNT(j)  (256  + 64 * (j))
#define XB_XSUB(j)  (1280 + 64 * (j))
#define XB_XGEN(j)  (2304 + 64 * (j))
#define XB_TOP      3328
#define XB_TOPGEN   3392
#define XCD_BAR_WORDS 3456
#define XB_SPIN_CAP (1u << 18)
__device__ __forceinline__ unsigned xb_ld(unsigned* p)              { return __hip_atomic_load(p, __ATOMIC_RELAXED, __HIP_MEMORY_SCOPE_AGENT); }
__device__ __forceinline__ unsigned xb_add(unsigned* p, unsigned v) { return __hip_atomic_fetch_add(p, v, __ATOMIC_RELAXED, __HIP_MEMORY_SCOPE_AGENT); }
__device__ __forceinline__ unsigned xb_xcc_id() { return (unsigned)__builtin_amdgcn_s_getreg((3 << 11) | 20) & 0xFu; }
#define XB_SPIN(cond, bar) do { unsigned _sp = 0; while (cond) { __builtin_amdgcn_s_sleep(1); \
    if ((++_sp & 255u) == 0u) { if (xb_ld(&(bar)[XB_TMO])) break; if (_sp > XB_SPIN_CAP) { atomicAdd(&(bar)[XB_TMO], 1u); break; } } } } while (0)
struct XcdBarrier { unsigned* bar; unsigned x; volatile LAS unsigned* st; };
__device__ __forceinline__ XcdBarrier xcd_barrier_post(unsigned* bar, volatile LAS unsigned* st) {
    XcdBarrier b; b.bar = bar; b.x = (unsigned)__builtin_amdgcn_readfirstlane((int)xb_xcc_id()); b.st = st;
    if (threadIdx.x == 0) (void)xb_add(&bar[XB_XCNT(b.x)], 1u);
    return b;
}
__device__ __forceinline__ void xcd_barrier_complete(unsigned* bar, unsigned x, unsigned& nloc, unsigned& nx) {
    const unsigned G = gridDim.x * gridDim.y * gridDim.z;
    unsigned sum, cnt, mine, sp = 0u;
    for (;;) {
        sum = 0u; cnt = 0u; mine = 0u;
#pragma unroll
        for (unsigned j = 0; j < 16; ++j) { const unsigned c = xb_ld(&bar[XB_XCNT(j)]); sum += c; cnt += (c > 0u) ? 1u : 0u; mine = (j == x) ? c : mine; }
        if (sum == G) break;
        __builtin_amdgcn_s_sleep(1);
        if ((++sp & 255u) == 0u) { if (xb_ld(&bar[XB_TMO])) break; if (sp > XB_SPIN_CAP) { atomicAdd(&bar[XB_TMO], 1u); break; } }
    }
    nloc = mine > 0u ? mine : 1u; nx = cnt > 0u ? cnt : 1u;
}
__device__ __forceinline__ void xcd_barrier(const XcdBarrier& b) {
    asm volatile("s_waitcnt vmcnt(0)" ::: "memory");
    __syncthreads();
    if (threadIdx.x == 0) {
        unsigned* bar = b.bar; asm volatile("" : "+s"(bar));
        __builtin_amdgcn_s_waitcnt(0);
        unsigned bx = b.x; asm volatile("" : "+s"(bx));
        const unsigned osub = (unsigned)__builtin_amdgcn_readfirstlane((int)XB_XSUB(bx)), ogen = (unsigned)__builtin_amdgcn_readfirstlane((int)XB_XGEN(bx));
        unsigned nloc = b.st[0], nx = b.st[1];
        if (nloc == 0u) { xcd_barrier_complete(bar, bx, nloc, nx); b.st[0] = nloc; b.st[1] = nx; }
        const unsigned old = xb_add(&bar[osub], 1u);
        const unsigned gen = old / nloc;
        if (old + 1u == (gen + 1u) * nloc) {
            __builtin_amdgcn_fence(__ATOMIC_RELEASE, "agent");
            asm volatile("s_waitcnt vmcnt(0)" ::: "memory");
            const unsigned og = xb_add(&bar[XB_TOP], 1u);
            const unsigned tg = og / nx;
            if (og + 1u == (tg + 1u) * nx) xb_add(&bar[XB_TOPGEN], 1u);
            else XB_SPIN(xb_ld(&bar[XB_TOPGEN]) == tg, bar);
            __builtin_amdgcn_fence(__ATOMIC_ACQUIRE, "agent");
            xb_add(&bar[ogen], 1u);
            asm volatile("s_waitcnt vmcnt(0)" ::: "memory");
        } else {
            XB_SPIN(xb_ld(&bar[ogen]) == gen, bar);
            __builtin_amdgcn_fence(__ATOMIC_ACQUIRE, "agent");
            asm volatile("s_waitcnt vmcnt(0)" ::: "memory");
        }
    }
    __syncthreads();
}

namespace pg8 {
typedef int pg8_v4i __attribute__((ext_vector_type(4)));
typedef int pg8_v8i __attribute__((ext_vector_type(8)));
constexpr int BM = 256, BK = 64, HALF = 128, HTB = HALF * BK * 2, STAGE_BYTES = 8 * HTB, NXCD = 8, WGM = 4;
__host__ __device__ __forceinline__ int lds_byte(int r, int c) { const int st = (r >> 4) * 2 + (c >> 5), rr = r & 15, cc = c & 31, ob = rr * 64 + cc * 2; return st * 1024 + (ob ^ (((ob >> 9) & 1) << 5)); }
__host__ __device__ __forceinline__ void stage_rc(int b, int& R, int& C) { const int st = b / 1024, sb = b % 1024, swz = sb ^ (((sb >> 9) & 1) << 5); R = (st >> 1) * 16 + swz / 64; C = (st & 1) * 32 + (swz % 64) / 2; }
__host__ __device__ __forceinline__ int perm32(int rho) { const int n = rho >> 4, i = rho & 15; return 8 * (i >> 2) + 4 * n + (i & 3); }
struct Unit { int pm, pn, hs; };
struct StaticOrder {
    int nM, nN, nwg, G, c, wgm;
    __host__ __device__ void init(int nM_, int nN_, int G_, int c_, int wgm_ = WGM) { nM = nM_; nN = nN_; nwg = nM * nN; G = G_; c = c_; wgm = wgm_; }
    __host__ __device__ bool next(int i, Unit& u) const {
        const long L = (long)i * G + c; if (L >= nwg) return false;
        int wgid = (int)L; { const int q = nwg / NXCD, r = nwg % NXCD, xcd = wgid % NXCD, off = wgid / NXCD; wgid = (xcd < r ? xcd * (q + 1) : r * (q + 1) + (xcd - r) * q) + off; }
        const int nig = wgm * nN, gid = wgid / nig, fm = gid * wgm, gsz = (nM - fm) < wgm ? (nM - fm) : wgm;
        u.pm = fm + ((wgid % nig) % gsz); u.pn = (wgid % nig) / gsz; u.hs = 0; return true;
    }
};
template <class Epi, class Sched, bool ALIGN_EPI, bool GATHER = false, bool KS = false, bool F8 = false>
__device__ __forceinline__ void gemm_phase(LAS unsigned char* lds, const int K, const Sched& S, const Epi& E, const int sc_wa = 0x7f7f) {
    int tid = threadIdx.x; asm volatile("" : "+v"(tid));
    const int wid = __builtin_amdgcn_readfirstlane(tid >> 6), lane = tid & 63, wr = wid >> 2, wc = wid & 3, fr = lane & 15, fq = lane >> 4;
    const int nt = KS ? 16 : K / BK;
    unsigned voffA[2], voffB[2]; int Rr[2], Cc[2];
#pragma unroll
    for (int i = 0; i < 2; ++i) { int R, C; stage_rc(tid * 16 + i * 8192, R, C); const int Rb = Epi::PERM ? ((R & ~31) + perm32(R & 31)) : R; Rr[i] = R; Cc[i] = C;
        voffA[i] = (unsigned)(R * K + C) * 2u; voffB[i] = (unsigned)(Rb * K + C) * 2u; }
    unsigned gA[2][2], gAn[2][2];
#pragma unroll
    for (int h2 = 0; h2 < 2; ++h2) { gA[h2][0] = gA[h2][1] = gAn[h2][0] = gAn[h2][1] = 0u; }
    const size_t kstep = (size_t)(BK * 2);
    const size_t hstep = (size_t)HALF * K * 2;
    const unsigned ldsw = (unsigned)wid * 1024u;
    const int aoff = lds_byte(wr * 64 + fr, fq * 8), boff = lds_byte(wc * 32 + fr, fq * 8);
#define PG8_SA(b, h) (((b) * 2 + (h)) * HTB)
#define PG8_SB(b, h) ((4 + (b) * 2 + (h)) * HTB)
#define PG8_STAGE(bufoff, gbase, voff) do { _Pragma("unroll") for (int _i = 0; _i < 2; ++_i) \
        __builtin_amdgcn_global_load_lds((const unsigned*)((const char*)(gbase) + (voff)[_i]), (LAS unsigned*)(lds + (bufoff) + ldsw + _i * 8192), 16, 0, 0); } while (0)
#define PG8_LD8(dst8, addr) do { const pg8_v4i lo_ = *(const LAS pg8_v4i*)(addr), hi_ = *(const LAS pg8_v4i*)((addr) + 1024); dst8 = __builtin_shufflevector(lo_, hi_, 0, 1, 2, 3, 4, 5, 6, 7); } while (0)
#define PG8_LDA(dst, b, h) do { if constexpr (F8) { _Pragma("unroll") for (int m = 0; m < 4; ++m) PG8_LD8(dst##8[m], lds + PG8_SA(b, h) + aoff + m * 2048); } \
        else { _Pragma("unroll") for (int m = 0; m < 4; ++m) _Pragma("unroll") for (int k = 0; k < 2; ++k) dst[m][k] = *(const LAS bf16x8*)(lds + PG8_SA(b, h) + aoff + m * 2048 + k * 1024); } } while (0)
#define PG8_LDB(dst, b, h) do { if constexpr (F8) { _Pragma("unroll") for (int n = 0; n < 2; ++n) PG8_LD8(dst##8[n], lds + PG8_SB(b, h) + boff + n * 2048); } \
        else { _Pragma("unroll") for (int n = 0; n < 2; ++n) _Pragma("unroll") for (int k = 0; k < 2; ++k) dst[n][k] = *(const LAS bf16x8*)(lds + PG8_SB(b, h) + boff + n * 2048 + k * 1024); } } while (0)
#define PG8_MMA(ai, bj, At, Bt) do { __builtin_amdgcn_s_setprio(1); _Pragma("unroll") for (int m = 0; m < 4; ++m) _Pragma("unroll") for (int n = 0; n < 2; ++n) { \
        if constexpr (F8) { acc[ai][bj][m][n] = __builtin_amdgcn_mfma_scale_f32_16x16x128_f8f6f4(Bt##8[n], At##8[m], acc[ai][bj][m][n], 0, 0, 0, sc_wa, 1, sc_wa); } \
        else { _Pragma("unroll") for (int k = 0; k < 2; ++k) acc[ai][bj][m][n] = __builtin_amdgcn_mfma_f32_16x16x32_bf16(Bt[n][k], At[m][k], acc[ai][bj][m][n], 0, 0, 0); } } \
        if constexpr (F8) asm volatile("" : "+v"(acc[ai][bj][0][0]), "+v"(acc[ai][bj][0][1]), "+v"(acc[ai][bj][1][0]), "+v"(acc[ai][bj][1][1]), "+v"(acc[ai][bj][2][0]), "+v"(acc[ai][bj][2][1]), "+v"(acc[ai][bj][3][0]), "+v"(acc[ai][bj][3][1]));   \
        __builtin_amdgcn_s_setprio(0); } while (0)
#define PG8_WAIT_V(n) asm volatile("s_waitcnt vmcnt(" #n ")" ::: "memory")
#define PG8_WAIT_L(n) asm volatile("s_waitcnt lgkmcnt(" #n ")" ::: "memory")
#define PG8_BAR __builtin_amdgcn_s_barrier()
#define PG8_SCHED __builtin_amdgcn_sched_barrier(0)
    Unit cur, nxt; int ui = 0;
    if (!S.next(0, cur)) return;
    f32x4 acc[2][2][4][2];
#pragma unroll
    for (int a = 0; a < 2; ++a)
#pragma unroll
        for (int b = 0; b < 2; ++b)
#pragma unroll
            for (int m = 0; m < 4; ++m)
#pragma unroll
                for (int n = 0; n < 2; ++n) acc[a][b][m][n] = (f32x4){0.f, 0.f, 0.f, 0.f};
    if constexpr (F8) {
#pragma unroll
        for (int a = 0; a < 2; ++a)
#pragma unroll
            for (int b = 0; b < 2; ++b)
#pragma unroll
                for (int m = 0; m < 4; ++m)
#pragma unroll
                    for (int n = 0; n < 2; ++n) asm volatile("" : "+v"(acc[a][b][m][n]));
    }
    bf16x8 At[4][2], B0[2][2], B1[2][2];
    pg8_v8i At8[4], B08[2], B18[2];
    const char* cA = S.aptr(cur); const char* cB = S.bptr(cur);
    if constexpr (GATHER) { S.gather(cur, Rr, Cc, K, gA); }
#define PG8_STAGE_A(bufoff, h, ko, usenext) PG8_STAGE_A2(bufoff, h, cA, ko, usenext)
#define PG8_STAGE_A2(bufoff, h, cur_base, ko, usenext) do { if constexpr (GATHER) { unsigned _v[2] = { (usenext) ? gAn[h][0] : gA[h][0], (usenext) ? gAn[h][1] : gA[h][1] }; PG8_STAGE(bufoff, cA + (ko), _v); } \
        else { PG8_STAGE(bufoff, ((usenext) ? nA : (cur_base)) + (size_t)(h) * hstep + (ko), voffA); } } while (0)
    { const char* nA = cA; (void)nA;
    PG8_STAGE(PG8_SB(0, 0), cB, voffB); PG8_STAGE(PG8_SB(0, 1), cB + hstep, voffB); PG8_STAGE_A(PG8_SA(0, 0), 0, 0, false); PG8_STAGE_A(PG8_SA(0, 1), 1, 0, false);
    if (wr == 1) PG8_BAR;
    PG8_WAIT_V(2); PG8_BAR;
    PG8_STAGE(PG8_SB(1, 0), cB + kstep, voffB); PG8_STAGE_A(PG8_SA(1, 0), 0, kstep, false); PG8_STAGE(PG8_SB(1, 1), cB + hstep + kstep, voffB);
    PG8_WAIT_V(6); PG8_BAR; }
    for (;;) {
        { int tid2 = threadIdx.x; asm volatile("" : "+v"(tid2));
#pragma unroll
          for (int i = 0; i < 2; ++i) { int R, C; stage_rc(tid2 * 16 + i * 8192, R, C); const int Rb = Epi::PERM ? ((R & ~31) + perm32(R & 31)) : R;
              voffA[i] = (unsigned)(R * K + C) * 2u; voffB[i] = (unsigned)(Rb * K + C) * 2u; } }
        const bool has_next = S.next(ui + 1, nxt);
        const char* nA = has_next ? S.aptr(nxt) : cA; const char* nB = has_next ? S.bptr(nxt) : cB;
        const char* dA = cA; const char* dB = cB; if constexpr (KS) { dA = S.aptr2(cur); dB = S.bptr2(cur); }
        if constexpr (GATHER) { if (has_next) S.gather(nxt, Rr, Cc, K, gAn); else {
#pragma unroll
            for (int h2 = 0; h2 < 2; ++h2) { gAn[h2][0] = gA[h2][0]; gAn[h2][1] = gA[h2][1]; } } }
#pragma unroll 1
        for (int t = 0; t < nt; t += 2) {
            const bool last = (t == nt - 2);
            const char* pa1 = (KS && t >= 8) ? dA : cA; const char* pa2 = (KS && t >= 6) ? dA : cA; const char* pb2 = (KS && t >= 6) ? dB : cB;
            const size_t ko1 = KS ? (size_t)((t + 1) & 7) * kstep : (size_t)(t + 1) * kstep;
            const size_t ko2 = last ? (size_t)0 : (KS ? (size_t)((t + 2) & 7) * kstep : (size_t)(t + 2) * kstep), ko3 = ko2 + kstep;
            const char* b2 = last ? nB : pb2 + ko2; const char* b3 = b2 + kstep;
            PG8_LDB(B0, 0, 0); PG8_LDB(B1, 0, 1); PG8_SCHED; PG8_LDA(At, 0, 0); PG8_STAGE_A2(PG8_SA(1, 1), 1, pa1, ko1, false);
            PG8_WAIT_V(8); PG8_WAIT_L(0); PG8_BAR; if (!Sched::HALFU || cur.hs != 2) { PG8_MMA(0, 0, At, B0); PG8_MMA(0, 1, At, B1); } PG8_BAR; PG8_SCHED;
            PG8_LDA(At, 0, 1); PG8_STAGE(PG8_SB(0, 0), b2, voffB); PG8_STAGE(PG8_SB(0, 1), b2 + hstep, voffB); PG8_STAGE_A2(PG8_SA(0, 0), 0, pa2, ko2, last);
            PG8_WAIT_V(8); PG8_WAIT_L(0); PG8_BAR; if (!Sched::HALFU || cur.hs != 1) { PG8_MMA(1, 0, At, B0); PG8_MMA(1, 1, At, B1); } PG8_BAR; PG8_SCHED;
            PG8_LDB(B0, 1, 0); PG8_LDB(B1, 1, 1); PG8_SCHED; PG8_LDA(At, 1, 0); PG8_STAGE_A2(PG8_SA(0, 1), 1, pa2, ko2, last);
            PG8_WAIT_V(8); PG8_WAIT_L(0); PG8_BAR; if (!Sched::HALFU || cur.hs != 2) { PG8_MMA(0, 0, At, B0); PG8_MMA(0, 1, At, B1); } PG8_BAR; PG8_SCHED;
            PG8_LDA(At, 1, 1); PG8_STAGE(PG8_SB(1, 0), b3, voffB); PG8_STAGE(PG8_SB(1, 1), b3 + hstep, voffB); PG8_STAGE_A2(PG8_SA(1, 0), 0, pa2, ko3, last);
            PG8_WAIT_V(8); PG8_WAIT_L(0); PG8_BAR; if (!Sched::HALFU || cur.hs != 1) { PG8_MMA(1, 0, At, B0); PG8_MMA(1, 1, At, B1); } PG8_BAR; PG8_SCHED;
            if constexpr (KS) { if (t == 6) { int efr = fr, efq = fq; asm volatile("" : "+v"(efr), "+v"(efq)); E.mid(acc, cur, wr, wc, efr, efq); } }
        }
        if constexpr (ALIGN_EPI) { if (wr == 0) PG8_BAR; }
        { int efr = fr, efq = fq; asm volatile("" : "+v"(efr), "+v"(efq));
          E(acc, cur, wr, wc, efr, efq); }
        if (!has_next) break;
#pragma unroll
        for (int a = 0; a < 2; ++a)
#pragma unroll
            for (int b = 0; b < 2; ++b)
#pragma unroll
                for (int m = 0; m < 4; ++m)
#pragma unroll
                    for (int n = 0; n < 2; ++n) { acc[a][b][m][n] = (f32x4){0.f, 0.f, 0.f, 0.f}; if constexpr (F8) asm volatile("" : "+v"(acc[a][b][m][n])); }
        cur = nxt; cA = nA; cB = nB; ++ui;
        if constexpr (GATHER) {
#pragma unroll
            for (int h2 = 0; h2 < 2; ++h2) { gA[h2][0] = gAn[h2][0]; gA[h2][1] = gAn[h2][1]; } }
        if constexpr (ALIGN_EPI) { if (wr == 1) PG8_BAR; }
    }
    PG8_WAIT_V(0);
    if constexpr (!ALIGN_EPI) { if (wr == 0) PG8_BAR; }
    PG8_BAR;
#undef PG8_SA
#undef PG8_SB
#undef PG8_STAGE
#undef PG8_STAGE_A
#undef PG8_STAGE_A2
#undef PG8_LDA
#undef PG8_LD8
#undef PG8_LDB
#undef PG8_MMA
#undef PG8_WAIT_V
#undef PG8_WAIT_L
#undef PG8_BAR
#undef PG8_SCHED
}
}
using pg8::Unit;

struct Args { const float* in[26]; float* out; unsigned char* ws; };
struct Frame {
    LAS unsigned char* lds;
    volatile LAS unsigned* MISC;
    int tid, lane, wave, vcu, G;
};

struct GOrder {
    static constexpr bool HALFU = false;
    pg8::StaticOrder so; const char* A; const char* B; size_t ta, tb;
    __device__ __forceinline__ bool next(int i, Unit& u) const { return so.next(i, u); }
    __device__ __forceinline__ const char* aptr(const Unit& u) const { return A + (size_t)u.pm * ta; }
    __device__ __forceinline__ const char* bptr(const Unit& u) const { return B + (size_t)u.pn * tb; }
};
struct P1Order {
    static constexpr bool HALFU = false;
    pg8::StaticOrder so; const char* X; const char* W; size_t t;
    __device__ __forceinline__ bool next(int i, Unit& u) const { return so.next(i, u); }
    __device__ __forceinline__ const char* aptr(const Unit& u) const { return (u.pn == 4 || u.pn == 5) ? W + (size_t)u.pn * t : X + (size_t)u.pm * t; }
    __device__ __forceinline__ const char* bptr(const Unit& u) const { return (u.pn == 4 || u.pn == 5) ? X + (size_t)u.pm * t : W + (size_t)u.pn * t; }
};
struct MergeOrder {
    static constexpr bool HALFU = false;
    pg8::StaticOrder so; const char* A; const char* B; size_t ta, tb;
    __device__ __forceinline__ bool next(int i, Unit& u) const { return so.next(i, u); }
    __device__ __forceinline__ const char* aptr(const Unit& u) const { return A + (size_t)u.pm * ta; }
    __device__ __forceinline__ const char* aptr2(const Unit& u) const { return A + (size_t)(u.pm + 128) * ta; }
    __device__ __forceinline__ const char* bptr(const Unit& u) const { return B + (size_t)u.pn * tb; }
    __device__ __forceinline__ const char* bptr2(const Unit& u) const { return B + (size_t)(u.pn + 4) * tb; }
};
struct MoeOrder {
    static constexpr bool HALFU = true;
    const int* meta; int G, c; const char* A; const char* B; size_t ta, tb;
    __device__ __forceinline__ bool next(int i, Unit& u) const {
        const int nrb = __builtin_amdgcn_readfirstlane(meta[0]);
        if (i < 4) { const int rb = i * 64 + (c & 7) * 8 + (c >> 5); const int e = __builtin_amdgcn_readfirstlane(meta[16 + rb]); u.pm = rb; u.pn = e * 4 + ((c >> 3) & 3); u.hs = 0; return true; }
        if (i > 4) return false;
        const int rb = 256 + (c & 7) + 8 * (c >> 6), sub = (c >> 3) & 7;
        if (rb >= nrb) return false;
        const int e = __builtin_amdgcn_readfirstlane(meta[16 + rb]);
        u.pm = rb; u.pn = e * 4 + (sub >> 1); u.hs = 1 + (sub & 1); return true;
    }
    __device__ __forceinline__ const char* aptr(const Unit& u) const { return A + (size_t)u.pm * ta; }
    __device__ __forceinline__ const char* bptr(const Unit& u) const { return B + (size_t)u.pn * tb; }
};

struct MoeOrderG {
    static constexpr bool HALFU = true;
    const int* meta; const LAS int* rowtok; int G, c; const char* A; const char* B; size_t tb;
    __device__ __forceinline__ bool next(int i, Unit& u) const {
        const int nrb = __builtin_amdgcn_readfirstlane(meta[0]);
        if (i < 4) { const int rb = i * 64 + (c & 7) * 8 + (c >> 5); const int e = __builtin_amdgcn_readfirstlane(meta[16 + rb]); u.pm = rb; u.pn = e * 4 + ((c >> 3) & 3); u.hs = 0; return true; }
        if (i > 4) return false;
        const int rb = 256 + (c & 7) + 8 * (c >> 6), sub = (c >> 3) & 7;
        if (rb >= nrb) return false;
        const int e = __builtin_amdgcn_readfirstlane(meta[16 + rb]);
        u.pm = rb; u.pn = e * 4 + (sub >> 1); u.hs = 1 + (sub & 1); return true;
    }
    __device__ __forceinline__ const char* aptr(const Unit&) const { return A; }
    __device__ __forceinline__ const char* bptr(const Unit& u) const { return B + (size_t)u.pn * tb; }
    __device__ __forceinline__ void gather(const Unit& u, const int (&Rr)[2], const int (&Cc)[2], int K, unsigned (&v)[2][2]) const {
        const LAS int* t = rowtok + (u.pm >> 6) * 256;
#pragma unroll
        for (int h = 0; h < 2; ++h)
#pragma unroll
            for (int i = 0; i < 2; ++i) v[h][i] = ((unsigned)t[h * 128 + Rr[i]] * (unsigned)K + (unsigned)Cc[i]) * 2u;
    }
};

#define EPI_ARGS const f32x4 (&acc)[2][2][4][2], const Unit& u, int wr, int wc, int fr, int fq
__device__ __forceinline__ v4u pack8(f32x4 a, f32x4 b) { v4u w; w.x = cvt_pk_bf16(a[0], a[1]); w.y = cvt_pk_bf16(a[2], a[3]); w.z = cvt_pk_bf16(b[0], b[1]); w.w = cvt_pk_bf16(b[2], b[3]); return w; }

struct EpiIn {
    static constexpr bool PERM = true;
    bf16 *Q, *Kb, *VT, *UG; unsigned char* SG; const float* rstd;
    __device__ __forceinline__ void operator()(EPI_ARGS) const {
        const int pn = u.pn;
        if (pn == 4 || pn == 5) {
            f32x4 rsa[2][2];
#pragma unroll
            for (int bj = 0; bj < 2; ++bj) { const int t0 = u.pm * 256 + bj * 128 + wc * 32 + 8 * fq; rsa[bj][0] = *(const f32x4*)(rstd + t0); rsa[bj][1] = *(const f32x4*)(rstd + t0 + 4); }
            asm volatile("" : "+v"(rsa[0][0]), "+v"(rsa[0][1]), "+v"(rsa[1][0]), "+v"(rsa[1][1]));
#pragma unroll
            for (int bj = 0; bj < 2; ++bj) {
                const int t0 = u.pm * 256 + bj * 128 + wc * 32 + 8 * fq; const int b = t0 >> 13, i0 = t0 & 8191;
                const f32x4 rs0 = rsa[bj][0], rs1 = rsa[bj][1];
#pragma unroll
                for (int ai = 0; ai < 2; ++ai)
#pragma unroll
                    for (int m = 0; m < 4; ++m) {
                        const int vr = (pn - 4) * 256 + ai * 128 + wr * 64 + m * 16 + fr;
                        bf16* dst = VT + ((size_t)(b * 512 + vr)) * LPB + 32 + i0;
                        *(v4u*)dst = pack8(acc[ai][bj][m][0] * rs0, acc[ai][bj][m][1] * rs1);
                    }
            }
        } else {
            float rsv[2][4];
#pragma unroll
            for (int ai = 0; ai < 2; ++ai)
#pragma unroll
                for (int m = 0; m < 4; ++m) rsv[ai][m] = rstd[u.pm * 256 + ai * 128 + wr * 64 + m * 16 + fr];
            asm volatile("" : "+v"(rsv[0][0]), "+v"(rsv[0][1]), "+v"(rsv[0][2]), "+v"(rsv[0][3]), "+v"(rsv[1][0]), "+v"(rsv[1][1]), "+v"(rsv[1][2]), "+v"(rsv[1][3]));
#pragma unroll
            for (int ai = 0; ai < 2; ++ai)
#pragma unroll
                for (int m = 0; m < 4; ++m) {
                    const int row = u.pm * 256 + ai * 128 + wr * 64 + m * 16 + fr; const float rs = rsv[ai][m];
#pragma unroll
                    for (int bj = 0; bj < 2; ++bj) {
                        const int col0 = pn * 256 + bj * 128 + wc * 32 + 8 * fq;
                        f32x4 v0 = acc[ai][bj][m][0] * rs, v1 = acc[ai][bj][m][1] * rs;
                        if (pn < 2) { *(v4u*)(Q + (size_t)row * 512 + col0) = pack8(v0 * QSCALE, v1 * QSCALE); }
                        else if (pn < 4) { const int b = row >> 13, i = row & 8191; *(v4u*)(Kb + ((size_t)(b * LPB + 32 + i)) * 512 + (col0 - 512)) = pack8(v0, v1); }
                        else if (pn < 8) { const int c = col0 - 1536; const int mrow = row >> 6;
                            *(v4u*)(UG + ((((size_t)((c >> 4) * 16 + (mrow >> 5)) * 64 + (row & 63)) * 2 + ((c & 15) >> 3)) * 32 + (mrow & 31)) * 8) = pack8(v0, v1); }
                        else {
                            unsigned g0 = 0u, g1 = 0u;
#pragma unroll
                            for (int e = 0; e < 4; ++e) { g0 = __builtin_amdgcn_cvt_pk_u8_f32(floorf(fast_sigmoid(v0[e]) * 256.0f), e, g0); g1 = __builtin_amdgcn_cvt_pk_u8_f32(floorf(fast_sigmoid(v1[e]) * 256.0f), e, g1); }
                            *(v2u*)(SG + (size_t)row * 2048 + (col0 - 2048)) = (v2u){g0, g1};
                        }
                    }
                }
        }
    }
};

struct EpiGlu {
    static constexpr bool PERM = true;
    const bf16* Y; bf16* O; const float* bias;
    __device__ __forceinline__ void operator()(EPI_ARGS) const {
#pragma unroll
        for (int bj = 0; bj < 2; ++bj) {
            const int col0 = u.pn * 256 + bj * 128 + wc * 32 + 8 * fq;
            const f32x4 b0 = *(const f32x4*)(bias + col0), b1 = *(const f32x4*)(bias + col0 + 4);
#pragma unroll
            for (int ai = 0; ai < 2; ++ai)
#pragma unroll
                for (int m = 0; m < 4; ++m) {
                    const int row = u.pm * 256 + ai * 128 + wr * 64 + m * 16 + fr;
                    const v4u yv = *(const v4u*)(Y + (size_t)row * 512 + col0);
                    f32x4 v0 = acc[ai][bj][m][0] + b0, v1 = acc[ai][bj][m][1] + b1;
                    v0[0] = bflo(yv.x) * fast_sigmoid(v0[0]); v0[1] = bfhi(yv.x) * fast_sigmoid(v0[1]); v0[2] = bflo(yv.y) * fast_sigmoid(v0[2]); v0[3] = bfhi(yv.y) * fast_sigmoid(v0[3]);
                    v1[0] = bflo(yv.z) * fast_sigmoid(v1[0]); v1[1] = bfhi(yv.z) * fast_sigmoid(v1[1]); v1[2] = bflo(yv.w) * fast_sigmoid(v1[2]); v1[3] = bfhi(yv.w) * fast_sigmoid(v1[3]);
                    *(v4u*)(O + (size_t)row * 512 + col0) = pack8(v0, v1);
                }
        }
    }
};

struct EpiMerge {
    static constexpr bool PERM = true;
    const unsigned char* SG; bf16* O;
    static __device__ __forceinline__ float gq(unsigned w, int i) { return (float)((w >> (8 * i)) & 0xffu) + 0.5f; }
    __device__ __forceinline__ void mid(f32x4 (&acc)[2][2][4][2], const Unit& u, int wr, int wc, int fr, int fq) const {
#pragma unroll
        for (int ai = 0; ai < 2; ++ai)
#pragma unroll
            for (int m = 0; m < 4; ++m) {
                const int row = u.pm * 256 + ai * 128 + wr * 64 + m * 16 + fr;
#pragma unroll
                for (int bj = 0; bj < 2; ++bj) {
                    const int col0 = u.pn * 256 + bj * 128 + wc * 32 + 8 * fq;
                    const v2u ga = *(const v2u*)(SG + (size_t)row * 2048 + col0), gb = *(const v2u*)(SG + (size_t)row * 2048 + 1024 + col0);
                    f32x4& v0 = acc[ai][bj][m][0]; f32x4& v1 = acc[ai][bj][m][1];
#pragma unroll
                    for (int e = 0; e < 4; ++e) { v0[e] *= gq(ga.x, e) * __builtin_amdgcn_rcpf(gq(gb.x, e)); v1[e] *= gq(ga.y, e) * __builtin_amdgcn_rcpf(gq(gb.y, e)); }
                }
            }
    }
    __device__ __forceinline__ void operator()(EPI_ARGS) const {
#pragma unroll
        for (int ai = 0; ai < 2; ++ai)
#pragma unroll
            for (int m = 0; m < 4; ++m) {
                const int row = u.pm * 256 + ai * 128 + wr * 64 + m * 16 + fr;
#pragma unroll
                for (int bj = 0; bj < 2; ++bj) {
                    const int col0 = u.pn * 256 + bj * 128 + wc * 32 + 8 * fq;
                    const v2u g = *(const v2u*)(SG + (size_t)row * 2048 + 1024 + col0);
                    f32x4 v0 = acc[ai][bj][m][0], v1 = acc[ai][bj][m][1];
#pragma unroll
                    for (int e = 0; e < 4; ++e) { v0[e] *= gq(g.x, e) * 0.00390625f; v1[e] *= gq(g.y, e) * 0.00390625f; }
                    *(v4u*)(O + (size_t)row * 1024 + col0) = pack8(v0, v1);
                }
            }
    }
};

struct EpiOut {
    static constexpr bool PERM = true;
    const float* X; bf16* HB; unsigned char* HB8; float* ssqp;
    __device__ __forceinline__ void operator()(EPI_ARGS) const {
#pragma unroll
        for (int ai = 0; ai < 2; ++ai)
#pragma unroll
            for (int m = 0; m < 4; ++m) {
                const int row = u.pm * 256 + ai * 128 + wr * 64 + m * 16 + fr; float ss = 0.f;
#pragma unroll
                for (int bj = 0; bj < 2; ++bj) {
                    const int col0 = u.pn * 256 + bj * 128 + wc * 32 + 8 * fq;
                    const f32x4 x0 = *(const f32x4*)(X + (size_t)row * D + col0), x1 = *(const f32x4*)(X + (size_t)row * D + col0 + 4);
                    const f32x4 v0 = acc[ai][bj][m][0] + x0, v1 = acc[ai][bj][m][1] + x1;
                    *(v4u*)(HB + (size_t)row * D + col0) = pack8(v0, v1);
                    { int p0 = 0, p1 = 0;
                      p0 = __builtin_amdgcn_cvt_pk_fp8_f32(v0[0], v0[1], p0, false); p0 = __builtin_amdgcn_cvt_pk_fp8_f32(v0[2], v0[3], p0, true);
                      p1 = __builtin_amdgcn_cvt_pk_fp8_f32(v1[0], v1[1], p1, false); p1 = __builtin_amdgcn_cvt_pk_fp8_f32(v1[2], v1[3], p1, true);
                      *(v2u*)(HB8 + (size_t)row * D + col0) = (v2u){(unsigned)p0, (unsigned)p1}; }
                    ss += (v0[0] * v0[0] + v0[1] * v0[1]) + (v0[2] * v0[2] + v0[3] * v0[3]) + (v1[0] * v1[0] + v1[1] * v1[1]) + (v1[2] * v1[2] + v1[3] * v1[3]);
                }
                { const int ln = fq * 16 + fr; ss += shx(ss, 16, ln); ss += shx(ss, 32, ln); }
                if (fq == 0) ssqp[(size_t)row * 16 + u.pn * 4 + wc] = ss;
            }
    }
};

struct EpiUp {
    static constexpr bool PERM = true;
    const float* srs; unsigned char* HID;
    __device__ __forceinline__ void operator()(EPI_ARGS) const {
        const int pnl = u.pn & 3;
        float rsv[2][4];
#pragma unroll
        for (int ai = 0; ai < 2; ++ai)
#pragma unroll
            for (int m = 0; m < 4; ++m) rsv[ai][m] = srs[u.pm * 256 + ai * 128 + wr * 64 + m * 16 + fr];
        asm volatile("" : "+v"(rsv[0][0]), "+v"(rsv[0][1]), "+v"(rsv[0][2]), "+v"(rsv[0][3]), "+v"(rsv[1][0]), "+v"(rsv[1][1]), "+v"(rsv[1][2]), "+v"(rsv[1][3]));
#pragma unroll
        for (int ai = 0; ai < 2; ++ai) {
            if (u.hs == 2 - ai) continue;
#pragma unroll
            for (int m = 0; m < 4; ++m) {
                const int slot = u.pm * 256 + ai * 128 + wr * 64 + m * 16 + fr; const float rs = rsv[ai][m];
                f32x4 h0, h1;
#pragma unroll
                for (int e = 0; e < 4; ++e) {
                    const float a0 = acc[ai][0][m][0][e] * rs, c0 = acc[ai][1][m][0][e] * rs; h0[e] = a0 * fast_sigmoid(a0) * c0 * 4.0f;
                    const float a1 = acc[ai][0][m][1][e] * rs, c1 = acc[ai][1][m][1][e] * rs; h1[e] = a1 * fast_sigmoid(a1) * c1 * 4.0f;
                }
                int p0 = 0, p1 = 0;
                p0 = __builtin_amdgcn_cvt_pk_fp8_f32(h0[0], h0[1], p0, false); p0 = __builtin_amdgcn_cvt_pk_fp8_f32(h0[2], h0[3], p0, true);
                p1 = __builtin_amdgcn_cvt_pk_fp8_f32(h1[0], h1[1], p1, false); p1 = __builtin_amdgcn_cvt_pk_fp8_f32(h1[2], h1[3], p1, true);
                *(v2u*)(HID + (size_t)slot * FF + pnl * 128 + wc * 32 + 8 * fq) = (v2u){(unsigned)p0, (unsigned)p1};
            }
        }
    }
};

struct EpiDown {
    static constexpr bool PERM = true;
    const int* sdst; const float* sgate; unsigned char* YB;
    __device__ __forceinline__ void operator()(EPI_ARGS) const {
        const int pnl = u.pn & 3;
#pragma unroll
        for (int ai = 0; ai < 2; ++ai) {
            if (u.hs == 2 - ai) continue;
#pragma unroll
            for (int m = 0; m < 4; ++m) {
                const int slot = u.pm * 256 + ai * 128 + wr * 64 + m * 16 + fr; const int dst = sdst[slot]; const float gt = sgate[slot] * 16.0f;
                if (dst >= 0) {
#pragma unroll
                    for (int bj = 0; bj < 2; ++bj) {
                        const f32x4 a = acc[ai][bj][m][0] * gt, c2 = acc[ai][bj][m][1] * gt; int p0 = 0, p1 = 0;
                        p0 = __builtin_amdgcn_cvt_pk_fp8_f32(a[0], a[1], p0, false); p0 = __builtin_amdgcn_cvt_pk_fp8_f32(a[2], a[3], p0, true);
                        p1 = __builtin_amdgcn_cvt_pk_fp8_f32(c2[0], c2[1], p1, false); p1 = __builtin_amdgcn_cvt_pk_fp8_f32(c2[2], c2[3], p1, true);
                        *(v2u*)(YB + ((unsigned)dst * (unsigned)D + (unsigned)(pnl * 256 + bj * 128 + wc * 32 + 8 * fq))) = (v2u){(unsigned)p0, (unsigned)p1};
                    }
                }
            }
        }
    }
};

__device__ __forceinline__ void p0_transpose_block(const float* W, int N, int k0, int n0, bf16* dst, int ldk, const float* ksc, LAS float* scr, int lane) {
#pragma unroll 8
    for (int i = 0; i < 32; ++i) { const int kk = 2 * i + (lane >> 5); float v = W[(size_t)(k0 + kk) * N + n0 + (lane & 31)]; if (ksc) v *= ksc[k0 + kk]; scr[kk * 33 + (lane & 31)] = v; }
    LDS_WAIT(); asm volatile("" ::: "memory");
    const int c = lane & 7;
#pragma unroll
    for (int j = 0; j < 4; ++j) { const int n = (lane >> 3) + 8 * j; const LAS float* s = scr + (8 * c) * 33 + n;
        v4u o; o.x = cvt_pk_bf16(s[0 * 33], s[1 * 33]); o.y = cvt_pk_bf16(s[2 * 33], s[3 * 33]); o.z = cvt_pk_bf16(s[4 * 33], s[5 * 33]); o.w = cvt_pk_bf16(s[6 * 33], s[7 * 33]);
        *(v4u*)(dst + (size_t)n * ldk + k0 + 8 * c) = o; }
    LDS_WAIT(); asm volatile("" ::: "memory");
}


__device__ __forceinline__ float gelu_tanh(float x) { const float u = 0.7978845608028654f * (x + 0.044715f * x * x * x); return x * fast_sigmoid(2.0f * u); }
typedef unsigned short us4 __attribute__((ext_vector_type(4)));

__device__ __forceinline__ void attn_unit(const bf16* Qb, const bf16* Kb, const bf16* VT, bf16* Ob, int b, int head, int qb, int lane, LAS unsigned char* wl) {
    const int l31 = lane & 31, h = lane >> 5;
    const int row = b * SEQ + qb * 32 + l31;
    bf16x8 qf[4];
#pragma unroll
    for (int st = 0; st < 4; ++st) qf[st] = *(const bf16x8*)(Qb + (size_t)row * 512 + head * 64 + 16 * st + 8 * h);
    const int Pq0 = 16 + qb * 32, qpos = Pq0 + l31;
    f32x16 o0, o1;
#pragma unroll
    for (int r = 0; r < 16; ++r) { o0[r] = 0.f; o1[r] = 0.f; }
    float carry = 1.f;
    LAS unsigned char* kl = wl; LAS unsigned char* vl = wl + 32 * 144;
    const bf16* kg = Kb + ((size_t)b * LPB + 16 + (lane >> 3)) * 512 + head * 64 + (lane & 7) * 8;
    const bf16* vg = VT + ((size_t)(b * 512 + head * 64 + (lane >> 2))) * LPB + 16 + (lane & 3) * 8;
    const int kwo = (lane >> 3) * 144 + (lane & 7) * 16, vwo = (lane >> 2) * 72 + (lane & 3) * 16;
    v4u krx[4], vrx[4], kry[4], vry[4];
#define ATT_GLOAD(kr, vr, kbx) do { _Pragma("unroll") for (int i = 0; i < 4; ++i) { kr[i] = *(const v4u*)(kg + (long)((kbx) + 8 * i) * 512); vr[i] = *(const v4u*)(vg + (size_t)(16 * i) * LPB + (long)(kbx)); } } while (0)
#define ATT_STAGE(kr, vr) do { _Pragma("unroll") for (int i = 0; i < 4; ++i) { *(LAS v4u*)(kl + kwo + i * 8 * 144) = kr[i]; \
        *(LAS v2u*)(vl + vwo + i * 16 * 72) = (v2u){vr[i].x, vr[i].y}; *(LAS v2u*)(vl + vwo + i * 16 * 72 + 8) = (v2u){vr[i].z, vr[i].w}; } } while (0)
#define ATT_FRAGS(Sx, vax, vbx) do { bf16x8 kf_[4]; _Pragma("unroll") for (int st = 0; st < 4; ++st) kf_[st] = *(const LAS bf16x8*)(kl + l31 * 144 + st * 32 + 16 * h); \
        _Pragma("unroll") for (int db = 0; db < 2; ++db) _Pragma("unroll") for (int s2 = 0; s2 < 2; ++s2) { const LAS unsigned char* vp = vl + (db * 32 + l31) * 72 + (16 * s2 + 4 * h) * 2; vax[db][s2] = *(const LAS v2u*)vp; vbx[db][s2] = *(const LAS v2u*)(vp + 16); } \
        _Pragma("unroll") for (int r = 0; r < 16; ++r) Sx[r] = 0.f; \
        _Pragma("unroll") for (int st = 0; st < 4; ++st) Sx = __builtin_amdgcn_mfma_f32_32x32x16_bf16(kf_[st], qf[st], Sx, 0, 0, 0); } while (0)
#define ATT_TILE(Sx, vax, vbx, kbx) do { \
        float be[16], kp[16]; \
        const bool boundary = ((kbx) + 31 >= Pq0) || ((kbx) < 0);        \
        _Pragma("unroll") for (int r = 0; r < 16; ++r) { const float e = __builtin_amdgcn_exp2f(-Sx[r]); be[r] = __builtin_amdgcn_rcpf(1.0f + e); kp[r] = 1.0f - be[r]; } \
        if (boundary) { _Pragma("unroll") for (int r = 0; r < 16; ++r) { const int key = (kbx) + (r & 3) + 8 * (r >> 2) + 4 * h; const bool valid = (key < qpos) && (key >= 0); \
                be[r] = valid ? be[r] : 0.f; kp[r] = valid ? kp[r] : 1.f; } } \
        float gs[4], pg[4]; \
        _Pragma("unroll") for (int g = 0; g < 4; ++g) { gs[g] = (kp[4 * g] * kp[4 * g + 1]) * (kp[4 * g + 2] * kp[4 * g + 3]); pg[g] = shx(gs[g], 32, lane); } \
        float w[16]; float later = carry; \
        _Pragma("unroll") for (int g = 3; g >= 0; --g) { \
            const float p3 = later * (h == 0 ? pg[g] : 1.f); \
            const float p2 = p3 * kp[4 * g + 3], p1 = p2 * kp[4 * g + 2], p0 = p1 * kp[4 * g + 1]; \
            w[4 * g + 3] = be[4 * g + 3] * p3; w[4 * g + 2] = be[4 * g + 2] * p2; w[4 * g + 1] = be[4 * g + 1] * p1; w[4 * g] = be[4 * g] * p0; \
            later *= gs[g] * pg[g]; } \
        carry = later; \
        _Pragma("unroll") for (int s2 = 0; s2 < 2; ++s2) { \
            v4u wp; wp.x = cvt_pk_bf16(w[8 * s2], w[8 * s2 + 1]); wp.y = cvt_pk_bf16(w[8 * s2 + 2], w[8 * s2 + 3]); wp.z = cvt_pk_bf16(w[8 * s2 + 4], w[8 * s2 + 5]); wp.w = cvt_pk_bf16(w[8 * s2 + 6], w[8 * s2 + 7]); \
            const bf16x8 wf = __builtin_bit_cast(bf16x8, wp); \
            v4u v0; v0.x = vax[0][s2].x; v0.y = vax[0][s2].y; v0.z = vbx[0][s2].x; v0.w = vbx[0][s2].y; \
            v4u v1; v1.x = vax[1][s2].x; v1.y = vax[1][s2].y; v1.z = vbx[1][s2].x; v1.w = vbx[1][s2].y; \
            o0 = __builtin_amdgcn_mfma_f32_32x32x16_bf16(__builtin_bit_cast(bf16x8, v0), wf, o0, 0, 0, 0); \
            o1 = __builtin_amdgcn_mfma_f32_32x32x16_bf16(__builtin_bit_cast(bf16x8, v1), wf, o1, 0, 0, 0); } } while (0)
#define ATT_STEP(kr, vr, kbx) do { ATT_STAGE(kr, vr); const int kb2_ = ((kbx) - 64 > -32) ? (kbx) - 64 : (kbx); ATT_GLOAD(kr, vr, kb2_); \
        f32x16 S_; v2u va_[2][2], vb_[2][2]; ATT_FRAGS(S_, va_, vb_); ATT_TILE(S_, va_, vb_, kbx); } while (0)
    ATT_GLOAD(krx, vrx, Pq0);
    { const int kb1 = (Pq0 - 32 > -32) ? Pq0 - 32 : Pq0; ATT_GLOAD(kry, vry, kb1); }
    for (int kb = Pq0; ; kb -= 64) {
        ATT_STEP(krx, vrx, kb);
        if (__all(carry < 9.3132257e-10f)) break;
        if (!((kb - 32) > -32)) break;
        ATT_STEP(kry, vry, kb - 32);
        if (__all(carry < 9.3132257e-10f)) break;
        if (!((kb - 64) > -32)) break;
    }
#undef ATT_STEP
#undef ATT_TILE
#undef ATT_GLOAD
#undef ATT_STAGE
#undef ATT_FRAGS
    bf16* op = Ob + (size_t)row * 512 + head * 64 + 4 * h;
#pragma unroll
    for (int g = 0; g < 4; ++g) {
        v2u a; a.x = cvt_pk_bf16(o0[4 * g], o0[4 * g + 1]); a.y = cvt_pk_bf16(o0[4 * g + 2], o0[4 * g + 3]); *(v2u*)(op + 8 * g) = a;
        v2u d; d.x = cvt_pk_bf16(o1[4 * g], o1[4 * g + 1]); d.y = cvt_pk_bf16(o1[4 * g + 2], o1[4 * g + 3]); *(v2u*)(op + 32 + 8 * g) = d;
    }
}


struct Tr64 { const float* W; int N, k0, n0, ldk; bf16* dst; const float* ksc; int f8; float osc; };
__device__ __forceinline__ void tr64_load(const Tr64& t, f32x4 (&v)[16], int lane) {
    const float* p = t.W + (size_t)(t.k0 + (lane >> 4)) * t.N + t.n0 + 4 * (lane & 15);
#pragma unroll
    for (int i = 0; i < 16; ++i) v[i] = __builtin_nontemporal_load((const f32x4*)(p + (size_t)(4 * i) * t.N));
}
__device__ __forceinline__ void tr64_store(const Tr64& t, const f32x4 (&v)[16], LAS float* scr, int lane) {
    const int cch = lane & 7;
    f32x4 g0 = (f32x4){1.f, 1.f, 1.f, 1.f}, g1 = g0;
    if (t.ksc) { g0 = *(const f32x4*)(t.ksc + t.k0 + 8 * cch); g1 = *(const f32x4*)(t.ksc + t.k0 + 8 * cch + 4); }
    { LAS float* w = scr + (lane >> 4) * 65 + 4 * (lane & 15);
#pragma unroll
        for (int i = 0; i < 16; ++i) { w[(4 * i) * 65 + 0] = v[i][0]; w[(4 * i) * 65 + 1] = v[i][1]; w[(4 * i) * 65 + 2] = v[i][2]; w[(4 * i) * 65 + 3] = v[i][3]; } }
    LDS_WAIT(); asm volatile("" ::: "memory");
    if (t.f8) { g0 = g0 * t.osc; g1 = g1 * t.osc;
#pragma unroll
        for (int jj = 0; jj < 8; ++jj) { const int n = (lane >> 3) + 8 * jj; const LAS float* sp = scr + (8 * cch) * 65 + n; int p0 = 0, p1 = 0;
            p0 = __builtin_amdgcn_cvt_pk_fp8_f32(sp[0 * 65] * g0[0], sp[1 * 65] * g0[1], p0, false); p0 = __builtin_amdgcn_cvt_pk_fp8_f32(sp[2 * 65] * g0[2], sp[3 * 65] * g0[3], p0, true);
            p1 = __builtin_amdgcn_cvt_pk_fp8_f32(sp[4 * 65] * g1[0], sp[5 * 65] * g1[1], p1, false); p1 = __builtin_amdgcn_cvt_pk_fp8_f32(sp[6 * 65] * g1[2], sp[7 * 65] * g1[3], p1, true);
            *(v2u*)((unsigned char*)t.dst + (size_t)n * t.ldk + t.k0 + 8 * cch) = (v2u){(unsigned)p0, (unsigned)p1}; }
    } else {
#pragma unroll
    for (int jj = 0; jj < 8; ++jj) { const int n = (lane >> 3) + 8 * jj; const LAS float* sp = scr + (8 * cch) * 65 + n;
        v4u o; o.x = cvt_pk_bf16(sp[0 * 65] * g0[0], sp[1 * 65] * g0[1]); o.y = cvt_pk_bf16(sp[2 * 65] * g0[2], sp[3 * 65] * g0[3]);
        o.z = cvt_pk_bf16(sp[4 * 65] * g1[0], sp[5 * 65] * g1[1]); o.w = cvt_pk_bf16(sp[6 * 65] * g1[2], sp[7 * 65] * g1[3]);
        *(v4u*)(t.dst + (size_t)n * t.ldk + t.k0 + 8 * cch) = o; }
    }
    LDS_WAIT(); asm volatile("" ::: "memory");
}
constexpr int I_E1 = 32 * 16 * 8, I_E3 = I_E1, I_E2 = 32 * 8 * 16, NEX = I_E1 + I_E3 + I_E2;
__device__ __forceinline__ Tr64 expert_item(int r, const float* ew1, const float* ew3, const float* ew2, const float* g_ffn, bf16* WupT, bf16* W2T) {
    Tr64 t; t.f8 = 1;
    if (r < I_E1 + I_E3) { const int w3 = r >= I_E1; if (w3) r -= I_E1; const int e = r >> 7; t.k0 = 64 * ((r >> 3) & 15); t.n0 = 64 * (r & 7);
        const int drow = (t.n0 >> 7) * 256 + (t.n0 & 127) + (w3 ? 128 : 0);
        t.W = (w3 ? ew3 : ew1) + (size_t)e * D * FF; t.N = FF; t.dst = (bf16*)((unsigned char*)WupT + ((size_t)e * 1024 + drow) * 1024); t.ldk = 1024; t.ksc = g_ffn; t.osc = 32.0f; }
    else { r -= I_E1 + I_E3; const int e = r >> 7; t.k0 = 64 * ((r >> 4) & 7); t.n0 = 64 * (r & 15);
        t.W = ew2 + (size_t)e * FF * D; t.N = D; t.dst = (bf16*)((unsigned char*)W2T + ((size_t)e * 1024 + t.n0) * 512); t.ldk = 512; t.ksc = nullptr; t.osc = 16.0f; }
    return t;
}

__global__ void __launch_bounds__(NWAVES * 64, 2) fwd_kernel(Args args) {
    extern __shared__ __attribute__((aligned(16))) unsigned char lds_raw[];
    Frame F;
    F.lds = (LAS unsigned char*)lds_raw;
    F.MISC = (volatile LAS unsigned*)(F.lds + MISC_OFF);
    F.tid = threadIdx.x; F.lane = F.tid & 63; F.wave = __builtin_amdgcn_readfirstlane(F.tid >> 6);
    F.G = gridDim.x; { const int bx = blockIdx.x; F.vcu = (F.G % 8 == 0) ? (bx % 8) * (F.G / 8) + bx / 8 : bx; }
    unsigned char* ws = args.ws;
    gu32* ctl = (gu32*)(ws + WS_CTL);
    for (int u = F.tid; u < (LDS_BYTES - LDSCTL_OFF) / 4; u += NWAVES * 64) ((LAS unsigned*)(F.lds + LDSCTL_OFF))[u] = 0u;
    __syncthreads();
    XcdBarrier bar = xcd_barrier_post((unsigned*)(ctl + CW_BAR), F.MISC + 8);
    const int wave = F.wave, c = F.vcu;
    const int gw = c * NWAVES + wave, NGW = F.G * NWAVES;

    const float* x = args.in[0]; const float* meta_tok = args.in[1]; const float* g_mix = args.in[2]; const float* w_in = args.in[3];
    const float* lam_re = args.in[4]; const float* lam_im = args.in[5]; const float* log_dt = args.in[6];
    const float* b_re = args.in[7]; const float* b_im = args.in[8]; const float* c_re = args.in[9]; const float* c_im = args.in[10];
    const float* ssm_d = args.in[11]; const float* glu_w = args.in[12]; const float* glu_b = args.in[13];
    const float* w_pa = args.in[14]; const float* w_pb = args.in[15]; const float* w_out = args.in[16]; const float* g_ffn = args.in[17];
    const float* rg_w = args.in[18]; const float* rg_b = args.in[19]; const float* re_w = args.in[20]; const float* re_b = args.in[21];
    const float* ew1 = args.in[22]; const float* ew3 = args.in[23]; const float* ew2 = args.in[24]; const float* g_fin = args.in[25];
    float* out = args.out;
    float* rstd1 = (float*)(ws + SM_RSTD1); float* rstd2 = (float*)(ws + SM_RSTD2);
    int* eid = (int*)(ws + SM_EID); float* gatev = (float*)(ws + SM_GATE); int* cntg = (int*)(ws + SM_CNT);
    float* umeta = (float*)(ws + SM_UMETA); float* bbar_g = (float*)(ws + SM_BBAR); float* lbar_g = (float*)(ws + SM_LBAR); float* l64_g = (float*)(ws + SM_L64);
    int* sdst = (int*)(ws + SM_SDST); float* sgate = (float*)(ws + SM_SGATE); float* srs = (float*)(ws + SM_SRS);
    float* metapart = (float*)(ws + SM_METAP);
    bf16* wr_t = (bf16*)(ws + SM_WR); float* rbias = (float*)(ws + SM_RB); int* moemeta = (int*)(ws + SM_MOEMETA); float* ssqp = (float*)(ws + SM_SSQP);
    bf16* WinT = (bf16*)(ws + WS_WIN); bf16* WpabT = (bf16*)(ws + WS_WPAB); bf16* WoT = (bf16*)(ws + WS_WO); bf16* GluT = (bf16*)(ws + WS_GLU);
    bf16* KT = (bf16*)(ws + WS_KT); bf16* T2 = (bf16*)(ws + WS_T2); bf16* T3 = (bf16*)(ws + WS_T3);
    bf16* WupT = (bf16*)(ws + WS_WUP); bf16* W2T = (bf16*)(ws + WS_W2);
    unsigned char* XB = ws + WS_XB; bf16* MRG = (bf16*)(ws + WS_XB);
    bf16* Qb = (bf16*)(ws + WS_Q); bf16* SSMb = (bf16*)(ws + WS_SSM); bf16* Kb = (bf16*)(ws + WS_K); bf16* VT = (bf16*)(ws + WS_VT);
    bf16* UG = (bf16*)(ws + WS_UG); bf16* Yb = (bf16*)(ws + WS_Y); float* Sst = (float*)(ws + WS_S); bf16* Xs = (bf16*)(ws + WS_XS);
    bf16* H1B = (bf16*)(ws + WS_H1B); unsigned char* H1B8 = ws + WS_H1B8; unsigned char* HID = ws + WS_HID; unsigned char* YB = (unsigned char*)(ws + WS_YB);
    unsigned char* SG = ws + WS_SG;
    int* inv_tok = (int*)(ws + WS_INV); float* inv_gate = (float*)(ws + WS_INV + (size_t)NE * CAPE * 4); float* inv_rs = (float*)(ws + WS_INV + (size_t)2 * NE * CAPE * 4);
    int* mymeta = (int*)(ws + WS_MWG) + (size_t)blockIdx.x * 512; unsigned* etot = (unsigned*)(ctl + CW_TOT);

    for (int rep = 0; rep < REP_P0; ++rep) {
        int tid = threadIdx.x; asm volatile("" : "+v"(tid)); const int lane = tid & 63; (void)lane;
        if (rep) { __syncthreads(); if (tid == 0) F.MISC[0] = 0u; __syncthreads(); }
        if (c & 1) {
            LAS float* scr = (LAS float*)(F.lds + wave * P0_SCR);
            constexpr int I_IN = 16 * 64, I_PA = 8 * 16, I_PB = 8 * 16, I_O = 16 * 16, I_G = 8 * 8;
            constexpr int NTR = I_IN + I_PA + I_PB + I_O + I_G, NXR = M / 4, NITEMS = NTR + NXR;
            const int per_wg = (REP_P0S * NITEMS + F.G - 1) / F.G;
            for (;;) {
                int kq = 0; if (lane == 0) kq = (int)__hip_atomic_fetch_add((unsigned*)(F.MISC + 0), 1u, __ATOMIC_RELAXED, __HIP_MEMORY_SCOPE_WORKGROUP);
                kq = __builtin_amdgcn_readfirstlane(kq);
                if (kq >= per_wg) break;
                int it = kq * F.G + c; if (it >= REP_P0S * NITEMS) break;
                if (REP_P0S > 1) it %= NITEMS;
                if (it >= NTR) {
                    const int m0 = (it - NTR) * 4; f32x4 v[4][4];
#pragma unroll
                    for (int q = 0; q < 4; ++q) { const f32x4* xr = (const f32x4*)(x + (size_t)(m0 + q) * D) + lane;
#pragma unroll
                        for (int jj = 0; jj < 4; ++jj) v[q][jj] = __builtin_nontemporal_load(&xr[64 * jj]); }
#pragma unroll
                    for (int q = 0; q < 4; ++q) { float ss = 0.f;
#pragma unroll
                        for (int jj = 0; jj < 4; ++jj) ss += (v[q][jj][0] * v[q][jj][0] + v[q][jj][1] * v[q][jj][1]) + (v[q][jj][2] * v[q][jj][2] + v[q][jj][3] * v[q][jj][3]);
                        ss = wave_sum(ss, lane);
                        if (lane == 0) rstd1[m0 + q] = 1.0f / sqrtf(ss * (1.0f / D) + RMS_EPS);
                        unsigned* o4 = (unsigned*)(XB + (size_t)(m0 + q) * D) + lane;
#pragma unroll
                        for (int jj = 0; jj < 4; ++jj) { int p = 0; p = __builtin_amdgcn_cvt_pk_fp8_f32(v[q][jj][0], v[q][jj][1], p, false); p = __builtin_amdgcn_cvt_pk_fp8_f32(v[q][jj][2], v[q][jj][3], p, true); o4[64 * jj] = (unsigned)p; } }
                    continue;
                }
                int r = it; const float* W; int N, k0, n0, ldk; bf16* dst; const float* ksc = nullptr; int f8 = 0; float osc = 1.0f;
                if (r < I_IN) { W = w_in; N = INC; k0 = 64 * (r >> 6); n0 = 64 * (r & 63); dst = (bf16*)((unsigned char*)WinT + (size_t)n0 * 1024); ldk = 1024; ksc = g_mix; f8 = 1; osc = 32.0f; }
                else if ((r -= I_IN) < I_PA) { W = w_pa; N = D; k0 = 64 * (r >> 4); n0 = 64 * (r & 15); dst = WpabT + (size_t)n0 * 512; ldk = 512; }
                else if ((r -= I_PA) < I_PB) { W = w_pb; N = D; k0 = 64 * (r >> 4); n0 = 64 * (r & 15); dst = WpabT + (size_t)(1024 + n0) * 512; ldk = 512; }
                else if ((r -= I_PB) < I_O) { W = w_out; N = D; k0 = 64 * (r >> 4); n0 = 64 * (r & 15); dst = WoT + (size_t)n0 * 1024; ldk = 1024; }
                else { r -= I_O; W = glu_w; N = SW; k0 = 64 * (r >> 3); n0 = 64 * (r & 7); dst = GluT + (size_t)n0 * 512; ldk = 512; }
                { Tr64 t; t.W = W; t.N = N; t.k0 = k0; t.n0 = n0; t.ldk = ldk; t.dst = dst; t.ksc = ksc; t.f8 = f8; t.osc = osc; f32x4 tv[16]; tr64_load(t, tv, lane); tr64_store(t, tv, scr, lane); }
            }
            __syncthreads();
        }
        {
            const int g = c >> 3, j = c & 7;
            LAS f32x2* LP = (LAS f32x2*)(F.lds);
            LAS f32x2* BB = (LAS f32x2*)(F.lds + 33792);
            LAS f32x2* CC = (LAS f32x2*)(F.lds + 33792 + 8192);
            LAS f32x2* CL = (LAS f32x2*)(F.lds + 33792 + 16384);
            LAS float* mrs = (LAS float*)(F.lds + 33792 + 16384 + 65536);
            const float dt = expf(log_dt[g]);
#pragma unroll 1
            for (int idx = tid; idx < 65 * 64; idx += 512) {
                const int n = idx >> 6, p = idx & 63; const float lr = lam_re[g * 64 + p], li = lam_im[g * 64 + p];
                const float mag = expf((float)n * (lr * dt));
                const float rev1 = (li * dt) * 0.15915494309189535f; const float hi = (float)n * rev1; const float lo = fmaf((float)n, rev1, -hi);
                const float fr_ = (hi - rintf(hi)) + lo; const float sn = __builtin_amdgcn_sinf(fr_), cs = __builtin_amdgcn_cosf(fr_);
                LP[idx] = (f32x2){mag * cs, mag * sn};
            }
            for (int idx = tid; idx < 1024; idx += 512) { const int cc = idx >> 6, p = idx & 63; CC[idx] = (f32x2){c_re[(g * 16 + cc) * 64 + p], c_im[(g * 16 + cc) * 64 + p]}; }
            for (int r = 2 * wave; r < 2 * wave + 2; ++r) {
                float ss = 0.f;
#pragma unroll
                for (int i = 0; i < 16; ++i) { const float v = meta_tok[r * 1024 + lane + 64 * i]; ss += v * v; }
                ss = wave_sum(ss, lane);
                if (lane == 0) mrs[r] = 1.0f / sqrtf(ss * (1.0f / 1024.0f) + RMS_EPS);
            }
            __syncthreads();
            for (int idx = tid; idx < 1024; idx += 512) {
                const int p = idx >> 4, cp = idx & 15; const float lr = lam_re[g * 64 + p], li = lam_im[g * 64 + p];
                const f32x2 L1 = LP[64 + p]; const float nr = L1.x - 1.0f, ni = L1.y, den = lr * lr + li * li;
                const float fre = (nr * lr + ni * li) / den, fim = (ni * lr - nr * li) / den;
                const float br = b_re[(g * 64 + p) * 16 + cp], bi = b_im[(g * 64 + p) * 16 + cp];
                const f32x2 v = (f32x2){fre * br - fim * bi, fre * bi + fim * br};
                BB[idx] = v;
                if (j == 0) { bbar_g[((g * 64 + p) * 16 + cp) * 2] = v.x; bbar_g[((g * 64 + p) * 16 + cp) * 2 + 1] = v.y; }
            }
#pragma unroll 2
            for (int idx = tid; idx < 8192; idx += 512) { const int nl = idx >> 10, cc = (idx >> 6) & 15, p = idx & 63; const f32x2 C = CC[cc * 64 + p], L = LP[(8 * j + nl) * 64 + p];
                CL[idx] = (f32x2){C.x * L.x - C.y * L.y, C.x * L.y + C.y * L.x}; }
            if (j == 0 && tid < 64) { const f32x2 L1 = LP[64 + tid], L64 = LP[64 * 64 + tid];
                lbar_g[(g * 64 + tid) * 2] = L1.x; lbar_g[(g * 64 + tid) * 2 + 1] = L1.y; l64_g[(g * 64 + tid) * 2] = L64.x; l64_g[(g * 64 + tid) * 2 + 1] = L64.y; }
            __syncthreads();
#pragma unroll 1
            for (int idx = tid; idx < 2048; idx += 512) {
                const int nl = idx >> 8, cc = (idx >> 4) & 15, cp = idx & 15; float a = 0.f;
                const LAS f32x2* clp = CL + (nl * 16 + cc) * 64;
#pragma unroll 8
                for (int p = 0; p < 64; ++p) { const f32x2 X = clp[p], B = BB[p * 16 + cp]; a += X.x * B.x - X.y * B.y; }
                const int n = 8 * j + nl;
                if (n == 0 && cc == cp) a += ssm_d[g * 16 + cc];
                KT[((size_t)(g * KT_ROWS + n + 1)) * 256 + cc * 16 + cp] = (bf16)(cvt_pk_bf16(a, 0.f) & 0xffffu);
            }
            if (j == 0 && tid < 256) KT[((size_t)(g * KT_ROWS)) * 256 + tid] = 0;
#pragma unroll 2
            for (int idx = tid; idx < 16384; idx += 512) {
                const int kk = idx & 127, nn = idx >> 7; const int s2 = 8 * j + (kk >> 4), cp = kk & 15, ri = nn >> 6, p = nn & 63;
                const f32x2 L = LP[(63 - s2) * 64 + p], B = BB[p * 16 + cp];
                const float v = ri ? (L.x * B.y + L.y * B.x) : (L.x * B.x - L.y * B.y);
                T2[((((size_t)(g * 4 + (nn >> 5)) * 64 + s2) * 2 + (cp >> 3)) * 32 + (nn & 31)) * 8 + (cp & 7)] = (bf16)(cvt_pk_bf16(v, 0.f) & 0xffffu);
            }
#pragma unroll 2
            for (int idx = tid; idx < 16384; idx += 512) {
                const int kk = idx & 127, nl = idx >> 7; const int t = 8 * j + (nl >> 4), cc = nl & 15, ri = kk >> 6, p = kk & 63;
                const f32x2 L = LP[(t + 1) * 64 + p], C = CC[cc * 64 + p];
                const float v = ri ? -(C.x * L.y + C.y * L.x) : (C.x * L.x - C.y * L.y);
                T3[((((size_t)(g * 32 + (t >> 1)) * 8 + (kk >> 4)) * 2 + ((kk >> 3) & 1)) * 32 + (t & 1) * 16 + cc) * 8 + (kk & 7)] = (bf16)(cvt_pk_bf16(v, 0.f) & 0xffffu);
            }
            float my_rs[16];
            if (wave == 0 && c < 192) {
#pragma unroll
                for (int r = 0; r < 16; ++r) my_rs[r] = mrs[r];
            }
            __syncthreads();
            LAS float* scr = (LAS float*)(F.lds + wave * P0_SCR);
            if (wave == 0 && c < 192) {
                const int cb = c >> 3, kp = c & 7, k0 = 128 * kp, n = 512 + 64 * cb + lane;
#pragma unroll
                for (int r = 0; r < 16; ++r) { const float g0 = g_mix[k0 + lane], g1 = g_mix[k0 + 64 + lane];
                    scr[r * 128 + lane] = meta_tok[r * 1024 + k0 + lane] * my_rs[r] * g0; scr[r * 128 + 64 + lane] = meta_tok[r * 1024 + k0 + 64 + lane] * my_rs[r] * g1; }
                LDS_WAIT(); asm volatile("" ::: "memory");
                float a[16];
#pragma unroll
                for (int r = 0; r < 16; ++r) a[r] = 0.f;
#pragma unroll 4
                for (int k = 0; k < 128; k += 4) {
                    const float w0 = w_in[(size_t)(k0 + k) * INC + n], w1 = w_in[(size_t)(k0 + k + 1) * INC + n], w2 = w_in[(size_t)(k0 + k + 2) * INC + n], w3 = w_in[(size_t)(k0 + k + 3) * INC + n];
#pragma unroll
                    for (int r = 0; r < 16; ++r) { const f32x4 xv = *(const LAS f32x4*)(scr + r * 128 + k); a[r] += xv[0] * w0 + xv[1] * w1 + xv[2] * w2 + xv[3] * w3; }
                }
#pragma unroll
                for (int r = 0; r < 16; ++r) metapart[((size_t)kp * 16 + r) * 1536 + 64 * cb + lane] = a[r];
                LDS_WAIT(); asm volatile("" ::: "memory");
            } else if (wave == 1 && c < 64) {
                const int n = c;
#pragma unroll 4
                for (int i = 0; i < 16; ++i) { const int k = lane + 64 * i; float v = 0.f;
                    if (n < 4) v = rg_w[k * 4 + n] * g_ffn[k]; else if (n < 36) v = re_w[k * 32 + (n - 4)] * g_ffn[k];
                    const unsigned hi = cvt_pk_bf16(v, 0.f) & 0xffffu; const float lo = v - bf2f((unsigned short)hi);
                    const int fo = ((((n >> 5) * 64 + (k >> 4)) * 2 + ((k >> 3) & 1)) * 32 + (n & 31)) * 8 + (k & 7);
                    wr_t[fo] = (bf16)hi; wr_t[65536 + fo] = (bf16)(cvt_pk_bf16(lo, 0.f) & 0xffffu); }
                if (lane == 0) rbias[n] = n < 4 ? rg_b[n] : (n < 36 ? re_b[n - 4] : 0.f);
            } else if (wave == 1 && c < 72) {
                const int it = c - 64, b = it >> 1;
                if (it & 1) { for (int idx = lane; idx < 512 * 16; idx += 64) { const int cc = idx >> 4, r = idx & 15; VT[((size_t)(b * 512 + cc)) * LPB + r] = 0; } }
                else { for (int idx = lane; idx < 16 * 512; idx += 64) Kb[((size_t)(b * LPB)) * 512 + idx] = 0; }
            }
            if (!(c & 1)) {
            constexpr int I_IN = 16 * 64, I_PA = 8 * 16, I_PB = 8 * 16, I_O = 16 * 16, I_G = 8 * 8;
            constexpr int NTR = I_IN + I_PA + I_PB + I_O + I_G, NXR = M / 4, NITEMS = NTR + NXR;
            const int per_wg = (REP_P0S * NITEMS + F.G - 1) / F.G;
            for (;;) {
                int kq = 0; if (lane == 0) kq = (int)__hip_atomic_fetch_add((unsigned*)(F.MISC + 0), 1u, __ATOMIC_RELAXED, __HIP_MEMORY_SCOPE_WORKGROUP);
                kq = __builtin_amdgcn_readfirstlane(kq);
                if (kq >= per_wg) break;
                int it = kq * F.G + c; if (it >= REP_P0S * NITEMS) break;
                if (REP_P0S > 1) it %= NITEMS;
                if (it >= NTR) {
                    const int m0 = (it - NTR) * 4; f32x4 v[4][4];
#pragma unroll
                    for (int q = 0; q < 4; ++q) { const f32x4* xr = (const f32x4*)(x + (size_t)(m0 + q) * D) + lane;
#pragma unroll
                        for (int jj = 0; jj < 4; ++jj) v[q][jj] = __builtin_nontemporal_load(&xr[64 * jj]); }
#pragma unroll
                    for (int q = 0; q < 4; ++q) { float ss = 0.f;
#pragma unroll
                        for (int jj = 0; jj < 4; ++jj) ss += (v[q][jj][0] * v[q][jj][0] + v[q][jj][1] * v[q][jj][1]) + (v[q][jj][2] * v[q][jj][2] + v[q][jj][3] * v[q][jj][3]);
                        ss = wave_sum(ss, lane);
                        if (lane == 0) rstd1[m0 + q] = 1.0f / sqrtf(ss * (1.0f / D) + RMS_EPS);
                        unsigned* o4 = (unsigned*)(XB + (size_t)(m0 + q) * D) + lane;
#pragma unroll
                        for (int jj = 0; jj < 4; ++jj) { int p = 0; p = __builtin_amdgcn_cvt_pk_fp8_f32(v[q][jj][0], v[q][jj][1], p, false); p = __builtin_amdgcn_cvt_pk_fp8_f32(v[q][jj][2], v[q][jj][3], p, true); o4[64 * jj] = (unsigned)p; } }
                    continue;
                }
                int r = it; const float* W; int N, k0, n0, ldk; bf16* dst; const float* ksc = nullptr; int f8 = 0; float osc = 1.0f;
                if (r < I_IN) { W = w_in; N = INC; k0 = 64 * (r >> 6); n0 = 64 * (r & 63); dst = (bf16*)((unsigned char*)WinT + (size_t)n0 * 1024); ldk = 1024; ksc = g_mix; f8 = 1; osc = 32.0f; }
                else if ((r -= I_IN) < I_PA) { W = w_pa; N = D; k0 = 64 * (r >> 4); n0 = 64 * (r & 15); dst = WpabT + (size_t)n0 * 512; ldk = 512; }
                else if ((r -= I_PA) < I_PB) { W = w_pb; N = D; k0 = 64 * (r >> 4); n0 = 64 * (r & 15); dst = WpabT + (size_t)(1024 + n0) * 512; ldk = 512; }
                else if ((r -= I_PB) < I_O) { W = w_out; N = D; k0 = 64 * (r >> 4); n0 = 64 * (r & 15); dst = WoT + (size_t)n0 * 1024; ldk = 1024; }
                else { r -= I_O; W = glu_w; N = SW; k0 = 64 * (r >> 3); n0 = 64 * (r & 7); dst = GluT + (size_t)n0 * 512; ldk = 512; }
                { Tr64 t; t.W = W; t.N = N; t.k0 = k0; t.n0 = n0; t.ldk = ldk; t.dst = dst; t.ksc = ksc; t.f8 = f8; t.osc = osc; f32x4 tv[16]; tr64_load(t, tv, lane); tr64_store(t, tv, scr, lane); }
            }
            }
        }
    }
    xcd_barrier(bar);

#if PH_MAX >= 1
    for (int rep = 0; rep < REP_P1; ++rep) {
        P1Order S; S.so.init(M / 256, INC / 256, F.G, (int)blockIdx.x, WGM_P1); S.X = (const char*)XB; S.W = (const char*)WinT; S.t = (size_t)256 * 1024;
        EpiIn E{Qb, Kb, VT, UG, SG, rstd1};
        pg8::gemm_phase<EpiIn, P1Order, true, false, false, true>(F.lds + RING_OFF, 512, S, E, 0x7f7a);
        if (rep == REP_P1 - 1) {
            int tid = threadIdx.x; asm volatile("" : "+v"(tid));
            const int t = c * 512 + tid;
            if (t < 16 * 1536) {
                const int r = t / 1536, n = t % 1536; float sacc = 0.f;
#pragma unroll
                for (int kp = 0; kp < 8; ++kp) sacc += metapart[((size_t)kp * 16 + r) * 1536 + n];
                const bf16 hv = (bf16)(cvt_pk_bf16(sacc, 0.f) & 0xffffu);
                if (n < 512) { for (int b = 0; b < NB; ++b) Kb[((size_t)(b * LPB + 16 + r)) * 512 + n] = hv; }
                else if (n < 1024) { for (int b = 0; b < NB; ++b) VT[((size_t)(b * 512 + (n - 512))) * LPB + 16 + r] = hv; }
                else umeta[r * 512 + (n - 1024)] = sacc;
            }
        }
    }
    xcd_barrier(bar);
#endif


#if PH_MAX >= 2
    for (int rep = 0; rep < REP_SSM; ++rep) {
    if (c < 128) {
        int tid = threadIdx.x; asm volatile("" : "+v"(tid)); const int lane = tid & 63;
        const int b = c >> 5, g = c & 31;
        LAS float* SL = (LAS float*)(F.lds);
        LAS f32x2* ends = (LAS f32x2*)(F.lds + 128 * 129 * 4);
        {
            const int mbl = wave >> 1, nh = wave & 1, mb = 4 * b + mbl;
            const int l31 = lane & 31, h = lane >> 5;
            f32x16 a2[2];
#pragma unroll
            for (int r = 0; r < 16; ++r) { a2[0][r] = 0.f; a2[1][r] = 0.f; }
            const bf16* ua = UG + (size_t)(g * 16 + mb) * 64 * 512 + lane * 8;
            const bf16* t2 = T2 + (size_t)(g * 4 + 2 * nh) * 64 * 512 + lane * 8;
#pragma unroll 8
            for (int s2 = 0; s2 < 64; ++s2) {
                const bf16x8 a = *(const bf16x8*)(ua + s2 * 512);
                const bf16x8 b0 = *(const bf16x8*)(t2 + s2 * 512), b1 = *(const bf16x8*)(t2 + 64 * 512 + s2 * 512);
                a2[0] = __builtin_amdgcn_mfma_f32_32x32x16_bf16(a, b0, a2[0], 0, 0, 0);
                a2[1] = __builtin_amdgcn_mfma_f32_32x32x16_bf16(a, b1, a2[1], 0, 0, 0);
            }
#pragma unroll
            for (int t = 0; t < 2; ++t)
#pragma unroll
                for (int r = 0; r < 16; ++r) SL[(32 * mbl + (r & 3) + 8 * (r >> 2) + 4 * h) * 129 + (2 * nh + t) * 32 + l31] = a2[t][r];
        }
        __syncthreads();
        {
            const int seg = wave & 3, p = lane;
            const float lr = lbar_g[(g * 64 + p) * 2], li = lbar_g[(g * 64 + p) * 2 + 1], qr = l64_g[(g * 64 + p) * 2], qi = l64_g[(g * 64 + p) * 2 + 1];
            float vr[32], vi[32];
            float cr = 0.f, ci = 0.f, q32r = qr, q32i = qi;
            if (wave < 4) {
#pragma unroll
                for (int m = 0; m < 32; ++m) { vr[m] = SL[(32 * seg + m) * 129 + p]; vi[m] = SL[(32 * seg + m) * 129 + 64 + p]; }
                float xr = 0.f, xi = 0.f;
#pragma unroll
                for (int m = 0; m < 32; ++m) { const float sr = vr[m], si = vi[m]; vr[m] = xr; vi[m] = xi; const float nr = qr * xr - qi * xi + sr, ni = qr * xi + qi * xr + si; xr = nr; xi = ni; }
                ends[seg * 64 + p] = (f32x2){xr, xi};
                for (int r = 0; r < NMETA; ++r) {
                    float bur = 0.f, bui = 0.f;
#pragma unroll
                    for (int cp = 0; cp < 16; ++cp) { const float uv = umeta[r * 512 + 16 * g + cp]; bur += bbar_g[((g * 64 + p) * 16 + cp) * 2] * uv; bui += bbar_g[((g * 64 + p) * 16 + cp) * 2 + 1] * uv; }
                    const float nr = lr * cr - li * ci + bur, ni = lr * ci + li * cr + bui; cr = nr; ci = ni;
                }
#pragma unroll
                for (int k = 0; k < 5; ++k) { const float nr = q32r * q32r - q32i * q32i, ni = 2.0f * q32r * q32i; q32r = nr; q32i = ni; }
            }
            __syncthreads();
            if (wave < 4) {
                for (int k = 0; k < seg; ++k) { const f32x2 e = ends[k * 64 + p]; const float nr = q32r * cr - q32i * ci + e.x, ni = q32r * ci + q32i * cr + e.y; cr = nr; ci = ni; }
                float pr_ = 1.f, pi_ = 0.f;
#pragma unroll
                for (int m = 0; m < 32; ++m) {
                    const float Xr = vr[m] + (pr_ * cr - pi_ * ci), Xi = vi[m] + (pr_ * ci + pi_ * cr);
                    { const int mrow = b * 128 + 32 * seg + m;
                      const size_t xo = ((((size_t)(g * 16 + (mrow >> 5)) * 8 + (p >> 4)) * 2 + ((p >> 3) & 1)) * 32 + (mrow & 31)) * 8 + (p & 7);
                      Xs[xo] = (bf16)(cvt_pk_bf16(Xr, 0.f) & 0xffffu); Xs[xo + 4 * 512] = (bf16)(cvt_pk_bf16(Xi, 0.f) & 0xffffu); }
                    const float nr = pr_ * qr - pi_ * qi, ni = pr_ * qi + pi_ * qr; pr_ = nr; pi_ = ni;
                }
            }
        }
        __syncthreads();
    }
    if (rep == 0) {
        int tid = threadIdx.x; asm volatile("" : "+v"(tid)); const int lane = tid & 63; (void)lane;
        LAS float* scr = (LAS float*)(F.lds + wave * P0_SCR);
#pragma unroll 1
        for (int pass = 0; pass < 2; ++pass) {
            const bool do_att = (pass == 0) != (wave >= 4);
            if (do_att) {
                const int nu = (c < 128) ? 3 : 5;
#pragma unroll 1
                for (int rp = 0; rp < REP_ATT; ++rp)
#pragma unroll 1
                for (int i = 0; i < nu; ++i) { const int cc = (i < 4) ? c : c - 128; const int qi = (i < 4) ? i : 3;
                    attn_unit(Qb, Kb, VT, (rp == REP_ATT - 1) ? Qb : SSMb, cc >> 6, wave, (cc & 63) * 4 + qi, lane, (LAS unsigned char*)scr); }
            } else {
#pragma unroll 1
                for (int k = 0; k < 4; k += 2) {
                    const Tr64 ta = expert_item(c + 256 * (wave + 8 * k), ew1, ew3, ew2, g_ffn, WupT, W2T);
                    const Tr64 tb = expert_item(c + 256 * (wave + 8 * (k + 1)), ew1, ew3, ew2, g_ffn, WupT, W2T);
                    f32x4 va[16], vb[16];
                    tr64_load(ta, va, lane); tr64_load(tb, vb, lane);
                    tr64_store(ta, va, scr, lane); tr64_store(tb, vb, scr, lane);
                }
            }
        }
    }
    xcd_barrier(bar);
    for (int ui = 0; ui < 2; ++ui) {
        int tid = threadIdx.x; asm volatile("" : "+v"(tid)); const int lane = tid & 63; (void)lane;
        const int U = c * 2 + ui; const int g = U >> 4, mb = U & 15;
        const int l31 = lane & 31, h = lane >> 5;
        LAS unsigned char* UT = F.lds;
        LAS unsigned char* KTl = F.lds + 65536;
        __syncthreads();
        {
            const unsigned char* usrc = (const unsigned char*)(UG + (size_t)(g * 16 + mb) * 64 * 512);
#pragma unroll
            for (int i = 0; i < 8; ++i) { const int idx = tid + 512 * i; *(LAS v4u*)(UT + idx * 16) = *(const v4u*)(usrc + (size_t)idx * 16); }
            const unsigned char* ksrc = (const unsigned char*)(KT + (size_t)g * KT_ROWS * 256);
            for (int idx = tid; idx < 2080; idx += 512) *(LAS v4u*)(KTl + idx * 16) = *(const v4u*)(ksrc + (size_t)idx * 16);
        }
        f32x16 ac[4];
#pragma unroll
        for (int j = 0; j < 4; ++j)
#pragma unroll
            for (int r = 0; r < 16; ++r) ac[j][r] = 0.f;
        {
            const bf16* xa = Xs + (size_t)(g * 16 + mb) * 8 * 512 + lane * 8;
            const bf16* t3 = T3 + (size_t)(g * 32) * 8 * 512 + lane * 8;
#pragma unroll
            for (int kh = 0; kh < 2; ++kh) {
                bf16x8 xa4[4], tb[4][4];
#pragma unroll
                for (int k2 = 0; k2 < 4; ++k2) { xa4[k2] = *(const bf16x8*)(xa + (kh * 4 + k2) * 512);
#pragma unroll
                    for (int j = 0; j < 4; ++j) { const int tp = (j == 0) ? 2 * wave : (j == 1) ? 2 * wave + 1 : (j == 2) ? 30 - 2 * wave : 31 - 2 * wave; tb[k2][j] = *(const bf16x8*)(t3 + ((size_t)tp * 8 + (kh * 4 + k2)) * 512); } }
#pragma unroll
                for (int k2 = 0; k2 < 4; ++k2)
#pragma unroll
                    for (int j = 0; j < 4; ++j) ac[j] = __builtin_amdgcn_mfma_f32_32x32x16_bf16(xa4[k2], tb[k2][j], ac[j], 0, 0, 0);
            }
        }
        __syncthreads();
        {
            const LAS unsigned char* ap = UT + lane * 16;
            const LAS unsigned char* kp = KTl + (l31 >> 4) * 512 + (l31 & 15) * 32 + 16 * h;
            const int tA0 = 2 * wave, tA1 = 30 - 2 * wave;
            bf16x8 pv0[2], pv1[2];
            pv0[0] = *(const LAS bf16x8*)(kp + (2 * tA0 + 3) * 512); pv0[1] = *(const LAS bf16x8*)(kp + (2 * tA0 + 2) * 512);
            pv1[0] = *(const LAS bf16x8*)(kp + (2 * tA1 + 3) * 512); pv1[1] = *(const LAS bf16x8*)(kp + (2 * tA1 + 2) * 512);
#pragma unroll 1
            for (int s0 = 0; s0 < 64; s0 += 2) {
#pragma unroll
                for (int par = 0; par < 2; ++par) {
                    const int s2 = s0 + par;
                    const bf16x8 a = *(const LAS bf16x8*)(ap + s2 * 1024);
                    if (s2 <= 2 * tA0 + 3) { ac[1] = __builtin_amdgcn_mfma_f32_32x32x16_bf16(a, pv0[par], ac[1], 0, 0, 0);
                        if (s2 <= 2 * tA0 + 1) { const bf16x8 f = *(const LAS bf16x8*)(kp + (2 * tA0 - s2 + 1) * 512); ac[0] = __builtin_amdgcn_mfma_f32_32x32x16_bf16(a, f, ac[0], 0, 0, 0); pv0[par] = f; } }
                    if (s2 <= 2 * tA1 + 3) { ac[3] = __builtin_amdgcn_mfma_f32_32x32x16_bf16(a, pv1[par], ac[3], 0, 0, 0);
                        if (s2 <= 2 * tA1 + 1) { const bf16x8 f = *(const LAS bf16x8*)(kp + (2 * tA1 - s2 + 1) * 512); ac[2] = __builtin_amdgcn_mfma_f32_32x32x16_bf16(a, f, ac[2], 0, 0, 0); pv1[par] = f; } }
                }
            }
        }
#pragma unroll
        for (int j = 0; j < 4; ++j) { const int tp = (j == 0) ? 2 * wave : (j == 1) ? 2 * wave + 1 : (j == 2) ? 30 - 2 * wave : 31 - 2 * wave; const int t = 2 * tp + (l31 >> 4);
#pragma unroll
            for (int r = 0; r < 16; ++r) { const int m = 32 * mb + (r & 3) + 8 * (r >> 2) + 4 * h;
                Yb[((size_t)m * 64 + t) * 512 + 16 * g + (l31 & 15)] = (bf16)(cvt_pk_bf16(gelu_tanh(ac[j][r]), 0.f) & 0xffffu); } }
    }

    xcd_barrier(bar);
    }
    for (int rep = 0; rep < REP_MIX; ++rep) {
    {
        GOrder S; S.so.init(M / 256, SW / 256, F.G, (int)blockIdx.x, WGM_GLU); S.A = (const char*)Yb; S.B = (const char*)GluT; S.ta = (size_t)256 * 512 * 2; S.tb = (size_t)256 * 512 * 2;
        EpiGlu E{Yb, SSMb, glu_b};
        pg8::gemm_phase<EpiGlu, GOrder, true>(F.lds + RING_OFF, 512, S, E);
    }
    xcd_barrier(bar);
    {
        MergeOrder S; S.so.init(M / 256, D / 256, F.G, (int)blockIdx.x, WGM_MRG); S.A = (const char*)Qb; S.B = (const char*)WpabT; S.ta = (size_t)256 * 512 * 2; S.tb = (size_t)256 * 512 * 2;
        EpiMerge E{SG, MRG};
        pg8::gemm_phase<EpiMerge, MergeOrder, true, false, true>(F.lds + RING_OFF, 512, S, E);
    }
    xcd_barrier(bar);
    {
        GOrder S; S.so.init(M / 256, D / 256, F.G, (int)blockIdx.x, WGM_WO); S.A = (const char*)MRG; S.B = (const char*)WoT; S.ta = (size_t)256 * 1024 * 2; S.tb = (size_t)256 * 1024 * 2;
        EpiOut E{x, H1B, H1B8, ssqp};
        pg8::gemm_phase<EpiOut, GOrder, true>(F.lds + RING_OFF, 1024, S, E);
    }
    xcd_barrier(bar);
    }
#endif

#if PH_MAX >= 3
    for (int rep = 0; rep < REP_RT; ++rep) {
    {
        int tid = threadIdx.x; asm volatile("" : "+v"(tid)); const int lane = tid & 63; (void)lane;
        LAS float* lg = (LAS float*)(F.lds);
        LAS int* cntl = (LAS int*)(F.lds + 2 * 128 * 65 * 4);
        LAS int* basel = cntl + 32; LAS int* eloc = basel + 32; LAS float* gloc = (LAS float*)(eloc + 256); LAS float* rloc = gloc + 256;
        if (tid < 32) cntl[tid] = 0;
        const int mt = wave & 3, kh = wave >> 2, l31 = lane & 31, h = lane >> 5;
        {
            const int row = 128 * c + 32 * mt + l31;
            f32x16 a0, a1;
#pragma unroll
            for (int r = 0; r < 16; ++r) { a0[r] = 0.f; a1[r] = 0.f; }
            const bf16* hp = H1B + (size_t)row * D + 512 * kh + 8 * h;
            const bf16* w0 = wr_t + (size_t)(32 * kh) * 512 + lane * 8;
#pragma unroll 8
            for (int ks = 0; ks < 32; ++ks) {
                const bf16x8 av = *(const bf16x8*)(hp + 16 * ks);
                const bf16x8 bh0 = *(const bf16x8*)(w0 + 512 * ks), bl0 = *(const bf16x8*)(w0 + 65536 + 512 * ks);
                const bf16x8 bh1 = *(const bf16x8*)(w0 + 32768 + 512 * ks), bl1 = *(const bf16x8*)(w0 + 32768 + 65536 + 512 * ks);
                a0 = __builtin_amdgcn_mfma_f32_32x32x16_bf16(av, bh0, a0, 0, 0, 0);
                a0 = __builtin_amdgcn_mfma_f32_32x32x16_bf16(av, bl0, a0, 0, 0, 0);
                a1 = __builtin_amdgcn_mfma_f32_32x32x16_bf16(av, bh1, a1, 0, 0, 0);
                a1 = __builtin_amdgcn_mfma_f32_32x32x16_bf16(av, bl1, a1, 0, 0, 0);
            }
#pragma unroll
            for (int r = 0; r < 16; ++r) { const int rr = 32 * mt + (r & 3) + 8 * (r >> 2) + 4 * h; lg[(kh * 128 + rr) * 65 + l31] = a0[r]; lg[(kh * 128 + rr) * 65 + 32 + l31] = a1[r]; }
        }
        __syncthreads();
        if (tid < 128) {
            const int row = 128 * c + tid; float ss = 0.f;
#pragma unroll
            for (int j = 0; j < 16; ++j) ss += ssqp[(size_t)row * 16 + j];
            const float rs = 1.0f / sqrtf(ss * (1.0f / D) + RMS_EPS); rstd2[row] = rs;
            const LAS float* l = lg + tid * 65; const LAS float* l2 = lg + (128 + tid) * 65;
            float gl[4]; int gi = 0; float gm;
#pragma unroll
            for (int j = 0; j < 4; ++j) gl[j] = rs * (l[j] + l2[j]) + rbias[j];
            gm = gl[0];
#pragma unroll
            for (int j = 1; j < 4; ++j) if (gl[j] > gm) { gm = gl[j]; gi = j; }
            float den = 0.f;
#pragma unroll
            for (int j = 0; j < 4; ++j) den += expf(gl[j] - gm);
            const float ptop = 1.0f / den;
            float v0 = -3.0e38f, v1 = -3.0e38f; int i0 = 0, i1 = 0;
            for (int j = 0; j < 8; ++j) { const float v = rs * (l[4 + gi * 8 + j] + l2[4 + gi * 8 + j]) + rbias[4 + gi * 8 + j];
                if (v > v0) { v1 = v0; i1 = i0; v0 = v; i0 = j; } else if (v > v1) { v1 = v; i1 = j; } }
            const float e1 = expf(v1 - v0); const float g0 = ptop / (1.0f + e1), g1 = ptop * e1 / (1.0f + e1);
            const int ea = gi * 8 + i0, eb = gi * 8 + i1;
            eloc[2 * tid] = ea; eloc[2 * tid + 1] = eb; gloc[2 * tid] = g0; gloc[2 * tid + 1] = g1; rloc[tid] = rs;
            atomicAdd((int*)(cntl + ea), 1); atomicAdd((int*)(cntl + eb), 1);
        }
        __syncthreads();
        if (tid < 32) basel[tid] = (int)__hip_atomic_fetch_add(etot + tid, (unsigned)cntl[tid], __ATOMIC_RELAXED, __HIP_MEMORY_SCOPE_AGENT);
        __syncthreads();
        if (tid < 256) {
            const int e = eloc[tid]; int rank = 0;
            for (int a = 0; a < tid; ++a) rank += (eloc[a] == e) ? 1 : 0;
            const int idx = e * CAPE + basel[e] + rank;
            inv_tok[idx] = 128 * c * 2 + tid; inv_gate[idx] = gloc[tid]; inv_rs[idx] = rloc[tid >> 1];
        }
    }
    xcd_barrier(bar);
    }
    for (int rep = 0; rep < REP_MOE; ++rep) {
    {
        LAS int* rowtok = (LAS int*)(F.lds + ROWTOK_OFF);
        { int tid = threadIdx.x; asm volatile("" : "+v"(tid));
          LAS int* tot = (LAS int*)(F.lds); LAS int* pst = tot + 32; LAS int* blke = pst + 40;
          if (tid < 32) tot[tid] = (int)etot[tid];
          __syncthreads();
          if (tid == 0) { int p = 0; for (int e = 0; e < 32; ++e) { pst[e] = p; p += ((tot[e] + 255) >> 8) << 8; } pst[32] = p; mymeta[0] = p >> 8; }
          __syncthreads();
          if (tid < 32) { for (int rb = pst[tid] >> 8; rb < (pst[tid + 1] >> 8); ++rb) { blke[rb] = tid; mymeta[16 + rb] = tid; } }
          __syncthreads();
          const int nrb = pst[32] >> 8; const int cb = (int)blockIdx.x;
          for (int idx = tid; idx < 5 * 256; idx += 512) { const int rb = ((idx >> 8) < 4) ? (idx >> 8) * 64 + (cb & 7) * 8 + (cb >> 5) : 256 + (cb & 7) + 8 * (cb >> 6); int tk = 0;
              if (rb < nrb) { const int e = blke[rb]; const int slot = rb * 256 + (idx & 255); const int rel = slot - pst[e]; const bool ok = rel < tot[e];
                  const int t2 = ok ? inv_tok[e * CAPE + rel] : -1; tk = ok ? (t2 >> 1) : 0;
                  sdst[slot] = t2; sgate[slot] = ok ? inv_gate[e * CAPE + rel] : 0.f; srs[slot] = ok ? inv_rs[e * CAPE + rel] : 0.f; }
              rowtok[idx] = tk; }
          asm volatile("s_waitcnt vmcnt(0)" ::: "memory");
          __syncthreads(); }
        MoeOrderG S; S.meta = mymeta; S.rowtok = rowtok; S.G = F.G; S.c = (int)blockIdx.x; S.A = (const char*)H1B8; S.B = (const char*)WupT; S.tb = (size_t)256 * 1024;
        EpiUp E{srs, HID};
        pg8::gemm_phase<EpiUp, MoeOrderG, true, true, false, true>(F.lds + RING_OFF, 512, S, E, 0x7f7a);
        if (rep == 0) {
            int tid = threadIdx.x; asm volatile("" : "+v"(tid)); const int lane = tid & 63;
            const int nrb = __builtin_amdgcn_readfirstlane(mymeta[0]); const int cb = (int)blockIdx.x;
            int T = nrb - 256; T = T < 0 ? 0 : (T > 31 ? 31 : T);
            const int r5 = (cb & 7) + 8 * (cb >> 6);
            if (r5 >= T) {
                const int nidle = (32 - T) * 8, me = (r5 - T) * 8 + ((cb >> 3) & 7);
                LAS float* scr = (LAS float*)(F.lds + wave * P0_SCR);
#pragma unroll 1
                for (int it = me + nidle * wave; it < I_E2; it += nidle * 8) {
                    const Tr64 t = expert_item(I_E1 + I_E3 + it, ew1, ew3, ew2, g_ffn, WupT, W2T);
                    f32x4 tv[16]; tr64_load(t, tv, lane); tr64_store(t, tv, scr, lane);
                }
            }
        }
    }
    xcd_barrier(bar);
    {
        MoeOrder S; S.meta = mymeta; S.G = F.G; S.c = (int)blockIdx.x; S.A = (const char*)HID; S.B = (const char*)W2T; S.ta = (size_t)256 * 512; S.tb = (size_t)256 * 512;
        EpiDown E{sdst, sgate, YB};
        pg8::gemm_phase<EpiDown, MoeOrder, true, false, false, true>(F.lds + RING_OFF, 256, S, E, 0x7d7b);
    }
    xcd_barrier(bar);
    }
#endif

#ifdef DBG_COPYSG
    for (int m = gw; m < M; m += NGW) { for (int j = 0; j < 16; ++j) HID[(size_t)m * 512 + ((lane + 64 * j) & 511)] = SG[(size_t)m * 2048 + DBG_COL0 + ((lane + 64 * j) & 511)]; }
    xcd_barrier(bar);
#endif
#ifdef DBG_BUF
    {
        for (int m = gw; m < M; m += NGW) {
            const bf16* src = DBG_BUF; const size_t ld = DBG_LD;
            float v[16];
#pragma unroll
            for (int j = 0; j < 16; ++j) v[j] = DBG_SCALE * bf2f(src[(size_t)(m % DBG_ROWS) * ld + ((lane + 64 * j) % ld)]);
            asm volatile("" ::: "memory");
#pragma unroll
            for (int j = 0; j < 16; ++j) out[(size_t)m * D + lane + 64 * j] = v[j];
        }
    }
#else
    for (int rep = 0; rep < REP_FIN; ++rep) {
        int tid = threadIdx.x; asm volatile("" : "+v"(tid)); const int lane = tid & 63; (void)lane;
        for (int m = gw; m < M; m += NGW) {
            f32x4 v[4]; float s = 0.f;
            { const v2u* hr = (const v2u*)(H1B + (size_t)m * D) + lane;
#pragma unroll
              for (int j = 0; j < 4; ++j) { const v2u a = hr[64 * j]; v[j][0] = bflo(a.x); v[j][1] = bfhi(a.x); v[j][2] = bflo(a.y); v[j][3] = bfhi(a.y); } }
#if PH_MAX >= 3
            const unsigned* y0 = (const unsigned*)(YB + (size_t)(2 * m) * D) + lane; const unsigned* y1 = (const unsigned*)(YB + (size_t)(2 * m + 1) * D) + lane;
#pragma unroll
            for (int j = 0; j < 4; ++j) { const int a = (int)y0[64 * j], b = (int)y1[64 * j];
                v[j][0] += (__builtin_amdgcn_cvt_f32_fp8(a, 0) + __builtin_amdgcn_cvt_f32_fp8(b, 0)) * 0.0625f; v[j][1] += (__builtin_amdgcn_cvt_f32_fp8(a, 1) + __builtin_amdgcn_cvt_f32_fp8(b, 1)) * 0.0625f;
                v[j][2] += (__builtin_amdgcn_cvt_f32_fp8(a, 2) + __builtin_amdgcn_cvt_f32_fp8(b, 2)) * 0.0625f; v[j][3] += (__builtin_amdgcn_cvt_f32_fp8(a, 3) + __builtin_amdgcn_cvt_f32_fp8(b, 3)) * 0.0625f; }
#endif
#pragma unroll
            for (int j = 0; j < 4; ++j) s += (v[j][0] * v[j][0] + v[j][1] * v[j][1]) + (v[j][2] * v[j][2] + v[j][3] * v[j][3]);
            const float rs = 1.0f / sqrtf(wave_sum(s, lane) * (1.0f / D) + RMS_EPS);
            f32x4* o = (f32x4*)(out + (size_t)m * D) + lane;
#pragma unroll
            for (int j = 0; j < 4; ++j) { const f32x4 g = *((const f32x4*)g_fin + lane + 64 * j); __builtin_nontemporal_store(v[j] * rs * g, &o[64 * j]); }
        }
    }
#endif
}

extern "C" void kernel_launch(void* const* d_in, const int* in_sizes, int n_in, void* d_out, int out_size, void* d_ws, size_t ws_size, hipStream_t stream) {
    static int grid = 0;
    if (grid == 0) {
        if (n_in != 26 || out_size != M * D || ws_size < WS_END) { fprintf(stderr, "kernel_launch: unexpected sizes n_in %d out %d ws %zu\n", n_in, out_size, ws_size); grid = -1; return; }
        int dev = 0, cus = 0, per_cu = 0;
        if (hipGetDevice(&dev) != hipSuccess || hipDeviceGetAttribute(&cus, hipDeviceAttributeMultiprocessorCount, dev) != hipSuccess) { grid = -1; return; }
        if (hipFuncSetAttribute((const void*)fwd_kernel, hipFuncAttributeMaxDynamicSharedMemorySize, LDS_BYTES) != hipSuccess) { fprintf(stderr, "kernel_launch: hipFuncSetAttribute failed\n"); grid = -1; return; }
        if (hipOccupancyMaxActiveBlocksPerMultiprocessor(&per_cu, (const void*)fwd_kernel, NWAVES * 64, LDS_BYTES) != hipSuccess || per_cu < 1)
            fprintf(stderr, "kernel_launch: occupancy query reports %d\n", per_cu);
        (void)hipGetLastError();
        grid = cus;
        if (grid != 256) fprintf(stderr, "kernel_launch: %d CUs (built for 256)\n", grid);
    }
    if (grid < 0) return;
    if (hipMemsetAsync((char*)d_ws + WS_CTL, 0, CTL_ZERO_BYTES, stream) != hipSuccess) return;
    Args a{};
    for (int i = 0; i < 26; ++i) a.in[i] = (const float*)d_in[i];
    a.out = (float*)d_out; a.ws = (unsigned char*)d_ws;
    hipLaunchKernelGGL(fwd_kernel, dim3(grid), dim3(NWAVES * 64), LDS_BYTES, stream, a);
}
```
